# Optimizing an MI355X kernel written in HIP

```python
import math
import jax, jax.numpy as jnp
from jax import lax
import numpy as np

D_MODEL = 1024
BATCH = 8
SEQ = 4096
DEPTH = 2

N_EVEN = (DEPTH + 1) // 2
N_ODD = DEPTH // 2

A_HEADS = 8
HEAD_DIM = 64
A_WIDTH = A_HEADS * HEAD_DIM
ATTN_BLOCK = 128
B_WIDTH = D_MODEL // 2
B_BLOCKS = 8
B_BLOCK_DIM = B_WIDTH // B_BLOCKS
CONV_WIDTH = 4
RG_C = 8.0
IN_AB = 3 * A_WIDTH + A_HEADS + 2 * B_WIDTH
C_WIDTH = 2 * D_MODEL
C_GROUPS = 8
C_GROUP_DIM = C_WIDTH // C_GROUPS
C_CHUNK = 128
MEM_LEN = 256
X_HEADS = 4
X_HEAD_DIM = D_MODEL // X_HEADS
N_GROUPS = 4
EXPERTS_PER_GROUP = 8
N_EXPERTS = N_GROUPS * EXPERTS_PER_GROUP
TOP_K = 2
D_EXPERT = D_MODEL // 2
EPS = 1e-6

kernel_name = "hybrid_fox_rglru_gmlp_hmoe"


def rms_norm(x, g):
    xf = x.astype(jnp.float32)
    y = xf * lax.rsqrt(jnp.mean(xf * xf, axis=-1, keepdims=True) + EPS)
    return (y * g.astype(jnp.float32)).astype(x.dtype)


def forgetting_attention(q, k, v, f_logit, f_bias, q_gain, k_gain):
    B, S, _ = q.shape
    q = rms_norm(q.reshape(B, S, A_HEADS, HEAD_DIM), q_gain).transpose(0, 2, 1, 3)
    k = rms_norm(k.reshape(B, S, A_HEADS, HEAD_DIM), k_gain).transpose(0, 2, 1, 3)
    v = v.reshape(B, S, A_HEADS, HEAD_DIM).transpose(0, 2, 1, 3)
    log_f = jax.nn.log_sigmoid(f_logit.astype(jnp.float32) + f_bias.astype(jnp.float32))
    c = jnp.cumsum(log_f, axis=1).transpose(0, 2, 1)
    scale = HEAD_DIM ** -0.5
    kpos = jnp.arange(S)

    def block(i):
        start = i * ATTN_BLOCK
        qb = lax.dynamic_slice_in_dim(q, start, ATTN_BLOCK, axis=2)
        cq = lax.dynamic_slice_in_dim(c, start, ATTN_BLOCK, axis=2)
        s = jnp.einsum('bhqd,bhkd->bhqk', qb, k, preferred_element_type=jnp.float32) * scale
        s = s + cq[..., :, None] - c[..., None, :]
        qpos = start + jnp.arange(ATTN_BLOCK)
        s = jnp.where(kpos[None, :] <= qpos[:, None], s, -jnp.inf)
        p = jax.nn.softmax(s, axis=-1).astype(v.dtype)
        return jnp.einsum('bhqk,bhkd->bhqd', p, v)

    o = lax.map(block, jnp.arange(S // ATTN_BLOCK))
    return o.transpose(1, 0, 3, 2, 4).reshape(B, S, A_WIDTH)


def causal_depthwise_conv(x, w, b):
    S = x.shape[1]
    xp = jnp.pad(x, ((0, 0), (CONV_WIDTH - 1, 0), (0, 0)))
    y = sum(xp[:, k:k + S] * w[k] for k in range(CONV_WIDTH))
    return y + b


def rglru_branch(xb, gb, conv_w, conv_b, wa, ba, wx, bx, lam):
    B, S, _ = xb.shape
    gate = jax.nn.gelu(gb)
    xc = causal_depthwise_conv(xb, conv_w, conv_b)
    xg = xc.reshape(B, S, B_BLOCKS, B_BLOCK_DIM)
    r = jax.nn.sigmoid(jnp.einsum('bsgi,gij->bsgj', xg, wa).reshape(B, S, B_WIDTH) + ba)
    i = jax.nn.sigmoid(jnp.einsum('bsgi,gij->bsgj', xg, wx).reshape(B, S, B_WIDTH) + bx)
    log_a = -RG_C * r.astype(jnp.float32) * jax.nn.softplus(-lam.astype(jnp.float32))
    a = jnp.exp(log_a)
    beta = jnp.sqrt(-jnp.expm1(2.0 * log_a))
    bterm = beta * (i * xc).astype(jnp.float32)

    def combine(left, right):
        a_l, b_l = left
        a_r, b_r = right
        return a_l * a_r, a_r * b_l + b_r

    _, h = lax.associative_scan(combine, (a, bterm), axis=1)
    return gate * h.astype(xb.dtype)


def fox_rglru_mixer(xn, w_in, f_bias, q_gain, k_gain, conv_w, conv_b, wa, ba, wx, bx, lam, w_out):
    proj = xn @ w_in
    cuts = [A_WIDTH, 2 * A_WIDTH, 3 * A_WIDTH, 3 * A_WIDTH + A_HEADS,
            3 * A_WIDTH + A_HEADS + B_WIDTH]
    q, k, v, f_logit, xb, gb = jnp.split(proj, cuts, axis=-1)
    attn = forgetting_attention(q, k, v, f_logit, f_bias, q_gain, k_gain)
    rec = rglru_branch(xb, gb, conv_w, conv_b, wa, ba, wx, bx, lam)
    return jnp.concatenate([attn, rec], axis=-1) @ w_out


def spatial_gating_mixer(xn, w_in, b_in, v_gain, w_s, b_s, w_out):
    B, S, _ = xn.shape
    z = jax.nn.gelu(xn @ w_in + b_in)
    u, v = jnp.split(z, 2, axis=-1)
    v = rms_norm(v, v_gain)
    v = v.reshape(B, S // C_CHUNK, C_CHUNK, C_GROUPS, C_GROUP_DIM)
    w_causal = jnp.tril(w_s)
    mixed = jnp.einsum('gts,bnsgc->bntgc', w_causal, v) + b_s.T[:, :, None]
    return (u * mixed.reshape(B, S, C_WIDTH)) @ w_out


def memory_cross_attention(xn, memn, wq, wkv, wo, q_gain, k_gain):
    B, S, _ = xn.shape
    q = rms_norm((xn @ wq).reshape(B, S, X_HEADS, X_HEAD_DIM), q_gain)
    k, v = jnp.split(memn @ wkv, 2, axis=-1)
    k = rms_norm(k.reshape(B, MEM_LEN, X_HEADS, X_HEAD_DIM), k_gain)
    v = v.reshape(B, MEM_LEN, X_HEADS, X_HEAD_DIM)
    s = jnp.einsum('bqhd,bkhd->bhqk', q, k, preferred_element_type=jnp.float32) * X_HEAD_DIM ** -0.5
    p = jax.nn.softmax(s, axis=-1).astype(v.dtype)
    o = jnp.einsum('bhqk,bkhd->bqhd', p, v).reshape(B, S, D_MODEL)
    return o @ wo


def hierarchical_moe(xn, wg, bg, we, be, w_gate, w_up, w_down):
    B, S, D = xn.shape
    T = B * S
    xf = xn.reshape(T, D)
    g_prob = jax.nn.softmax((xf @ wg + bg).astype(jnp.float32), axis=-1)
    g_idx = jnp.argmax(g_prob, axis=-1)
    g_w = jnp.take_along_axis(g_prob, g_idx[:, None], axis=-1)
    e_logits = (xf @ we + be).astype(jnp.float32).reshape(T, N_GROUPS, EXPERTS_PER_GROUP)
    e_sel = jnp.take_along_axis(e_logits, g_idx[:, None, None], axis=1)[:, 0]
    top_v, top_i = lax.top_k(e_sel, TOP_K)
    weights = (g_w * jax.nn.softmax(top_v, axis=-1)).astype(xn.dtype)
    expert = (g_idx[:, None] * EXPERTS_PER_GROUP + top_i).reshape(-1)
    order = jnp.argsort(expert)
    tok = order // TOP_K
    sizes = jnp.bincount(expert, length=N_EXPERTS).astype(jnp.int32)
    xs = xf[tok]
    h = jax.nn.silu(lax.ragged_dot(xs, w_gate, sizes)) * lax.ragged_dot(xs, w_up, sizes)
    y = lax.ragged_dot(h, w_down, sizes) * weights.reshape(-1)[order][:, None]
    out = jax.ops.segment_sum(y, tok, num_segments=T)
    return out.reshape(B, S, D)


def setup_inputs(seed: int = 0) -> dict:
    key = jax.random.key(seed)
    keys = list(jax.random.split(key, 40))
    kit = iter(keys)

    def nrm(shape, scale):
        return jax.random.normal(next(kit), shape, jnp.float32) * scale

    def gain(shape):
        return 1.0 + nrm(shape, 0.02)

    D = D_MODEL
    x = nrm((BATCH, SEQ, D), 1.0)
    mem = nrm((BATCH, MEM_LEN, D), 1.0)
    u = jax.random.uniform(next(kit), (N_EVEN, B_WIDTH), jnp.float32, 0.9, 0.999)
    sg = u ** (1.0 / RG_C)
    lam = jnp.log(sg) - jnp.log1p(-sg)
    return {
        "x": x,
        "mem": mem,
        "norm_mix": gain((DEPTH, D)),
        "norm_cross": gain((DEPTH, D)),
        "norm_mem": gain((DEPTH, D)),
        "norm_ffn": gain((DEPTH, D)),
        "ab_w_in": nrm((N_EVEN, D, IN_AB), D ** -0.5),
        "ab_f_bias": 3.0 + nrm((N_EVEN, A_HEADS), 1.0),
        "ab_q_gain": gain((N_EVEN, HEAD_DIM)),
        "ab_k_gain": gain((N_EVEN, HEAD_DIM)),
        "ab_conv_w": nrm((N_EVEN, CONV_WIDTH, B_WIDTH), CONV_WIDTH ** -0.5),
        "ab_conv_b": nrm((N_EVEN, B_WIDTH), 0.02),
        "ab_wa": nrm((N_EVEN, B_BLOCKS, B_BLOCK_DIM, B_BLOCK_DIM), B_BLOCK_DIM ** -0.5),
        "ab_ba": nrm((N_EVEN, B_WIDTH), 0.02),
        "ab_wx": nrm((N_EVEN, B_BLOCKS, B_BLOCK_DIM, B_BLOCK_DIM), B_BLOCK_DIM ** -0.5),
        "ab_bx": nrm((N_EVEN, B_WIDTH), 0.02),
        "ab_lambda": lam,
        "ab_w_out": nrm((N_EVEN, A_WIDTH + B_WIDTH, D), (A_WIDTH + B_WIDTH) ** -0.5),
        "c_w_in": nrm((N_ODD, D, 2 * C_WIDTH), D ** -0.5),
        "c_b_in": nrm((N_ODD, 2 * C_WIDTH), 0.02),
        "c_v_gain": gain((N_ODD, C_WIDTH)),
        "c_w_s": nrm((N_ODD, C_GROUPS, C_CHUNK, C_CHUNK), C_CHUNK ** -0.5),
        "c_b_s": 1.0 + nrm((N_ODD, C_GROUPS, C_CHUNK), 0.1),
        "c_w_out": nrm((N_ODD, C_WIDTH, D), C_WIDTH ** -0.5),
        "x_wq": nrm((DEPTH, D, D), D ** -0.5),
        "x_wkv": nrm((DEPTH, D, 2 * D), D ** -0.5),
        "x_wo": nrm((DEPTH, D, D), D ** -0.5),
        "x_q_gain": gain((DEPTH, X_HEAD_DIM)),
        "x_k_gain": gain((DEPTH, X_HEAD_DIM)),
        "moe_wg": nrm((DEPTH, D, N_GROUPS), D ** -0.5),
        "moe_bg": nrm((DEPTH, N_GROUPS), 0.01),
        "moe_we": nrm((DEPTH, D, N_EXPERTS), D ** -0.5),
        "moe_be": nrm((DEPTH, N_EXPERTS), 0.01),
        "moe_w_gate": nrm((DEPTH, N_EXPERTS, D, D_EXPERT), D ** -0.5),
        "moe_w_up": nrm((DEPTH, N_EXPERTS, D, D_EXPERT), D ** -0.5),
        "moe_w_down": nrm((DEPTH, N_EXPERTS, D_EXPERT, D), D_EXPERT ** -0.5),
    }


def reference(x, mem, norm_mix, norm_cross, norm_mem, norm_ffn,
              ab_w_in, ab_f_bias, ab_q_gain, ab_k_gain, ab_conv_w, ab_conv_b,
              ab_wa, ab_ba, ab_wx, ab_bx, ab_lambda, ab_w_out,
              c_w_in, c_b_in, c_v_gain, c_w_s, c_b_s, c_w_out,
              x_wq, x_wkv, x_wo, x_q_gain, x_k_gain,
              moe_wg, moe_bg, moe_we, moe_be, moe_w_gate, moe_w_up, moe_w_down):
    for layer in range(DEPTH):
        j = layer // 2
        h = rms_norm(x, norm_mix[layer])
        if layer % 2 == 0:
            x = x + fox_rglru_mixer(h, ab_w_in[j], ab_f_bias[j], ab_q_gain[j], ab_k_gain[j],
                                    ab_conv_w[j], ab_conv_b[j], ab_wa[j], ab_ba[j],
                                    ab_wx[j], ab_bx[j], ab_lambda[j], ab_w_out[j])
        else:
            x = x + spatial_gating_mixer(h, c_w_in[j], c_b_in[j], c_v_gain[j],
                                         c_w_s[j], c_b_s[j], c_w_out[j])
        x = x + memory_cross_attention(rms_norm(x, norm_cross[layer]),
                                       rms_norm(mem, norm_mem[layer]),
                                       x_wq[layer], x_wkv[layer], x_wo[layer],
                                       x_q_gain[layer], x_k_gain[layer])
        x = x + hierarchical_moe(rms_norm(x, norm_ffn[layer]), moe_wg[layer], moe_bg[layer],
                                 moe_we[layer], moe_be[layer], moe_w_gate[layer],
                                 moe_w_up[layer], moe_w_down[layer])
    return x
```

```cpp
#include <hip/hip_runtime.h>
#include <hip/hip_cooperative_groups.h>
#include <cstdint>
#include <cstdio>
namespace cg = cooperative_groups;

#ifndef FAST_CORE
#define FAST_CORE 0
#endif
#ifndef ONLY_PHASE2
#define ONLY_PHASE2 -1
#endif
#ifndef ONE_LAUNCH
#define ONE_LAUNCH 1
#endif

#define LAS __attribute__((address_space(3)))
typedef unsigned short bf16_t;
typedef short bf16x8 __attribute__((ext_vector_type(8)));
typedef float f32x4 __attribute__((ext_vector_type(4)));
typedef float f32x2 __attribute__((ext_vector_type(2)));
typedef unsigned u32x4 __attribute__((ext_vector_type(4)));
typedef unsigned u32x2 __attribute__((ext_vector_type(2)));

constexpr int NB = 8, SEQ = 4096, T = NB * SEQ, D = 1024;
constexpr int AH = 8, HD = 64, AW = 512, BW = 512;
constexpr int INAB = 2568;
constexpr int CW = 2048, CG = 8, CCH = 128;
constexpr int MEML = 256, XH = 4, XHD = 256;
constexpr int NGRP = 4, EPG = 8, NEXP = 32, DEXP = 512;
constexpr float EPS = 1e-6f;
constexpr float LOG2E = 1.4426950408889634f;
constexpr float C2 = 0.125f * LOG2E;
constexpr float C3 = 0.0625f * LOG2E;
constexpr int NTHREADS = 512, NWAVES = 8;
constexpr int LDS_BYTES = 147456;

constexpr size_t MiB = 1ull << 20;
constexpr size_t WS_CTL = 0;
constexpr size_t WS_W_IN0 = 1 * MiB, WS_W_OUT0 = 6 * MiB, WS_W_IN1 = 8 * MiB, WS_W_OUT1 = 16 * MiB;
constexpr size_t WS_W_Q = 20 * MiB, WS_W_KV = 24 * MiB, WS_W_O = 32 * MiB, WS_W_R = 36 * MiB, WS_TRIL = 37 * MiB;
constexpr size_t WS_W_GU = 38 * MiB, WS_W_DN = 102 * MiB;
constexpr size_t WS_X = 134 * MiB, WS_MEMB = 198 * MiB, WS_K2 = 202 * MiB, WS_V2T = 210 * MiB;
constexpr size_t WS_XSTAT = 218 * MiB, WS_VSTAT = 220 * MiB, WS_QSTAT = 224 * MiB, WS_PSUM = 226 * MiB;
constexpr size_t WS_FLOG = 228 * MiB, WS_CSUM = 229 * MiB, WS_LSUM = 230 * MiB, WS_MISC = 231 * MiB;
constexpr size_t WS_RLOG = 232 * MiB, WS_PAIRW = 238 * MiB, WS_LIST = 239 * MiB, WS_ARENA = 248 * MiB, WS_END = 504 * MiB;
constexpr size_t AR_Q = 0, AR_K = 32 * MiB, AR_V = 64 * MiB, AR_XB = 96 * MiB, AR_GATE = 128 * MiB, AR_AR = 160 * MiB;
constexpr size_t AR_Q2 = 0, AR_P = 64 * MiB, AR_O = 128 * MiB;
constexpr size_t AR_H = 0, AR_Y = 64 * MiB;
constexpr size_t AR_U = 0, AR_V3 = 128 * MiB;
constexpr size_t MISC_MEMSTAT = 0, MISC_K2STAT = 65536;

struct Args { const float* in[36]; float* out; unsigned char* ws; int ph_lo, ph_hi; };
enum { I_X = 0, I_MEM, I_NMIX, I_NCROSS, I_NMEM, I_NFFN, I_ABWIN, I_FBIAS, I_AQG, I_AKG, I_CONVW, I_CONVB, I_WA, I_BA, I_WX, I_BX, I_LAM, I_ABWOUT,
       I_CWIN, I_CBIN, I_CVG, I_CWS, I_CBS, I_CWOUT, I_XWQ, I_XWKV, I_XWO, I_XQG, I_XKG, I_MWG, I_MBG, I_MWE, I_MBE, I_MGATE, I_MUP, I_MDOWN };

__device__ __forceinline__ float bf_lo(unsigned u) { return __uint_as_float(u << 16); }
__device__ __forceinline__ float bf_hi(unsigned u) { return __uint_as_float(u & 0xffff0000u); }
__device__ __forceinline__ float bf2f(bf16_t v) { return __uint_as_float((unsigned)v << 16); }
__device__ __forceinline__ unsigned pk2(float lo, float hi) { typedef __bf16 bf2_t __attribute__((ext_vector_type(2))); f32x2 v = {lo, hi}; bf2_t b = __builtin_convertvector(v, bf2_t); return __builtin_bit_cast(unsigned, b); }
__device__ __forceinline__ bf16_t f2bf(float f) { return (bf16_t)(pk2(f, 0.f) & 0xffffu); }
__device__ __forceinline__ float wave_sum(float v) {
#pragma unroll
    for (int o = 1; o < 64; o <<= 1) v += __shfl_xor(v, o);
    return v;
}
__device__ __forceinline__ float gelu_tanh(float x) { const float u = 0.7978845608028654f * (x + 0.044715f * x * x * x); return x / (1.f + __expf(-2.f * u)); }
__device__ __forceinline__ float sigmoidf(float x) { return 1.f / (1.f + __expf(-x)); }
__device__ __forceinline__ float sum16(const float* p) { const f32x4 a = *(const f32x4*)p, b = *(const f32x4*)(p + 4), c = *(const f32x4*)(p + 8), d = *(const f32x4*)(p + 12);
    return ((a.x + a.y) + (a.z + a.w)) + ((b.x + b.y) + (b.z + b.w)) + ((c.x + c.y) + (c.z + c.w)) + ((d.x + d.y) + (d.z + d.w)); }
__device__ __forceinline__ int perm32(int rho) { const int n = rho >> 4, i = rho & 15; return 8 * (i >> 2) + 4 * n + (i & 3); }

struct U { int pm, pn, e, cnt; };
__device__ __forceinline__ int brow_std(int bj, int S) { return 64 * (S >> 5) + 32 * bj + perm32(S & 31); }
typedef f32x4 Acc[2][2][4][2];

template <class P> __device__ __forceinline__ void gemm_naive(const P& p) {
    const int tid = threadIdx.x, wid = tid >> 6, lane = tid & 63, wr = wid >> 2, wc = wid & 3, fr = lane & 15, fq = lane >> 4;
    for (int i = 0;; ++i) {
        U u; if (!p.unit(i * (int)gridDim.x + (int)blockIdx.x, u)) break;
        Acc acc;
#pragma unroll
        for (int a = 0; a < 2; ++a)
#pragma unroll
            for (int b = 0; b < 2; ++b)
#pragma unroll
                for (int m = 0; m < 4; ++m)
#pragma unroll
                    for (int n = 0; n < 2; ++n) acc[a][b][m][n] = (f32x4){0.f, 0.f, 0.f, 0.f};
        const bf16_t* A = p.a_ptr(u); const bf16_t* B = p.b_ptr(u); const int lda = p.lda, ldb = p.ldb, K = p.K;
        unsigned aoff[8], boff[16];
#pragma unroll
        for (int ai = 0; ai < 2; ++ai)
#pragma unroll
            for (int m = 0; m < 4; ++m) aoff[ai * 4 + m] = (unsigned)p.a_row(u, 128 * ai + 64 * wr + 16 * m + fr) * (unsigned)lda;
#pragma unroll
        for (int bj = 0; bj < 2; ++bj)
#pragma unroll
            for (int n = 0; n < 2; ++n)
#pragma unroll
                for (int e = 0; e < 4; ++e) boff[bj * 8 + n * 4 + e] = (unsigned)P::b_row(bj, 32 * wc + 16 * n + 4 * fq + e) * (unsigned)ldb;
        for (int k0 = 0; k0 < K; k0 += 2) {
            float af[8][2];
#pragma unroll
            for (int r = 0; r < 8; ++r) { const unsigned v = *(const unsigned*)(A + aoff[r] + k0); af[r][0] = bf_lo(v); af[r][1] = bf_hi(v); }
#pragma unroll
            for (int bj = 0; bj < 2; ++bj)
#pragma unroll
                for (int n = 0; n < 2; ++n)
#pragma unroll
                    for (int e = 0; e < 4; ++e) {
                        const unsigned v = *(const unsigned*)(B + boff[bj * 8 + n * 4 + e] + k0);
                        const float b0 = bf_lo(v), b1 = bf_hi(v);
#pragma unroll
                        for (int ai = 0; ai < 2; ++ai)
#pragma unroll
                            for (int m = 0; m < 4; ++m) { const float* x = af[ai * 4 + m]; acc[ai][bj][m][n][e] += x[0] * b0 + x[1] * b1; }
                    }
        }
        p.epi(acc, u, wr, wc, fr, fq);
    }
}

struct PlainSched {
    int nM, nN;
    __device__ __forceinline__ bool unit(int L, U& u) const { if (L >= nM * nN) return false; u.pm = L / nN; u.pn = L - u.pm * nN; u.e = 0; u.cnt = 0; return true; }
};

struct PInProj0 : PlainSched {
    const bf16_t* X; const bf16_t* W; const float* xstat; const float* qg; const float* kg; bf16_t *Q, *Kq, *V, *XB, *GATE; int lda, ldb, K;
    __device__ __forceinline__ const bf16_t* a_ptr(const U& u) const { return X + (size_t)u.pm * 256 * D; }
    __device__ __forceinline__ int a_row(const U&, int R) const { return R; }
    __device__ __forceinline__ const bf16_t* b_ptr(const U& u) const { return W + (size_t)u.pn * 256 * D; }
    static __device__ __forceinline__ int b_row(int bj, int S) { return brow_std(bj, S); }
    __device__ __forceinline__ void epi(Acc& acc, const U& u, int wr, int wc, int fr, int fq) const {
        const int kind = u.pn >> 1, half = u.pn & 1;
        bf16_t* dst = kind == 0 ? Q : kind == 1 ? Kq : kind == 2 ? V : kind == 3 ? XB : GATE;
        const float* gain = kind == 0 ? qg : kg;
#pragma unroll
        for (int ai = 0; ai < 2; ++ai)
#pragma unroll
            for (int m = 0; m < 4; ++m) {
                const int row = u.pm * 256 + 128 * ai + 64 * wr + 16 * m + fr;
                const float s = rsqrtf(sum16(xstat + (size_t)row * 16) * (1.f / D) + EPS);
                float v[2][8];
#pragma unroll
                for (int bj = 0; bj < 2; ++bj)
#pragma unroll
                    for (int n = 0; n < 2; ++n)
#pragma unroll
                        for (int e = 0; e < 4; ++e) v[bj][n * 4 + e] = acc[ai][bj][m][n][e] * s;
                if (kind <= 1) {
                    float ss = 0.f;
#pragma unroll
                    for (int bj = 0; bj < 2; ++bj)
#pragma unroll
                        for (int j = 0; j < 8; ++j) ss += v[bj][j] * v[bj][j];
                    ss += __shfl_xor(ss, 16); ss += __shfl_xor(ss, 32);
                    const float rn = rsqrtf(ss * (1.f / HD) + EPS) * (kind == 0 ? C2 : 1.f);
#pragma unroll
                    for (int bj = 0; bj < 2; ++bj)
#pragma unroll
                        for (int j = 0; j < 8; ++j) v[bj][j] *= rn * gain[32 * bj + 8 * fq + j];
                } else if (kind == 4) {
#pragma unroll
                    for (int bj = 0; bj < 2; ++bj)
#pragma unroll
                        for (int j = 0; j < 8; ++j) v[bj][j] = gelu_tanh(v[bj][j]);
                }
#pragma unroll
                for (int bj = 0; bj < 2; ++bj) {
                    u32x4 w; w.x = pk2(v[bj][0], v[bj][1]); w.y = pk2(v[bj][2], v[bj][3]); w.z = pk2(v[bj][4], v[bj][5]); w.w = pk2(v[bj][6], v[bj][7]);
                    *(u32x4*)(dst + (size_t)row * 512 + 256 * half + 64 * wc + 32 * bj + 8 * fq) = w;
                }
            }
    }
};

struct PMemKV : PlainSched {
    const bf16_t* A; const bf16_t* W; const float* memstat; float* k2stat; bf16_t* K2; bf16_t* V2T; int lda, ldb, K;
    __device__ __forceinline__ const bf16_t* a_ptr(const U& u) const { return A + (size_t)u.pm * 256 * D; }
    __device__ __forceinline__ int a_row(const U&, int R) const { return R; }
    __device__ __forceinline__ const bf16_t* b_ptr(const U& u) const { return W + (size_t)u.pn * 256 * D; }
    static __device__ __forceinline__ int b_row(int bj, int S) { return brow_std(bj, S); }
    __device__ __forceinline__ void epi(Acc& acc, const U& u, int wr, int wc, int fr, int fq) const {
        const int b = u.pm, h = u.pn & 3; const bool isv = u.pn >= 4;
#pragma unroll
        for (int ai = 0; ai < 2; ++ai)
#pragma unroll
            for (int m = 0; m < 4; ++m) {
                const int key = 128 * ai + 64 * wr + 16 * m + fr, row = b * 256 + key;
                const float s = rsqrtf(memstat[row] * (1.f / D) + EPS);
                if (!isv) {
                    float ss = 0.f;
#pragma unroll
                    for (int bj = 0; bj < 2; ++bj) {
                        float v[8];
#pragma unroll
                        for (int n = 0; n < 2; ++n)
#pragma unroll
                            for (int e = 0; e < 4; ++e) { v[n * 4 + e] = acc[ai][bj][m][n][e] * s; ss += v[n * 4 + e] * v[n * 4 + e]; }
                        u32x4 w; w.x = pk2(v[0], v[1]); w.y = pk2(v[2], v[3]); w.z = pk2(v[4], v[5]); w.w = pk2(v[6], v[7]);
                        *(u32x4*)(K2 + ((size_t)(b * 4 + h) * 256 + key) * 256 + 64 * wc + 32 * bj + 8 * fq) = w;
                    }
                    ss += __shfl_xor(ss, 16); ss += __shfl_xor(ss, 32);
                    if (fq == 0) k2stat[(size_t)row * 16 + 4 * h + wc] = ss;
                } else {
#pragma unroll
                    for (int bj = 0; bj < 2; ++bj)
#pragma unroll
                        for (int n = 0; n < 2; ++n)
#pragma unroll
                            for (int e = 0; e < 4; ++e) { const int d = 64 * wc + 32 * bj + 8 * fq + 4 * n + e;
                                V2T[((size_t)(b * 4 + h) * 256 + d) * 256 + key] = f2bf(acc[ai][bj][m][n][e] * s); }
                }
            }
    }
};

struct PResid : PlainSched {
    const bf16_t* A; const bf16_t* W; bf16_t* X; float* xstat; int lda, ldb, K;
    __device__ __forceinline__ const bf16_t* a_ptr(const U& u) const { return A + (size_t)u.pm * 256 * lda; }
    __device__ __forceinline__ int a_row(const U&, int R) const { return R; }
    __device__ __forceinline__ const bf16_t* b_ptr(const U& u) const { return W + (size_t)u.pn * 256 * ldb; }
    static __device__ __forceinline__ int b_row(int bj, int S) { return brow_std(bj, S); }
    __device__ __forceinline__ void epi(Acc& acc, const U& u, int wr, int wc, int fr, int fq) const {
#pragma unroll
        for (int ai = 0; ai < 2; ++ai)
#pragma unroll
            for (int m = 0; m < 4; ++m) {
                const int row = u.pm * 256 + 128 * ai + 64 * wr + 16 * m + fr; float ss = 0.f;
#pragma unroll
                for (int bj = 0; bj < 2; ++bj) {
                    bf16_t* xp = X + (size_t)row * D + 256 * u.pn + 64 * wc + 32 * bj + 8 * fq;
                    const u32x4 o = *(const u32x4*)xp;
                    float v[8] = {bf_lo(o.x), bf_hi(o.x), bf_lo(o.y), bf_hi(o.y), bf_lo(o.z), bf_hi(o.z), bf_lo(o.w), bf_hi(o.w)};
#pragma unroll
                    for (int n = 0; n < 2; ++n)
#pragma unroll
                        for (int e = 0; e < 4; ++e) v[n * 4 + e] += acc[ai][bj][m][n][e];
                    u32x4 w; w.x = pk2(v[0], v[1]); w.y = pk2(v[2], v[3]); w.z = pk2(v[4], v[5]); w.w = pk2(v[6], v[7]);
                    *(u32x4*)xp = w;
                    const float r[8] = {bf_lo(w.x), bf_hi(w.x), bf_lo(w.y), bf_hi(w.y), bf_lo(w.z), bf_hi(w.z), bf_lo(w.w), bf_hi(w.w)};
#pragma unroll
                    for (int j = 0; j < 8; ++j) ss += r[j] * r[j];
                }
                ss += __shfl_xor(ss, 16); ss += __shfl_xor(ss, 32);
                if (fq == 0) xstat[(size_t)row * 16 + 4 * u.pn + wc] = ss;
            }
    }
};

struct PCrossQ : PlainSched {
    const bf16_t* X; const bf16_t* W; const float* xstat; bf16_t* Q2; float* qstat; int lda, ldb, K;
    __device__ __forceinline__ const bf16_t* a_ptr(const U& u) const { return X + (size_t)u.pm * 256 * D; }
    __device__ __forceinline__ int a_row(const U&, int R) const { return R; }
    __device__ __forceinline__ const bf16_t* b_ptr(const U& u) const { return W + (size_t)u.pn * 256 * D; }
    static __device__ __forceinline__ int b_row(int bj, int S) { return brow_std(bj, S); }
    __device__ __forceinline__ void epi(Acc& acc, const U& u, int wr, int wc, int fr, int fq) const {
#pragma unroll
        for (int ai = 0; ai < 2; ++ai)
#pragma unroll
            for (int m = 0; m < 4; ++m) {
                const int row = u.pm * 256 + 128 * ai + 64 * wr + 16 * m + fr; float ss = 0.f;
                const float s = rsqrtf(sum16(xstat + (size_t)row * 16) * (1.f / D) + EPS);
#pragma unroll
                for (int bj = 0; bj < 2; ++bj) {
                    float v[8];
#pragma unroll
                    for (int n = 0; n < 2; ++n)
#pragma unroll
                        for (int e = 0; e < 4; ++e) v[n * 4 + e] = acc[ai][bj][m][n][e] * s;
                    u32x4 w; w.x = pk2(v[0], v[1]); w.y = pk2(v[2], v[3]); w.z = pk2(v[4], v[5]); w.w = pk2(v[6], v[7]);
                    *(u32x4*)(Q2 + (size_t)row * D + 256 * u.pn + 64 * wc + 32 * bj + 8 * fq) = w;
                    const float r[8] = {bf_lo(w.x), bf_hi(w.x), bf_lo(w.y), bf_hi(w.y), bf_lo(w.z), bf_hi(w.z), bf_lo(w.w), bf_hi(w.w)};
#pragma unroll
                    for (int j = 0; j < 8; ++j) ss += r[j] * r[j];
                }
                ss += __shfl_xor(ss, 16); ss += __shfl_xor(ss, 32);
                if (fq == 0) qstat[(size_t)row * 16 + 4 * u.pn + wc] = ss;
            }
    }
};

struct PCrossS : PlainSched {
    const bf16_t* Q2; const bf16_t* K2; const float* qstat; bf16_t* P; float* psum; int lda, ldb, K;
    __device__ __forceinline__ const bf16_t* a_ptr(const U& u) const { return Q2 + (size_t)u.pm * 256 * D + 256 * u.pn; }
    __device__ __forceinline__ int a_row(const U&, int R) const { return R; }
    __device__ __forceinline__ const bf16_t* b_ptr(const U& u) const { return K2 + (size_t)((u.pm >> 4) * 4 + u.pn) * 65536; }
    static __device__ __forceinline__ int b_row(int bj, int S) { return brow_std(bj, S); }
    __device__ __forceinline__ void epi(Acc& acc, const U& u, int wr, int wc, int fr, int fq) const {
#pragma unroll
        for (int ai = 0; ai < 2; ++ai)
#pragma unroll
            for (int m = 0; m < 4; ++m) {
                const int row = u.pm * 256 + 128 * ai + 64 * wr + 16 * m + fr; float ss = 0.f;
                const f32x4 qs = *(const f32x4*)(qstat + (size_t)row * 16 + 4 * u.pn);
                const float rn = rsqrtf(((qs.x + qs.y) + (qs.z + qs.w)) * (1.f / XHD) + EPS) * C3;
#pragma unroll
                for (int bj = 0; bj < 2; ++bj) {
                    float v[8];
#pragma unroll
                    for (int n = 0; n < 2; ++n)
#pragma unroll
                        for (int e = 0; e < 4; ++e) v[n * 4 + e] = exp2f(acc[ai][bj][m][n][e] * rn);
                    u32x4 w; w.x = pk2(v[0], v[1]); w.y = pk2(v[2], v[3]); w.z = pk2(v[4], v[5]); w.w = pk2(v[6], v[7]);
                    *(u32x4*)(P + (size_t)row * D + 256 * u.pn + 64 * wc + 32 * bj + 8 * fq) = w;
                    const float r[8] = {bf_lo(w.x), bf_hi(w.x), bf_lo(w.y), bf_hi(w.y), bf_lo(w.z), bf_hi(w.z), bf_lo(w.w), bf_hi(w.w)};
#pragma unroll
                    for (int j = 0; j < 8; ++j) ss += r[j];
                }
                ss += __shfl_xor(ss, 16); ss += __shfl_xor(ss, 32);
                if (fq == 0) psum[(size_t)row * 16 + 4 * u.pn + wc] = ss;
            }
    }
};

struct PCrossPV : PlainSched {
    const bf16_t* P; const bf16_t* V2T; const float* psum; bf16_t* O; int lda, ldb, K;
    __device__ __forceinline__ const bf16_t* a_ptr(const U& u) const { return P + (size_t)u.pm * 256 * D + 256 * u.pn; }
    __device__ __forceinline__ int a_row(const U&, int R) const { return R; }
    __device__ __forceinline__ const bf16_t* b_ptr(const U& u) const { return V2T + (size_t)((u.pm >> 4) * 4 + u.pn) * 65536; }
    static __device__ __forceinline__ int b_row(int bj, int S) { return brow_std(bj, S); }
    __device__ __forceinline__ void epi(Acc& acc, const U& u, int wr, int wc, int fr, int fq) const {
#pragma unroll
        for (int ai = 0; ai < 2; ++ai)
#pragma unroll
            for (int m = 0; m < 4; ++m) {
                const int row = u.pm * 256 + 128 * ai + 64 * wr + 16 * m + fr;
                const f32x4 ps = *(const f32x4*)(psum + (size_t)row * 16 + 4 * u.pn);
                const float inv = 1.f / ((ps.x + ps.y) + (ps.z + ps.w));
#pragma unroll
                for (int bj = 0; bj < 2; ++bj) {
                    float v[8];
#pragma unroll
                    for (int n = 0; n < 2; ++n)
#pragma unroll
                        for (int e = 0; e < 4; ++e) v[n * 4 + e] = acc[ai][bj][m][n][e] * inv;
                    u32x4 w; w.x = pk2(v[0], v[1]); w.y = pk2(v[2], v[3]); w.z = pk2(v[4], v[5]); w.w = pk2(v[6], v[7]);
                    *(u32x4*)(O + (size_t)row * D + 256 * u.pn + 64 * wc + 32 * bj + 8 * fq) = w;
                }
            }
    }
};

struct PRouter : PlainSched {
    const bf16_t* X; const bf16_t* W; const float* xstat; const float* bg; const float* be; float* rlog; int lda, ldb, K;
    __device__ __forceinline__ const bf16_t* a_ptr(const U& u) const { return X + (size_t)u.pm * 256 * D; }
    __device__ __forceinline__ int a_row(const U&, int R) const { return R; }
    __device__ __forceinline__ const bf16_t* b_ptr(const U&) const { return W; }
    static __device__ __forceinline__ int b_row(int bj, int S) { return brow_std(bj, S); }
    __device__ __forceinline__ void epi(Acc& acc, const U& u, int wr, int wc, int fr, int fq) const {
        if (wc != 0) return;
#pragma unroll
        for (int ai = 0; ai < 2; ++ai)
#pragma unroll
            for (int m = 0; m < 4; ++m) {
                const int row = u.pm * 256 + 128 * ai + 64 * wr + 16 * m + fr;
                const float s = rsqrtf(sum16(xstat + (size_t)row * 16) * (1.f / D) + EPS);
#pragma unroll
                for (int n = 0; n < 2; ++n)
#pragma unroll
                    for (int e = 0; e < 4; ++e) { const int c = 8 * fq + 4 * n + e; rlog[(size_t)row * 40 + c] = acc[ai][0][m][n][e] * s + (c < 4 ? bg[c] : be[c - 4]); }
                if (fq == 0) {
#pragma unroll
                    for (int e = 0; e < 4; ++e) rlog[(size_t)row * 40 + 32 + e] = acc[ai][1][m][0][e] * s + be[28 + e];
                }
            }
    }
};

struct MoeSched {
    const int* cnt; const int* list; volatile LAS int* tpre;
    __device__ __forceinline__ bool unit(int L, U& u) const {
        const int mt = L >> 2; if (mt >= tpre[32]) return false;
        int e = 0;
        for (int j = 1; j < 32; ++j) e = (mt >= tpre[j]) ? j : e;
        u.e = e; u.pm = mt - tpre[e]; u.pn = L & 3; u.cnt = cnt[e]; return true;
    }
    __device__ __forceinline__ int pair_of(const U& u, int R) const { int s = u.pm * 256 + R; s = s < u.cnt ? s : u.cnt - 1; return list[(size_t)u.e * 65536 + s]; }
};
__device__ __forceinline__ void moe_sched_build(const int* cnt, volatile LAS int* tpre) {
    __syncthreads();
    if (threadIdx.x == 0) { int acc = 0; for (int e = 0; e < 32; ++e) { tpre[e] = acc; acc += (cnt[e] + 255) >> 8; } tpre[32] = acc; }
    __syncthreads();
}
struct PMoeUp : MoeSched {
    const bf16_t* X; const bf16_t* W; const float* xstat; bf16_t* H; int lda, ldb, K;
    __device__ __forceinline__ const bf16_t* a_ptr(const U&) const { return X; }
    __device__ __forceinline__ int a_row(const U& u, int R) const { return pair_of(u, R) >> 1; }
    __device__ __forceinline__ const bf16_t* b_ptr(const U& u) const { return W + (size_t)u.e * (1024 * 1024) + (size_t)u.pn * 128 * 1024; }
    static __device__ __forceinline__ int b_row(int bj, int S) { return 512 * bj + 32 * (S >> 5) + perm32(S & 31); }
    __device__ __forceinline__ void epi(Acc& acc, const U& u, int wr, int wc, int fr, int fq) const {
#pragma unroll
        for (int ai = 0; ai < 2; ++ai)
#pragma unroll
            for (int m = 0; m < 4; ++m) {
                const int pr = pair_of(u, 128 * ai + 64 * wr + 16 * m + fr), tok = pr >> 1;
                const float s = rsqrtf(sum16(xstat + (size_t)tok * 16) * (1.f / D) + EPS);
                float v[8];
#pragma unroll
                for (int n = 0; n < 2; ++n)
#pragma unroll
                    for (int e = 0; e < 4; ++e) { const float g = acc[ai][0][m][n][e] * s, up = acc[ai][1][m][n][e] * s; v[n * 4 + e] = g / (1.f + __expf(-g)) * up; }
                u32x4 w; w.x = pk2(v[0], v[1]); w.y = pk2(v[2], v[3]); w.z = pk2(v[4], v[5]); w.w = pk2(v[6], v[7]);
                *(u32x4*)(H + (size_t)pr * DEXP + 128 * u.pn + 32 * wc + 8 * fq) = w;
            }
    }
};
struct PMoeDown : MoeSched {
    const bf16_t* H; const bf16_t* W; const float* pairw; bf16_t* Y; int lda, ldb, K;
    __device__ __forceinline__ const bf16_t* a_ptr(const U&) const { return H; }
    __device__ __forceinline__ int a_row(const U& u, int R) const { return pair_of(u, R); }
    __device__ __forceinline__ const bf16_t* b_ptr(const U& u) const { return W + (size_t)u.e * (1024 * 512) + (size_t)u.pn * 256 * 512; }
    static __device__ __forceinline__ int b_row(int bj, int S) { return brow_std(bj, S); }
    __device__ __forceinline__ void epi(Acc& acc, const U& u, int wr, int wc, int fr, int fq) const {
#pragma unroll
        for (int ai = 0; ai < 2; ++ai)
#pragma unroll
            for (int m = 0; m < 4; ++m) {
                const int pr = pair_of(u, 128 * ai + 64 * wr + 16 * m + fr); const float wgt = pairw[pr];
#pragma unroll
                for (int bj = 0; bj < 2; ++bj) {
                    float v[8];
#pragma unroll
                    for (int n = 0; n < 2; ++n)
#pragma unroll
                        for (int e = 0; e < 4; ++e) v[n * 4 + e] = acc[ai][bj][m][n][e] * wgt;
                    u32x4 w; w.x = pk2(v[0], v[1]); w.y = pk2(v[2], v[3]); w.z = pk2(v[4], v[5]); w.w = pk2(v[6], v[7]);
                    *(u32x4*)(Y + (size_t)pr * D + 256 * u.pn + 64 * wc + 32 * bj + 8 * fq) = w;
                }
            }
    }
};
struct PInProj1 : PlainSched {
    const bf16_t* X; const bf16_t* W; const float* xstat; const float* bias; bf16_t* Ub; bf16_t* V3; float* vstat; int lda, ldb, K;
    __device__ __forceinline__ const bf16_t* a_ptr(const U& u) const { return X + (size_t)u.pm * 256 * D; }
    __device__ __forceinline__ int a_row(const U&, int R) const { return R; }
    __device__ __forceinline__ const bf16_t* b_ptr(const U& u) const { return W + (size_t)u.pn * 256 * D; }
    static __device__ __forceinline__ int b_row(int bj, int S) { return brow_std(bj, S); }
    __device__ __forceinline__ void epi(Acc& acc, const U& u, int wr, int wc, int fr, int fq) const {
        const bool isv = u.pn >= 8; const int pn8 = u.pn & 7; bf16_t* dst = isv ? V3 : Ub;
#pragma unroll
        for (int ai = 0; ai < 2; ++ai)
#pragma unroll
            for (int m = 0; m < 4; ++m) {
                const int row = u.pm * 256 + 128 * ai + 64 * wr + 16 * m + fr; float ss = 0.f;
                const float s = rsqrtf(sum16(xstat + (size_t)row * 16) * (1.f / D) + EPS);
#pragma unroll
                for (int bj = 0; bj < 2; ++bj) {
                    const int lc = 64 * wc + 32 * bj + 8 * fq;
                    const f32x4 b0 = *(const f32x4*)(bias + 256 * u.pn + lc), b1 = *(const f32x4*)(bias + 256 * u.pn + lc + 4);
                    float v[8];
#pragma unroll
                    for (int e = 0; e < 4; ++e) { v[e] = gelu_tanh(acc[ai][bj][m][0][e] * s + b0[e]); v[4 + e] = gelu_tanh(acc[ai][bj][m][1][e] * s + b1[e]); }
                    u32x4 w; w.x = pk2(v[0], v[1]); w.y = pk2(v[2], v[3]); w.z = pk2(v[4], v[5]); w.w = pk2(v[6], v[7]);
                    *(u32x4*)(dst + (size_t)row * CW + 256 * pn8 + lc) = w;
                    const float r[8] = {bf_lo(w.x), bf_hi(w.x), bf_lo(w.y), bf_hi(w.y), bf_lo(w.z), bf_hi(w.z), bf_lo(w.w), bf_hi(w.w)};
#pragma unroll
                    for (int j = 0; j < 8; ++j) ss += r[j] * r[j];
                }
                if (isv) { ss += __shfl_xor(ss, 16); ss += __shfl_xor(ss, 32); if (fq == 0) vstat[(size_t)row * 32 + 4 * pn8 + wc] = ss; }
            }
    }
};

template <class P> __device__ __forceinline__ void run_gemm(LAS unsigned char* lds, const P& p) {
    (void)lds;
    gemm_naive<P>(p);
}

__device__ __forceinline__ void tconv_item(const float* W, int ldw, int n0, bf16_t* dst, int ldd, int drow0, const float* ksc, LAS float* scr, int kb, int nb, int lane) {
    const int k0 = 64 * kb, c0 = n0 + 32 * nb;
#pragma unroll 8
    for (int i = 0; i < 32; ++i) { const int kk = 2 * i + (lane >> 5); scr[kk * 33 + (lane & 31)] = W[(size_t)(k0 + kk) * ldw + c0 + (lane & 31)]; }
    asm volatile("s_waitcnt lgkmcnt(0)" ::: "memory");
    const int c = lane & 7;
    float sc[8];
#pragma unroll
    for (int j = 0; j < 8; ++j) sc[j] = ksc ? ksc[k0 + 8 * c + j] : 1.f;
#pragma unroll
    for (int j = 0; j < 4; ++j) { const int n = (lane >> 3) + 8 * j; const LAS float* s = scr + (8 * c) * 33 + n;
        u32x4 o; o.x = pk2(s[0 * 33] * sc[0], s[1 * 33] * sc[1]); o.y = pk2(s[2 * 33] * sc[2], s[3 * 33] * sc[3]); o.z = pk2(s[4 * 33] * sc[4], s[5 * 33] * sc[5]); o.w = pk2(s[6 * 33] * sc[6], s[7 * 33] * sc[7]);
        *(u32x4*)(dst + (size_t)(drow0 + 32 * nb + n) * ldd + k0 + 8 * c) = o; }
    asm volatile("s_waitcnt lgkmcnt(0)" ::: "memory");
}
__device__ __forceinline__ bool tconv_job(int& r, const float* W, int ldw, int n0, int Kd, int Nc, bf16_t* dst, int drow0, const float* ksc, LAS float* scr, int lane) {
    const int nkb = Kd / 64, nnb = Nc / 32, items = nkb * nnb;
    if (r >= items) { r -= items; return false; }
    const int kb = r / nnb, nb = r - kb * nnb;
    tconv_item(W, ldw, n0, dst, Kd, drow0, ksc, scr, kb, nb, lane);
    return true;
}
__device__ __forceinline__ void conv_moe_layer(const Args& a, int l, LAS unsigned char* lds) {
    const int lane = threadIdx.x & 63, wave = threadIdx.x >> 6;
    LAS float* scr = (LAS float*)(lds + wave * 8448);
    const int gw = blockIdx.x * NWAVES + wave, NGW = gridDim.x * NWAVES;
    bf16_t* WGU = (bf16_t*)(a.ws + WS_W_GU); bf16_t* WDN = (bf16_t*)(a.ws + WS_W_DN);
    const float* g = a.in[I_NFFN] + l * D;
    for (int it = gw; it < 3 * 32 * 256; it += NGW) {
        const int kind = it / 8192, r = it - kind * 8192, e = r >> 8, q = r & 255;
        if (kind == 0) { const float* W = a.in[I_MGATE] + ((size_t)l * 32 + e) * (D * DEXP); tconv_item(W, DEXP, 0, WGU + (size_t)e * 1024 * 1024, D, 0, g, scr, q >> 4, q & 15, lane); }
        else if (kind == 1) { const float* W = a.in[I_MUP] + ((size_t)l * 32 + e) * (D * DEXP); tconv_item(W, DEXP, 0, WGU + (size_t)e * 1024 * 1024, D, 512, g, scr, q >> 4, q & 15, lane); }
        else { const float* W = a.in[I_MDOWN] + ((size_t)l * 32 + e) * (DEXP * D); tconv_item(W, D, 0, WDN + (size_t)e * 1024 * 512, DEXP, 0, nullptr, scr, q >> 5, q & 31, lane); }
    }
}
__device__ __forceinline__ void phase_prologue(const Args& a, LAS unsigned char* lds) {
    const int tid = threadIdx.x, lane = tid & 63, wave = tid >> 6;
    LAS float* scr = (LAS float*)(lds + wave * 8448);
    const int gw = blockIdx.x * NWAVES + wave, NGW = gridDim.x * NWAVES;
    unsigned char* ws = a.ws;
    constexpr int NITEMS = 768 + 512 + 512 + 2048 + 1024 + 2 * 512 + 2 * 1024 + 2 * 512;
    for (int it = gw; it < NITEMS; it += NGW) {
        int r = it;
        if (tconv_job(r, a.in[I_ABWIN], INAB, 0, D, 1536, (bf16_t*)(ws + WS_W_IN0), 0, a.in[I_NMIX], scr, lane)) continue;
        if (tconv_job(r, a.in[I_ABWIN], INAB, 1544, D, 1024, (bf16_t*)(ws + WS_W_IN0), 1536, a.in[I_NMIX], scr, lane)) continue;
        if (tconv_job(r, a.in[I_ABWOUT], D, 0, D, D, (bf16_t*)(ws + WS_W_OUT0), 0, nullptr, scr, lane)) continue;
        if (tconv_job(r, a.in[I_CWIN], 2 * CW, 0, D, 2 * CW, (bf16_t*)(ws + WS_W_IN1), 0, a.in[I_NMIX] + D, scr, lane)) continue;
        if (tconv_job(r, a.in[I_CWOUT], D, 0, CW, D, (bf16_t*)(ws + WS_W_OUT1), 0, nullptr, scr, lane)) continue;
        if (tconv_job(r, a.in[I_XWQ], D, 0, D, D, (bf16_t*)(ws + WS_W_Q), 0, a.in[I_NCROSS], scr, lane)) continue;
        if (tconv_job(r, a.in[I_XWQ] + (size_t)D * D, D, 0, D, D, (bf16_t*)(ws + WS_W_Q) + (size_t)D * D, 0, a.in[I_NCROSS] + D, scr, lane)) continue;
        if (tconv_job(r, a.in[I_XWKV], 2 * D, 0, D, 2 * D, (bf16_t*)(ws + WS_W_KV), 0, a.in[I_NMEM], scr, lane)) continue;
        if (tconv_job(r, a.in[I_XWKV] + (size_t)D * 2 * D, 2 * D, 0, D, 2 * D, (bf16_t*)(ws + WS_W_KV) + (size_t)2 * D * D, 0, a.in[I_NMEM] + D, scr, lane)) continue;
        if (tconv_job(r, a.in[I_XWO], D, 0, D, D, (bf16_t*)(ws + WS_W_O), 0, nullptr, scr, lane)) continue;
        tconv_job(r, a.in[I_XWO] + (size_t)D * D, D, 0, D, D, (bf16_t*)(ws + WS_W_O) + (size_t)D * D, 0, nullptr, scr, lane);
    }
    conv_moe_layer(a, 0, lds);
    const int gt = blockIdx.x * NTHREADS + tid, NGT = gridDim.x * NTHREADS;
    for (int i = gt; i < 2 * 256 * D; i += NGT) {
        const int l = i / (256 * D), n = (i / D) & 255, k = i & (D - 1);
        float v = 0.f;
        if (n < 4) v = a.in[I_MWG][((size_t)l * D + k) * 4 + n] * a.in[I_NFFN][l * D + k];
        else if (n < 36) v = a.in[I_MWE][((size_t)l * D + k) * 32 + (n - 4)] * a.in[I_NFFN][l * D + k];
        ((bf16_t*)(ws + WS_W_R))[i] = f2bf(v);
    }
    for (int i = gt; i < CG * CCH * CCH; i += NGT) { const int t = (i >> 7) & 127, s = i & 127; ((bf16_t*)(ws + WS_TRIL))[i] = f2bf(s <= t ? a.in[I_CWS][i] : 0.f); }
    __syncthreads();
    LAS float* wf = (LAS float*)(lds + 73728);
    for (int i = tid; i < D * 8; i += NTHREADS) { const int k = i >> 3, h = i & 7; wf[i] = a.in[I_ABWIN][(size_t)k * INAB + 1536 + h] * a.in[I_NMIX][k]; }
    __syncthreads();
    bf16_t* X = (bf16_t*)(ws + WS_X); float* xstat = (float*)(ws + WS_XSTAT); float* flog = (float*)(ws + WS_FLOG);
    for (int row = gw; row < T; row += NGW) {
        const f32x4* xr = (const f32x4*)(a.in[I_X] + (size_t)row * D) + lane;
        f32x4 v[4]; float ss = 0.f; float fl[8];
#pragma unroll
        for (int h = 0; h < 8; ++h) fl[h] = 0.f;
#pragma unroll
        for (int j = 0; j < 4; ++j) { v[j] = xr[64 * j]; ss += (v[j].x * v[j].x + v[j].y * v[j].y) + (v[j].z * v[j].z + v[j].w * v[j].w); }
#pragma unroll
        for (int j = 0; j < 4; ++j)
#pragma unroll
            for (int e = 0; e < 4; ++e) { const int k = 4 * lane + 256 * j + e; const f32x4 w0 = *(const LAS f32x4*)(wf + k * 8), w1 = *(const LAS f32x4*)(wf + k * 8 + 4);
#pragma unroll
                for (int h = 0; h < 4; ++h) { fl[h] += v[j][e] * w0[h]; fl[4 + h] += v[j][e] * w1[h]; } }
        ss = wave_sum(ss);
#pragma unroll
        for (int h = 0; h < 8; ++h) fl[h] = wave_sum(fl[h]);
        u32x2* o8 = (u32x2*)(X + (size_t)row * D) + lane;
#pragma unroll
        for (int j = 0; j < 4; ++j) { u32x2 o; o.x = pk2(v[j].x, v[j].y); o.y = pk2(v[j].z, v[j].w); o8[64 * j] = o; }
        if (lane < 16) xstat[(size_t)row * 16 + lane] = lane == 0 ? ss : 0.f;
        const float s = rsqrtf(ss * (1.f / D) + EPS);
        if (lane < 8) { float f = fl[0];
#pragma unroll
            for (int h = 1; h < 8; ++h) f = lane == h ? fl[h] : f;
            flog[(size_t)row * 8 + lane] = f * s; }
    }
    bf16_t* MB = (bf16_t*)(ws + WS_MEMB); float* memstat = (float*)(ws + WS_MISC + MISC_MEMSTAT);
    for (int row = gw; row < NB * MEML; row += NGW) {
        const f32x4* xr = (const f32x4*)(a.in[I_MEM] + (size_t)row * D) + lane; float ss = 0.f;
        u32x2* o8 = (u32x2*)(MB + (size_t)row * D) + lane;
#pragma unroll
        for (int j = 0; j < 4; ++j) { const f32x4 v = xr[64 * j]; ss += (v.x * v.x + v.y * v.y) + (v.z * v.z + v.w * v.w); u32x2 o; o.x = pk2(v.x, v.y); o.y = pk2(v.z, v.w); o8[64 * j] = o; }
        ss = wave_sum(ss);
        if (lane == 0) memstat[row] = ss;
    }
}

__device__ __forceinline__ void phase_cumsum(const Args& a, LAS unsigned char* lds) {
    const int tid = threadIdx.x, lane = tid & 63, wave = tid >> 6;
    const float* flog = (const float*)(a.ws + WS_FLOG); float* csum = (float*)(a.ws + WS_CSUM);
    LAS float* wsum = (LAS float*)lds;
    for (int u = blockIdx.x; u < NB * AH; u += gridDim.x) {
        const int b = u >> 3, h = u & 7; const float fb = a.in[I_FBIAS][h];
        float v[8]; float run = 0.f;
#pragma unroll
        for (int j = 0; j < 8; ++j) { const float x = flog[((size_t)b * SEQ + 8 * tid + j) * 8 + h] + fb; const float lf = fminf(x, 0.f) - log1pf(__expf(-fabsf(x))); run += lf; v[j] = run; }
        float inc = run;
#pragma unroll
        for (int o = 1; o < 64; o <<= 1) { const float t = __shfl_up(inc, o); if (lane >= o) inc += t; }
        __syncthreads();
        if (lane == 63) wsum[wave] = inc;
        __syncthreads();
        float base = inc - run;
        for (int w = 0; w < wave; ++w) base += wsum[w];
#pragma unroll
        for (int j = 0; j < 8; ++j) csum[(size_t)u * SEQ + 8 * tid + j] = base + v[j];
    }
}

__device__ __forceinline__ void phase_k2fin(const Args& a) {
    const int lane = threadIdx.x & 63, wave = threadIdx.x >> 6;
    const int gw = blockIdx.x * NWAVES + wave, NGW = gridDim.x * NWAVES;
    bf16_t* K2 = (bf16_t*)(a.ws + WS_K2); const float* k2stat = (const float*)(a.ws + WS_MISC + MISC_K2STAT);
    for (int it = gw; it < 2 * NB * XH * MEML; it += NGW) {
        const int key = it & 255, h = (it >> 8) & 3, b = (it >> 10) & 7, l = it >> 13;
        const f32x4 st = *(const f32x4*)(k2stat + ((size_t)l * 2048 + b * 256 + key) * 16 + 4 * h);
        const float rn = rsqrtf(((st.x + st.y) + (st.z + st.w)) * (1.f / XHD) + EPS);
        u32x2* p = (u32x2*)(K2 + (size_t)it * 256) + lane; const u32x2 v = *p;
        const float* qg = a.in[I_XQG] + l * XHD + 4 * lane; const float* kg = a.in[I_XKG] + l * XHD + 4 * lane;
        u32x2 o; o.x = pk2(bf_lo(v.x) * rn * qg[0] * kg[0], bf_hi(v.x) * rn * qg[1] * kg[1]); o.y = pk2(bf_lo(v.y) * rn * qg[2] * kg[2], bf_hi(v.y) * rn * qg[3] * kg[3]);
        *p = o;
    }
}

__device__ __forceinline__ void lru_unit(const Args& a, LAS unsigned char* lds, int b, int g, int ch, int pass) {
    const int tid = threadIdx.x, c = tid & 63, tq = tid >> 6;
    LAS float* xc = (LAS float*)lds;
    LAS float* wA = (LAS float*)(lds + 33792);
    LAS float* wX = (LAS float*)(lds + 33792 + 16384);
    LAS float* seg = (LAS float*)(lds + 33792 + 32768);
    const bf16_t* XB = (const bf16_t*)(a.ws + WS_ARENA + AR_XB); const bf16_t* GATE = (const bf16_t*)(a.ws + WS_ARENA + AR_GATE);
    bf16_t* AR = (bf16_t*)(a.ws + WS_ARENA + AR_AR); float* lsum = (float*)(a.ws + WS_LSUM);
    const int ch0 = 64 * g + c; const size_t row0 = (size_t)b * SEQ + 128 * ch;
    __syncthreads();
    for (int i = tid; i < 4096; i += NTHREADS) { wA[i] = a.in[I_WA][g * 4096 + i]; wX[i] = a.in[I_WX][g * 4096 + i]; }
    {
        const float w0 = a.in[I_CONVW][0 * BW + ch0], w1 = a.in[I_CONVW][1 * BW + ch0], w2 = a.in[I_CONVW][2 * BW + ch0], w3 = a.in[I_CONVW][3 * BW + ch0], cb = a.in[I_CONVB][ch0];
        float xm3, xm2, xm1; const int tl0 = 16 * tq, s0 = 128 * ch + tl0;
        xm3 = s0 >= 3 ? bf2f(XB[(row0 + tl0 - 3) * BW + ch0]) : 0.f; xm2 = s0 >= 2 ? bf2f(XB[(row0 + tl0 - 2) * BW + ch0]) : 0.f; xm1 = s0 >= 1 ? bf2f(XB[(row0 + tl0 - 1) * BW + ch0]) : 0.f;
#pragma unroll 4
        for (int j = 0; j < 16; ++j) { const float x0 = bf2f(XB[(row0 + tl0 + j) * BW + ch0]); xc[(tl0 + j) * 65 + c] = w0 * xm3 + w1 * xm2 + w2 * xm1 + w3 * x0 + cb; xm3 = xm2; xm2 = xm1; xm1 = x0; }
    }
    __syncthreads();
    float ra[16], rx[16];
#pragma unroll
    for (int j = 0; j < 16; ++j) { ra[j] = 0.f; rx[j] = 0.f; }
    for (int k = 0; k < 64; ++k) { const float wa = wA[k * 64 + c], wx = wX[k * 64 + c];
#pragma unroll
        for (int j = 0; j < 16; ++j) { const float x = xc[(16 * tq + j) * 65 + k]; ra[j] += x * wa; rx[j] += x * wx; } }
    const float ba = a.in[I_BA][ch0], bx = a.in[I_BX][ch0], lam = a.in[I_LAM][ch0];
    const float sp = (lam > 0.f ? 0.f : -lam) + log1pf(__expf(-fabsf(lam)));
    float av[16], bv[16]; float Pp = 1.f, hh = 0.f;
#pragma unroll
    for (int j = 0; j < 16; ++j) { const float r = sigmoidf(ra[j] + ba), ig = sigmoidf(rx[j] + bx); const float la = -8.f * r * sp; const float aa = __expf(la);
        const float beta = sqrtf(fmaxf(-expm1f(2.f * la), 0.f)); av[j] = aa; bv[j] = beta * (ig * xc[(16 * tq + j) * 65 + c]); Pp *= aa; hh = aa * hh + bv[j]; }
    seg[(tq * 64 + c) * 2] = Pp; seg[(tq * 64 + c) * 2 + 1] = hh;
    __syncthreads();
    if (pass == 0) {
        if (tq == 0) { float PA = 1.f, H = 0.f;
            for (int q = 0; q < 8; ++q) { const float pq = seg[(q * 64 + c) * 2], hq = seg[(q * 64 + c) * 2 + 1]; H = pq * H + hq; PA *= pq; }
            float* o = lsum + (((size_t)b * 32 + ch) * BW + ch0) * 2; o[0] = PA; o[1] = H; }
    } else {
        float H = 0.f;
        for (int q = 0; q < ch; ++q) { const float* o = lsum + (((size_t)b * 32 + q) * BW + ch0) * 2; H = o[0] * H + o[1]; }
        for (int q = 0; q < tq; ++q) H = seg[(q * 64 + c) * 2] * H + seg[(q * 64 + c) * 2 + 1];
#pragma unroll
        for (int j = 0; j < 16; ++j) { H = av[j] * H + bv[j]; const size_t row = row0 + 16 * tq + j; AR[row * D + 512 + ch0] = f2bf(bf2f(GATE[row * BW + ch0]) * H); }
    }
}
__device__ __forceinline__ void phase_lru(const Args& a, LAS unsigned char* lds, int pass) {
    for (int u = blockIdx.x; u < NB * 8 * 32; u += gridDim.x) { const int ch = u & 31, g = (u >> 5) & 7, b = u >> 8; lru_unit(a, lds, b, g, ch, pass); }
    __syncthreads();
}

__device__ __forceinline__ void phase_attn_naive(const Args& a) {
    const int tid = threadIdx.x;
    const bf16_t* Q = (const bf16_t*)(a.ws + WS_ARENA + AR_Q); const bf16_t* Kb = (const bf16_t*)(a.ws + WS_ARENA + AR_K); const bf16_t* Vb = (const bf16_t*)(a.ws + WS_ARENA + AR_V);
    bf16_t* AR = (bf16_t*)(a.ws + WS_ARENA + AR_AR); const float* csum = (const float*)(a.ws + WS_CSUM);
    const int NU = NB * AH * (SEQ / NTHREADS);
    for (int i = blockIdx.x; i < NU; i += gridDim.x) {
        const int uu = NU - 1 - i;
        const int qb = uu / (NB * AH), bh = uu % (NB * AH), b = bh >> 3, h = bh & 7;
        const int t = qb * NTHREADS + tid; const size_t row = (size_t)b * SEQ + t;
        u32x4 qp[8]; float o[64];
#pragma unroll
        for (int d8 = 0; d8 < 8; ++d8) qp[d8] = *(const u32x4*)(Q + row * AW + h * HD + 8 * d8);
#pragma unroll
        for (int d = 0; d < 64; ++d) o[d] = 0.f;
        const float* cs = csum + (size_t)bh * SEQ; const float ci = cs[t] * LOG2E;
        float mx = -INFINITY, l = 0.f;
        const int jmax = qb * NTHREADS + (tid | 63);
        for (int j = 0; j <= jmax; ++j) {
            const size_t kr = ((size_t)b * SEQ + j) * AW + h * HD;
            float s = 0.f;
#pragma unroll
            for (int d8 = 0; d8 < 8; ++d8) { const u32x4 v = *(const u32x4*)(Kb + kr + 8 * d8); const u32x4 q = qp[d8];
                s += bf_lo(q.x) * bf_lo(v.x) + bf_hi(q.x) * bf_hi(v.x) + bf_lo(q.y) * bf_lo(v.y) + bf_hi(q.y) * bf_hi(v.y) + bf_lo(q.z) * bf_lo(v.z) + bf_hi(q.z) * bf_hi(v.z) + bf_lo(q.w) * bf_lo(v.w) + bf_hi(q.w) * bf_hi(v.w); }
            s += ci - cs[j] * LOG2E;
            if (j > t) s = -INFINITY;
            const float mn = fmaxf(mx, s); const float sc = exp2f(mx - mn), p = exp2f(s - mn);
            l = l * sc + p; mx = mn;
#pragma unroll
            for (int d8 = 0; d8 < 8; ++d8) { const u32x4 v = *(const u32x4*)(Vb + kr + 8 * d8);
                o[8 * d8] = o[8 * d8] * sc + p * bf_lo(v.x); o[8 * d8 + 1] = o[8 * d8 + 1] * sc + p * bf_hi(v.x); o[8 * d8 + 2] = o[8 * d8 + 2] * sc + p * bf_lo(v.y); o[8 * d8 + 3] = o[8 * d8 + 3] * sc + p * bf_hi(v.y);
                o[8 * d8 + 4] = o[8 * d8 + 4] * sc + p * bf_lo(v.z); o[8 * d8 + 5] = o[8 * d8 + 5] * sc + p * bf_hi(v.z); o[8 * d8 + 6] = o[8 * d8 + 6] * sc + p * bf_lo(v.w); o[8 * d8 + 7] = o[8 * d8 + 7] * sc + p * bf_hi(v.w); }
        }
        const float inv = 1.f / l;
#pragma unroll
        for (int d8 = 0; d8 < 8; ++d8) { u32x4 w; w.x = pk2(o[8 * d8] * inv, o[8 * d8 + 1] * inv); w.y = pk2(o[8 * d8 + 2] * inv, o[8 * d8 + 3] * inv); w.z = pk2(o[8 * d8 + 4] * inv, o[8 * d8 + 5] * inv); w.w = pk2(o[8 * d8 + 6] * inv, o[8 * d8 + 7] * inv);
            *(u32x4*)(AR + row * D + h * HD + 8 * d8) = w; }
    }
}

__device__ __forceinline__ void phase_mix_naive(const Args& a, LAS unsigned char* lds) {
    const int tid = threadIdx.x, lane = tid & 63, wave = tid >> 6;
    LAS float* vt = (LAS float*)lds;
    bf16_t* Ub = (bf16_t*)(a.ws + WS_ARENA + AR_U); const bf16_t* V3 = (const bf16_t*)(a.ws + WS_ARENA + AR_V3); const float* vstat = (const float*)(a.ws + WS_VSTAT);
    const bf16_t* tril = (const bf16_t*)(a.ws + WS_TRIL);
    for (int u = blockIdx.x; u < (T / CCH) * CG; u += gridDim.x) {
        const int g = u & 7, n = u >> 3; const size_t row0 = (size_t)n * CCH;
        __syncthreads();
        for (int i = tid; i < 128 * 64; i += NTHREADS) {
            const int s = i >> 6, c4 = (i & 63) * 4; const size_t row = row0 + s;
            const float* st = vstat + row * 32; float tot = 0.f;
#pragma unroll
            for (int j = 0; j < 32; ++j) tot += st[j];
            const float rs = rsqrtf(tot * (1.f / CW) + EPS);
            const u32x2 v = *(const u32x2*)(V3 + row * CW + 256 * g + c4); const float* gn = a.in[I_CVG] + 256 * g + c4;
            *(LAS f32x4*)(vt + s * 256 + c4) = (f32x4){bf_lo(v.x) * rs * gn[0], bf_hi(v.x) * rs * gn[1], bf_lo(v.y) * rs * gn[2], bf_hi(v.y) * rs * gn[3]};
        }
        __syncthreads();
        for (int tt = 0; tt < 16; ++tt) {
            const int t = wave * 16 + tt; const bf16_t* wrow = tril + ((size_t)g * 128 + t) * 128;
            f32x4 acc = (f32x4){0.f, 0.f, 0.f, 0.f};
            for (int s = 0; s <= t; ++s) { const float w = bf2f(wrow[s]); const f32x4 v = *(const LAS f32x4*)(vt + s * 256 + 4 * lane); acc += v * w; }
            const float bs = a.in[I_CBS][g * 128 + t];
            u32x2* up = (u32x2*)(Ub + (row0 + t) * CW + 256 * g + 4 * lane); const u32x2 uv = *up;
            u32x2 o; o.x = pk2(bf_lo(uv.x) * (acc.x + bs), bf_hi(uv.x) * (acc.y + bs)); o.y = pk2(bf_lo(uv.y) * (acc.z + bs), bf_hi(uv.y) * (acc.w + bs));
            *up = o;
        }
    }
    __syncthreads();
}

__device__ __forceinline__ void phase_route(const Args& a, LAS unsigned char* lds, int l) {
    const int tid = threadIdx.x;
    LAS int* hist = (LAS int*)lds; LAS int* base = hist + 32;
    const float* rlog = (const float*)(a.ws + WS_RLOG); float* pairw = (float*)(a.ws + WS_PAIRW); int* list = (int*)(a.ws + WS_LIST); int* cnt = (int*)(a.ws + WS_CTL) + 64 * l;
    for (int cb = blockIdx.x; cb < T / 256; cb += gridDim.x) {
        __syncthreads();
        if (tid < 32) hist[tid] = 0;
        __syncthreads();
        int e0 = 0, e1 = 0, r0 = 0, r1 = 0; const int tok = cb * 256 + (tid & 255);
        if (tid < 256) {
            const float* lg = rlog + (size_t)tok * 40;
            int gi = 0; float gm = lg[0];
#pragma unroll
            for (int j = 1; j < 4; ++j) if (lg[j] > gm) { gm = lg[j]; gi = j; }
            float gs = 0.f;
#pragma unroll
            for (int j = 0; j < 4; ++j) gs += __expf(lg[j] - gm);
            const float gw = 1.f / gs;
            const float* el = lg + 4 + 8 * gi;
            int i0 = 0; float v0 = el[0];
#pragma unroll
            for (int j = 1; j < 8; ++j) if (el[j] > v0) { v0 = el[j]; i0 = j; }
            int i1 = -1; float v1 = -INFINITY;
#pragma unroll
            for (int j = 0; j < 8; ++j) if (j != i0 && el[j] > v1) { v1 = el[j]; i1 = j; }
            const float ex = __expf(v1 - v0), den = 1.f / (1.f + ex);
            pairw[2 * tok] = gw * den; pairw[2 * tok + 1] = gw * ex * den;
            e0 = gi * 8 + i0; e1 = gi * 8 + i1;
            r0 = atomicAdd((int*)&hist[e0], 1); r1 = atomicAdd((int*)&hist[e1], 1);
        }
        __syncthreads();
        if (tid < 32) base[tid] = hist[tid] ? atomicAdd(&cnt[tid], hist[tid]) : 0;
        __syncthreads();
        if (tid < 256) { list[(size_t)e0 * 65536 + base[e0] + r0] = 2 * tok; list[(size_t)e1 * 65536 + base[e1] + r1] = 2 * tok + 1; }
    }
    __syncthreads();
}

__device__ __forceinline__ void phase_combine(const Args& a, bool last) {
    const int lane = threadIdx.x & 63, wave = threadIdx.x >> 6;
    const int gw = blockIdx.x * NWAVES + wave, NGW = gridDim.x * NWAVES;
    bf16_t* X = (bf16_t*)(a.ws + WS_X); const bf16_t* Y = (const bf16_t*)(a.ws + WS_ARENA + AR_Y); float* xstat = (float*)(a.ws + WS_XSTAT);
    for (int row = gw; row < T; row += NGW) {
        float ss = 0.f;
#pragma unroll
        for (int hlf = 0; hlf < 2; ++hlf) {
            const int c0 = 512 * hlf + 8 * lane;
            const u32x4 xv = *(const u32x4*)(X + (size_t)row * D + c0), y0 = *(const u32x4*)(Y + (size_t)(2 * row) * D + c0), y1 = *(const u32x4*)(Y + (size_t)(2 * row + 1) * D + c0);
            float v[8] = {bf_lo(xv.x), bf_hi(xv.x), bf_lo(xv.y), bf_hi(xv.y), bf_lo(xv.z), bf_hi(xv.z), bf_lo(xv.w), bf_hi(xv.w)};
            const float p[8] = {bf_lo(y0.x), bf_hi(y0.x), bf_lo(y0.y), bf_hi(y0.y), bf_lo(y0.z), bf_hi(y0.z), bf_lo(y0.w), bf_hi(y0.w)};
            const float q[8] = {bf_lo(y1.x), bf_hi(y1.x), bf_lo(y1.y), bf_hi(y1.y), bf_lo(y1.z), bf_hi(y1.z), bf_lo(y1.w), bf_hi(y1.w)};
#pragma unroll
            for (int j = 0; j < 8; ++j) v[j] = (v[j] + p[j]) + q[j];
            if (last) { float* o = a.out + (size_t)row * D + c0; *(f32x4*)o = (f32x4){v[0], v[1], v[2], v[3]}; *(f32x4*)(o + 4) = (f32x4){v[4], v[5], v[6], v[7]}; }
            else { u32x4 w; w.x = pk2(v[0], v[1]); w.y = pk2(v[2], v[3]); w.z = pk2(v[4], v[5]); w.w = pk2(v[6], v[7]); *(u32x4*)(X + (size_t)row * D + c0) = w;
                const float r[8] = {bf_lo(w.x), bf_hi(w.x), bf_lo(w.y), bf_hi(w.y), bf_lo(w.z), bf_hi(w.z), bf_lo(w.w), bf_hi(w.w)};
#pragma unroll
                for (int j = 0; j < 8; ++j) ss += r[j] * r[j]; }
        }
        if (!last) { ss = wave_sum(ss); if (lane < 16) xstat[(size_t)row * 16 + lane] = lane == 0 ? ss : 0.f; }
    }
}

constexpr int NPHASES = 26;
#ifdef ONLY_PHASE
#define PH(k) if (((k) == ONLY_PHASE || (k) == ONLY_PHASE2) && a.ph_lo <= (k) && (k) < a.ph_hi)
#else
#define PH(k) if (a.ph_lo <= (k) && (k) < a.ph_hi)
#endif
#define SYNC(k) do { if ((k) + 1 < a.ph_hi) cg::this_grid().sync(); } while (0)

template <int L> __device__ __forceinline__ void layer_tail(const Args& a, LAS unsigned char* lds, const int base) {
    unsigned char* ws = a.ws; unsigned char* ar = ws + WS_ARENA;
    bf16_t* X = (bf16_t*)(ws + WS_X); float* xstat = (float*)(ws + WS_XSTAT);
    volatile LAS int* tpre = (volatile LAS int*)(lds + 131072);
    PH(base + 0) { PCrossQ p; p.nM = T / 256; p.nN = 4; p.X = X; p.W = (const bf16_t*)(ws + WS_W_Q) + (size_t)L * D * D; p.xstat = xstat; p.Q2 = (bf16_t*)(ar + AR_Q2); p.qstat = (float*)(ws + WS_QSTAT); p.lda = D; p.ldb = D; p.K = D; run_gemm(lds, p); SYNC(base + 0); }
    PH(base + 1) { PCrossS p; p.nM = T / 256; p.nN = 4; p.Q2 = (const bf16_t*)(ar + AR_Q2); p.K2 = (const bf16_t*)(ws + WS_K2) + (size_t)L * 2048 * 1024; p.qstat = (const float*)(ws + WS_QSTAT); p.P = (bf16_t*)(ar + AR_P); p.psum = (float*)(ws + WS_PSUM); p.lda = D; p.ldb = 256; p.K = 256; run_gemm(lds, p); SYNC(base + 1); }
    PH(base + 2) { PCrossPV p; p.nM = T / 256; p.nN = 4; p.P = (const bf16_t*)(ar + AR_P); p.V2T = (const bf16_t*)(ws + WS_V2T) + (size_t)L * 2048 * 1024; p.psum = (const float*)(ws + WS_PSUM); p.O = (bf16_t*)(ar + AR_O); p.lda = D; p.ldb = 256; p.K = 256; run_gemm(lds, p); SYNC(base + 2); }
    PH(base + 3) { PResid p; p.nM = T / 256; p.nN = 4; p.A = (const bf16_t*)(ar + AR_O); p.W = (const bf16_t*)(ws + WS_W_O) + (size_t)L * D * D; p.X = X; p.xstat = xstat; p.lda = D; p.ldb = D; p.K = D; run_gemm(lds, p); SYNC(base + 3); }
    PH(base + 4) { PRouter p; p.nM = T / 256; p.nN = 1; p.X = X; p.W = (const bf16_t*)(ws + WS_W_R) + (size_t)L * 256 * D; p.xstat = xstat; p.bg = a.in[I_MBG] + L * 4; p.be = a.in[I_MBE] + L * 32; p.rlog = (float*)(ws + WS_RLOG); p.lda = D; p.ldb = D; p.K = D; run_gemm(lds, p); SYNC(base + 4); }
    PH(base + 5) { phase_route(a, lds, L); SYNC(base + 5); }
    PH(base + 6) { PMoeUp p; p.cnt = (const int*)(ws + WS_CTL) + 64 * L; p.list = (const int*)(ws + WS_LIST); p.tpre = tpre; p.X = X; p.W = (const bf16_t*)(ws + WS_W_GU); p.xstat = xstat; p.H = (bf16_t*)(ar + AR_H); p.lda = D; p.ldb = D; p.K = D;
        moe_sched_build(p.cnt, tpre); run_gemm(lds, p); SYNC(base + 6); }
    PH(base + 7) { PMoeDown p; p.cnt = (const int*)(ws + WS_CTL) + 64 * L; p.list = (const int*)(ws + WS_LIST); p.tpre = tpre; p.H = (const bf16_t*)(ar + AR_H); p.W = (const bf16_t*)(ws + WS_W_DN); p.pairw = (const float*)(ws + WS_PAIRW); p.Y = (bf16_t*)(ar + AR_Y); p.lda = DEXP; p.ldb = DEXP; p.K = DEXP;
        moe_sched_build(p.cnt, tpre); run_gemm(lds, p); SYNC(base + 7); }
    PH(base + 8) { phase_combine(a, L == 1); SYNC(base + 8); }
}

__global__ void __launch_bounds__(NTHREADS, 2) fwd_kernel(Args a) {
    extern __shared__ __attribute__((aligned(16))) unsigned char lds_raw[];
    LAS unsigned char* lds = (LAS unsigned char*)lds_raw;
    unsigned char* ws = a.ws;
    bf16_t* X = (bf16_t*)(ws + WS_X); float* xstat = (float*)(ws + WS_XSTAT);
    unsigned char* ar = ws + WS_ARENA;
    PH(0) { phase_prologue(a, lds); SYNC(0); }
    PH(1) {
        phase_cumsum(a, lds);
        { PInProj0 p; p.nM = T / 256; p.nN = 10; p.X = X; p.W = (const bf16_t*)(ws + WS_W_IN0); p.xstat = xstat; p.qg = a.in[I_AQG]; p.kg = a.in[I_AKG];
          p.Q = (bf16_t*)(ar + AR_Q); p.Kq = (bf16_t*)(ar + AR_K); p.V = (bf16_t*)(ar + AR_V); p.XB = (bf16_t*)(ar + AR_XB); p.GATE = (bf16_t*)(ar + AR_GATE); p.lda = D; p.ldb = D; p.K = D;
          run_gemm(lds, p); }
        for (int ll = 0; ll < 2; ++ll) {
            PMemKV m; m.nM = 8; m.nN = 8; m.A = (const bf16_t*)(ws + WS_MEMB); m.W = (const bf16_t*)(ws + WS_W_KV) + (size_t)ll * 2 * D * D; m.memstat = (const float*)(ws + WS_MISC + MISC_MEMSTAT);
            m.k2stat = (float*)(ws + WS_MISC + MISC_K2STAT) + (size_t)ll * 2048 * 16; m.K2 = (bf16_t*)(ws + WS_K2) + (size_t)ll * 2048 * 1024; m.V2T = (bf16_t*)(ws + WS_V2T) + (size_t)ll * 2048 * 1024; m.lda = D; m.ldb = D; m.K = D;
            run_gemm(lds, m);
        }
        SYNC(1);
    }
    PH(2) { phase_k2fin(a); phase_lru(a, lds, 0); SYNC(2); }
    PH(3) { phase_lru(a, lds, 1); phase_attn_naive(a); SYNC(3); }
    PH(4) { PResid p; p.nM = T / 256; p.nN = 4; p.A = (const bf16_t*)(ar + AR_AR); p.W = (const bf16_t*)(ws + WS_W_OUT0); p.X = X; p.xstat = xstat; p.lda = D; p.ldb = D; p.K = D; run_gemm(lds, p); SYNC(4); }
    layer_tail<0>(a, lds, 5);
    PH(14) { conv_moe_layer(a, 1, lds);
        PInProj1 p; p.nM = T / 256; p.nN = 16; p.X = X; p.W = (const bf16_t*)(ws + WS_W_IN1); p.xstat = xstat; p.bias = a.in[I_CBIN]; p.Ub = (bf16_t*)(ar + AR_U); p.V3 = (bf16_t*)(ar + AR_V3); p.vstat = (float*)(ws + WS_VSTAT); p.lda = D; p.ldb = D; p.K = D;
        __syncthreads(); run_gemm(lds, p); SYNC(14); }
    PH(15) { phase_mix_naive(a, lds); SYNC(15); }
    PH(16) { PResid p; p.nM = T / 256; p.nN = 4; p.A = (const bf16_t*)(ar + AR_U); p.W = (const bf16_t*)(ws + WS_W_OUT1); p.X = X; p.xstat = xstat; p.lda = CW; p.ldb = CW; p.K = CW; run_gemm(lds, p); SYNC(16); }
    layer_tail<1>(a, lds, 17);
}

extern "C" void kernel_launch(void* const* d_in, const int* in_sizes, int n_in, void* d_out, int out_size, void* d_ws, size_t ws_size, hipStream_t stream) {
    static int grid = 0;
    if (grid == 0) {
        if (n_in != 36 || out_size != T * D || ws_size < WS_END) { fprintf(stderr, "kernel_launch: unexpected sizes n_in %d out %d ws %zu\n", n_in, out_size, ws_size); grid = -1; return; }
        int dev = 0, cus = 0, per_cu = 0;
        hipGetDevice(&dev); hipDeviceGetAttribute(&cus, hipDeviceAttributeMultiprocessorCount, dev);
        hipFuncSetAttribute((const void*)fwd_kernel, hipFuncAttributeMaxDynamicSharedMemorySize, LDS_BYTES);
        hipOccupancyMaxActiveBlocksPerMultiprocessor(&per_cu, (const void*)fwd_kernel, NTHREADS, LDS_BYTES);
        if (per_cu < 1) { fprintf(stderr, "kernel_launch: occupancy query says %d blocks per CU\n", per_cu); per_cu = 1; }
        (void)hipGetLastError();
        grid = cus;
    }
    if (grid < 0) return;
    hipMemsetAsync((char*)d_ws + WS_CTL, 0, 4096, stream);
    Args a{};
    for (int i = 0; i < 36; ++i) a.in[i] = (const float*)d_in[i];
    a.out = (float*)d_out; a.ws = (unsigned char*)d_ws;
#if ONE_LAUNCH
    a.ph_lo = 0; a.ph_hi = NPHASES;
    void* args[] = {&a};
    hipError_t e = hipLaunchCooperativeKernel((const void*)fwd_kernel, dim3(grid), dim3(NTHREADS), args, LDS_BYTES, stream);
    if (e != hipSuccess) fprintf(stderr, "cooperative launch failed: %s (grid %d)\n", hipGetErrorString(e), grid);
#else
    for (int ph = 0; ph < NPHASES; ++ph) { a.ph_lo = ph; a.ph_hi = ph + 1; hipLaunchKernelGGL(fwd_kernel, dim3(grid), dim3(NTHREADS), LDS_BYTES, stream, a); }
#endif
}
```

```cpp
#include <hip/hip_runtime.h>
#include <hip/hip_cooperative_groups.h>
#include <cstdint>
#include <cstdio>
namespace cg = cooperative_groups;

#ifndef FAST_CORE
#define FAST_CORE 1
#endif
#ifndef ONLY_PHASE2
#define ONLY_PHASE2 -1
#endif
#ifndef ONE_LAUNCH
#define ONE_LAUNCH 1
#endif

#define LAS __attribute__((address_space(3)))
typedef unsigned short bf16_t;
typedef short bf16x8 __attribute__((ext_vector_type(8)));
typedef float f32x4 __attribute__((ext_vector_type(4)));
typedef float f32x2 __attribute__((ext_vector_type(2)));
typedef unsigned u32x4 __attribute__((ext_vector_type(4)));
typedef unsigned u32x2 __attribute__((ext_vector_type(2)));

constexpr int NB = 8, SEQ = 4096, T = NB * SEQ, D = 1024;
constexpr int AH = 8, HD = 64, AW = 512, BW = 512;
constexpr int INAB = 2568;
constexpr int CW = 2048, CG = 8, CCH = 128;
constexpr int MEML = 256, XH = 4, XHD = 256;
constexpr int NGRP = 4, EPG = 8, NEXP = 32, DEXP = 512;
constexpr float EPS = 1e-6f;
constexpr float LOG2E = 1.4426950408889634f;
constexpr float C2 = 0.125f * LOG2E;
constexpr float C3 = 0.0625f * LOG2E;
constexpr int NTHREADS = 512, NWAVES = 8;
constexpr int LDS_BYTES = 147456;

constexpr size_t MiB = 1ull << 20;
constexpr size_t WS_CTL = 0;
constexpr size_t WS_W_IN0 = 1 * MiB, WS_W_OUT0 = 6 * MiB, WS_W_IN1 = 8 * MiB, WS_W_OUT1 = 16 * MiB;
constexpr size_t WS_W_Q = 20 * MiB, WS_W_KV = 24 * MiB, WS_W_O = 32 * MiB, WS_W_R = 36 * MiB, WS_TRIL = 37 * MiB;
constexpr size_t WS_W_GU = 38 * MiB, WS_W_DN = 102 * MiB;
constexpr size_t WS_X = 134 * MiB, WS_MEMB = 198 * MiB, WS_K2 = 202 * MiB, WS_V2T = 210 * MiB;
constexpr size_t WS_XSTAT = 218 * MiB, WS_VSTAT = 220 * MiB, WS_QSTAT = 224 * MiB, WS_PSUM = 226 * MiB;
constexpr size_t WS_FLOG = 228 * MiB, WS_CSUM = 229 * MiB, WS_LSUM = 230 * MiB, WS_MISC = 231 * MiB;
constexpr size_t WS_RLOG = 232 * MiB, WS_PAIRW = 238 * MiB, WS_LIST = 239 * MiB, WS_ARENA = 248 * MiB, WS_END = 504 * MiB;
constexpr size_t AR_Q = 0, AR_K = 32 * MiB, AR_V = 64 * MiB, AR_XB = 96 * MiB, AR_GATE = 128 * MiB, AR_AR = 160 * MiB;
constexpr size_t AR_V2TMP = 224 * MiB;
constexpr size_t AR_Q2 = 0, AR_P = 64 * MiB, AR_O = 128 * MiB;
constexpr size_t AR_H = 0, AR_Y = 64 * MiB;
constexpr size_t AR_U = 0, AR_V3 = 128 * MiB;
constexpr size_t MISC_MEMSTAT = 0, MISC_K2STAT = 65536;

struct Args { const float* in[36]; float* out; unsigned char* ws; int ph_lo, ph_hi; };
enum { I_X = 0, I_MEM, I_NMIX, I_NCROSS, I_NMEM, I_NFFN, I_ABWIN, I_FBIAS, I_AQG, I_AKG, I_CONVW, I_CONVB, I_WA, I_BA, I_WX, I_BX, I_LAM, I_ABWOUT,
       I_CWIN, I_CBIN, I_CVG, I_CWS, I_CBS, I_CWOUT, I_XWQ, I_XWKV, I_XWO, I_XQG, I_XKG, I_MWG, I_MBG, I_MWE, I_MBE, I_MGATE, I_MUP, I_MDOWN };

__device__ __forceinline__ float bf_lo(unsigned u) { return __uint_as_float(u << 16); }
__device__ __forceinline__ float bf_hi(unsigned u) { return __uint_as_float(u & 0xffff0000u); }
__device__ __forceinline__ float bf2f(bf16_t v) { return __uint_as_float((unsigned)v << 16); }
__device__ __forceinline__ unsigned pk2(float lo, float hi) { typedef __bf16 bf2_t __attribute__((ext_vector_type(2))); f32x2 v = {lo, hi}; bf2_t b = __builtin_convertvector(v, bf2_t); return __builtin_bit_cast(unsigned, b); }
__device__ __forceinline__ bf16_t f2bf(float f) { return (bf16_t)(pk2(f, 0.f) & 0xffffu); }
__device__ __forceinline__ float wave_sum(float v) {
#pragma unroll
    for (int o = 1; o < 64; o <<= 1) v += __shfl_xor(v, o);
    return v;
}
__device__ __forceinline__ float gelu_tanh(float x) { const float u = 0.7978845608028654f * (x + 0.044715f * x * x * x); return x / (1.f + __expf(-2.f * u)); }
__device__ __forceinline__ float sigmoidf(float x) { return 1.f / (1.f + __expf(-x)); }
__device__ __forceinline__ float sum16(const float* p) { const f32x4 a = *(const f32x4*)p, b = *(const f32x4*)(p + 4), c = *(const f32x4*)(p + 8), d = *(const f32x4*)(p + 12);
    return ((a.x + a.y) + (a.z + a.w)) + ((b.x + b.y) + (b.z + b.w)) + ((c.x + c.y) + (c.z + c.w)) + ((d.x + d.y) + (d.z + d.w)); }
__device__ __forceinline__ int perm32(int rho) { const int n = rho >> 4, i = rho & 15; return 8 * (i >> 2) + 4 * n + (i & 3); }

struct U { int pm, pn, e, cnt; };
__device__ __forceinline__ int brow_std(int bj, int S) { return 64 * (S >> 5) + 32 * bj + perm32(S & 31); }
typedef f32x4 Acc[2][2][4][2];

template <class P> __device__ __forceinline__ void gemm_naive(const P& p) {
    const int tid = threadIdx.x, wid = tid >> 6, lane = tid & 63, wr = wid >> 2, wc = wid & 3, fr = lane & 15, fq = lane >> 4;
    for (int i = 0;; ++i) {
        U u; if (!p.unit(i * (int)gridDim.x + (int)blockIdx.x, u)) break;
        Acc acc;
#pragma unroll
        for (int a = 0; a < 2; ++a)
#pragma unroll
            for (int b = 0; b < 2; ++b)
#pragma unroll
                for (int m = 0; m < 4; ++m)
#pragma unroll
                    for (int n = 0; n < 2; ++n) acc[a][b][m][n] = (f32x4){0.f, 0.f, 0.f, 0.f};
        const bf16_t* A = p.a_ptr(u); const bf16_t* B = p.b_ptr(u); const int lda = p.lda, ldb = p.ldb, K = p.K;
        unsigned aoff[8], boff[16];
#pragma unroll
        for (int ai = 0; ai < 2; ++ai)
#pragma unroll
            for (int m = 0; m < 4; ++m) aoff[ai * 4 + m] = (unsigned)p.a_row(u, 128 * ai + 64 * wr + 16 * m + fr) * (unsigned)lda;
#pragma unroll
        for (int bj = 0; bj < 2; ++bj)
#pragma unroll
            for (int n = 0; n < 2; ++n)
#pragma unroll
                for (int e = 0; e < 4; ++e) boff[bj * 8 + n * 4 + e] = (unsigned)P::b_row(bj, 32 * wc + 16 * n + 4 * fq + e) * (unsigned)ldb;
        for (int k0 = 0; k0 < K; k0 += 2) {
            float af[8][2];
#pragma unroll
            for (int r = 0; r < 8; ++r) { const unsigned v = *(const unsigned*)(A + aoff[r] + k0); af[r][0] = bf_lo(v); af[r][1] = bf_hi(v); }
#pragma unroll
            for (int bj = 0; bj < 2; ++bj)
#pragma unroll
                for (int n = 0; n < 2; ++n)
#pragma unroll
                    for (int e = 0; e < 4; ++e) {
                        const unsigned v = *(const unsigned*)(B + boff[bj * 8 + n * 4 + e] + k0);
                        const float b0 = bf_lo(v), b1 = bf_hi(v);
#pragma unroll
                        for (int ai = 0; ai < 2; ++ai)
#pragma unroll
                            for (int m = 0; m < 4; ++m) { const float* x = af[ai * 4 + m]; acc[ai][bj][m][n][e] += x[0] * b0 + x[1] * b1; }
                    }
        }
        p.epi(acc, u, wr, wc, fr, fq);
    }
}

struct PlainSched {
    int nM, nN;
    __device__ __forceinline__ bool unit(int L, U& u) const { if (L >= nM * nN) return false; u.pm = L / nN; u.pn = L - u.pm * nN; u.e = 0; u.cnt = 0; return true; }
};

struct PInProj0 : PlainSched {
    static constexpr bool GATHER = false; static constexpr int ID = 0;
    const bf16_t* X; const bf16_t* W; const float* xstat; const float* qg; const float* kg; bf16_t *Q, *Kq, *V, *XB, *GATE; int lda, ldb, K;
    __device__ __forceinline__ const bf16_t* a_ptr(const U& u) const { return X + (size_t)u.pm * 256 * D; }
    __device__ __forceinline__ int a_row(const U&, int R) const { return R; }
    __device__ __forceinline__ const bf16_t* b_ptr(const U& u) const { return W + (size_t)u.pn * 256 * D; }
    static __device__ __forceinline__ int b_row(int bj, int S) { return brow_std(bj, S); }
    __device__ __forceinline__ void epi(Acc& acc, const U& u, int wr, int wc, int fr, int fq) const {
        const int kind = u.pn >> 1, half = u.pn & 1;
        bf16_t* dst = kind == 0 ? Q : kind == 1 ? Kq : kind == 2 ? V : kind == 3 ? XB : GATE;
        const float* gain = kind == 0 ? qg : kg;
        float sc[8];
#pragma unroll
        for (int ai = 0; ai < 2; ++ai)
#pragma unroll
            for (int m = 0; m < 4; ++m) {
                const int row = u.pm * 256 + 128 * ai + 64 * wr + 16 * m + fr;
                const float s = rsqrtf(sum16(xstat + (size_t)row * 16) * (1.f / D) + EPS);
                float r = s;
                if (kind <= 1) {
                    float ss = 0.f;
#pragma unroll
                    for (int bj = 0; bj < 2; ++bj)
#pragma unroll
                        for (int n = 0; n < 2; ++n)
#pragma unroll
                            for (int e = 0; e < 4; ++e) { const float v = acc[ai][bj][m][n][e] * s; ss += v * v; }
                    ss += __shfl_xor(ss, 16); ss += __shfl_xor(ss, 32);
                    r = s * rsqrtf(ss * (1.f / HD) + EPS) * (kind == 0 ? C2 : 1.f);
                }
                sc[ai * 4 + m] = r;
            }
#pragma unroll
        for (int bj = 0; bj < 2; ++bj) {
            float g[8];
#pragma unroll
            for (int j = 0; j < 8; ++j) g[j] = kind <= 1 ? gain[32 * bj + 8 * fq + j] : 1.f;
#pragma unroll
            for (int ai = 0; ai < 2; ++ai)
#pragma unroll
                for (int m = 0; m < 4; ++m) {
                    const int row = u.pm * 256 + 128 * ai + 64 * wr + 16 * m + fr;
                    float v[8];
#pragma unroll
                    for (int j = 0; j < 8; ++j) v[j] = acc[ai][bj][m][j >> 2][j & 3] * sc[ai * 4 + m] * g[j];
                    if (kind == 4) {
#pragma unroll
                        for (int j = 0; j < 8; ++j) v[j] = gelu_tanh(v[j]);
                    }
                    u32x4 w; w.x = pk2(v[0], v[1]); w.y = pk2(v[2], v[3]); w.z = pk2(v[4], v[5]); w.w = pk2(v[6], v[7]);
                    *(u32x4*)(dst + (size_t)row * 512 + 256 * half + 64 * wc + 32 * bj + 8 * fq) = w;
                }
        }
    }
};

struct PMemKV : PlainSched {
    static constexpr bool GATHER = false; static constexpr int ID = 1;
    const bf16_t* A; const bf16_t* W; const float* memstat; float* k2stat_; bf16_t* K2_; bf16_t* V2T_; int lda, ldb, K;
    __device__ __forceinline__ const bf16_t* a_ptr(const U& u) const { return A + (size_t)u.pm * 256 * D; }
    __device__ __forceinline__ int a_row(const U&, int R) const { return R; }
    __device__ __forceinline__ const bf16_t* b_ptr(const U& u) const { return W + (size_t)u.pn * 256 * D; }
    static __device__ __forceinline__ int b_row(int bj, int S) { return brow_std(bj, S); }
    __device__ __forceinline__ void epi(Acc& acc, const U& u, int wr, int wc, int fr, int fq) const {
        const int b = u.pm, h = u.pn & 3, ly = u.pn >> 3; const bool isv = (u.pn & 4) != 0;
        float* k2stat = k2stat_ + (size_t)ly * 2048 * 16; bf16_t* K2 = K2_ + (size_t)ly * 2048 * 1024; bf16_t* V2T = V2T_ + (size_t)ly * 2048 * 1024;
        bf16_t* dst = (isv ? V2T : K2) + (size_t)(b * 4 + h) * 65536;
        int lrow = 64 * wr + fr; asm volatile("" : "+v"(lrow));
#pragma unroll
        for (int ai = 0; ai < 2; ++ai)
#pragma unroll
            for (int m = 0; m < 4; ++m) {
                const int key = 128 * ai + 16 * m + lrow, row = b * 256 + key;
                const float s = rsqrtf(memstat[row] * (1.f / D) + EPS);
                float ss = 0.f;
#pragma unroll
                for (int bj = 0; bj < 2; ++bj) {
                    float v[8];
#pragma unroll
                    for (int j = 0; j < 8; ++j) { v[j] = acc[ai][bj][m][j >> 2][j & 3] * s; ss += v[j] * v[j]; }
                    u32x4 w; w.x = pk2(v[0], v[1]); w.y = pk2(v[2], v[3]); w.z = pk2(v[4], v[5]); w.w = pk2(v[6], v[7]);
                    *(u32x4*)(dst + (size_t)key * 256 + 64 * wc + 32 * bj + 8 * fq) = w;
                }
                ss += __shfl_xor(ss, 16); ss += __shfl_xor(ss, 32);
                if (fq == 0 && !isv) k2stat[(size_t)row * 16 + 4 * h + wc] = ss;
            }
    }
};

struct PResid : PlainSched {
    static constexpr bool GATHER = false; static constexpr int ID = 2;
    const bf16_t* A; const bf16_t* W; bf16_t* X; float* xstat; int lda, ldb, K;
    __device__ __forceinline__ const bf16_t* a_ptr(const U& u) const { return A + (size_t)u.pm * 256 * lda; }
    __device__ __forceinline__ int a_row(const U&, int R) const { return R; }
    __device__ __forceinline__ const bf16_t* b_ptr(const U& u) const { return W + (size_t)u.pn * 256 * ldb; }
    static __device__ __forceinline__ int b_row(int bj, int S) { return brow_std(bj, S); }
    __device__ __forceinline__ void epi(Acc& acc, const U& u, int wr, int wc, int fr, int fq) const {
#pragma unroll
        for (int ai = 0; ai < 2; ++ai)
#pragma unroll
            for (int m = 0; m < 4; ++m) {
                const int row = u.pm * 256 + 128 * ai + 64 * wr + 16 * m + fr; float ss = 0.f;
#pragma unroll
                for (int bj = 0; bj < 2; ++bj) {
                    bf16_t* xp = X + (size_t)row * D + 256 * u.pn + 64 * wc + 32 * bj + 8 * fq;
                    const u32x4 o = *(const u32x4*)xp;
                    float v[8] = {bf_lo(o.x), bf_hi(o.x), bf_lo(o.y), bf_hi(o.y), bf_lo(o.z), bf_hi(o.z), bf_lo(o.w), bf_hi(o.w)};
#pragma unroll
                    for (int n = 0; n < 2; ++n)
#pragma unroll
                        for (int e = 0; e < 4; ++e) v[n * 4 + e] += acc[ai][bj][m][n][e];
                    u32x4 w; w.x = pk2(v[0], v[1]); w.y = pk2(v[2], v[3]); w.z = pk2(v[4], v[5]); w.w = pk2(v[6], v[7]);
                    *(u32x4*)xp = w;
                    const float r[8] = {bf_lo(w.x), bf_hi(w.x), bf_lo(w.y), bf_hi(w.y), bf_lo(w.z), bf_hi(w.z), bf_lo(w.w), bf_hi(w.w)};
#pragma unroll
                    for (int j = 0; j < 8; ++j) ss += r[j] * r[j];
                }
                ss += __shfl_xor(ss, 16); ss += __shfl_xor(ss, 32);
                if (fq == 0) xstat[(size_t)row * 16 + 4 * u.pn + wc] = ss;
            }
    }
};

struct PCrossQ : PlainSched {
    static constexpr bool GATHER = false; static constexpr int ID = 3;
    const bf16_t* X; const bf16_t* W; const float* xstat; bf16_t* Q2; float* qstat; int lda, ldb, K;
    __device__ __forceinline__ const bf16_t* a_ptr(const U& u) const { return X + (size_t)u.pm * 256 * D; }
    __device__ __forceinline__ int a_row(const U&, int R) const { return R; }
    __device__ __forceinline__ const bf16_t* b_ptr(const U& u) const { return W + (size_t)u.pn * 256 * D; }
    static __device__ __forceinline__ int b_row(int bj, int S) { return brow_std(bj, S); }
    __device__ __forceinline__ void epi(Acc& acc, const U& u, int wr, int wc, int fr, int fq) const {
#pragma unroll
        for (int ai = 0; ai < 2; ++ai)
#pragma unroll
            for (int m = 0; m < 4; ++m) {
                const int row = u.pm * 256 + 128 * ai + 64 * wr + 16 * m + fr; float ss = 0.f;
                const float s = rsqrtf(sum16(xstat + (size_t)row * 16) * (1.f / D) + EPS);
#pragma unroll
                for (int bj = 0; bj < 2; ++bj) {
                    float v[8];
#pragma unroll
                    for (int n = 0; n < 2; ++n)
#pragma unroll
                        for (int e = 0; e < 4; ++e) v[n * 4 + e] = acc[ai][bj][m][n][e] * s;
                    u32x4 w; w.x = pk2(v[0], v[1]); w.y = pk2(v[2], v[3]); w.z = pk2(v[4], v[5]); w.w = pk2(v[6], v[7]);
                    *(u32x4*)(Q2 + (size_t)row * D + 256 * u.pn + 64 * wc + 32 * bj + 8 * fq) = w;
                    const float r[8] = {bf_lo(w.x), bf_hi(w.x), bf_lo(w.y), bf_hi(w.y), bf_lo(w.z), bf_hi(w.z), bf_lo(w.w), bf_hi(w.w)};
#pragma unroll
                    for (int j = 0; j < 8; ++j) ss += r[j] * r[j];
                }
                ss += __shfl_xor(ss, 16); ss += __shfl_xor(ss, 32);
                if (fq == 0) qstat[(size_t)row * 16 + 4 * u.pn + wc] = ss;
            }
    }
};

struct PCrossS : PlainSched {
    static constexpr bool GATHER = false; static constexpr int ID = 4;
    const bf16_t* Q2; const bf16_t* K2; const float* qstat; bf16_t* P; float* psum; int lda, ldb, K;
    __device__ __forceinline__ const bf16_t* a_ptr(const U& u) const { return Q2 + (size_t)u.pm * 256 * D + 256 * u.pn; }
    __device__ __forceinline__ int a_row(const U&, int R) const { return R; }
    __device__ __forceinline__ const bf16_t* b_ptr(const U& u) const { return K2 + (size_t)((u.pm >> 4) * 4 + u.pn) * 65536; }
    static __device__ __forceinline__ int b_row(int bj, int S) { return brow_std(bj, S); }
    __device__ __forceinline__ void epi(Acc& acc, const U& u, int wr, int wc, int fr, int fq) const {
#pragma unroll
        for (int ai = 0; ai < 2; ++ai)
#pragma unroll
            for (int m = 0; m < 4; ++m) {
                const int row = u.pm * 256 + 128 * ai + 64 * wr + 16 * m + fr; float ss = 0.f;
                const f32x4 qs = *(const f32x4*)(qstat + (size_t)row * 16 + 4 * u.pn);
                const float rn = rsqrtf(((qs.x + qs.y) + (qs.z + qs.w)) * (1.f / XHD) + EPS) * C3;
#pragma unroll
                for (int bj = 0; bj < 2; ++bj) {
                    float v[8];
#pragma unroll
                    for (int n = 0; n < 2; ++n)
#pragma unroll
                        for (int e = 0; e < 4; ++e) v[n * 4 + e] = exp2f(acc[ai][bj][m][n][e] * rn);
                    u32x4 w; w.x = pk2(v[0], v[1]); w.y = pk2(v[2], v[3]); w.z = pk2(v[4], v[5]); w.w = pk2(v[6], v[7]);
                    *(u32x4*)(P + (size_t)row * D + 256 * u.pn + 64 * wc + 32 * bj + 8 * fq) = w;
                    const float r[8] = {bf_lo(w.x), bf_hi(w.x), bf_lo(w.y), bf_hi(w.y), bf_lo(w.z), bf_hi(w.z), bf_lo(w.w), bf_hi(w.w)};
#pragma unroll
                    for (int j = 0; j < 8; ++j) ss += r[j];
                }
                ss += __shfl_xor(ss, 16); ss += __shfl_xor(ss, 32);
                if (fq == 0) psum[(size_t)row * 16 + 4 * u.pn + wc] = ss;
            }
    }
};

struct PCrossPV : PlainSched {
    static constexpr bool GATHER = false; static constexpr int ID = 5;
    const bf16_t* P; const bf16_t* V2T; const float* psum; bf16_t* O; int lda, ldb, K;
    __device__ __forceinline__ const bf16_t* a_ptr(const U& u) const { return P + (size_t)u.pm * 256 * D + 256 * u.pn; }
    __device__ __forceinline__ int a_row(const U&, int R) const { return R; }
    __device__ __forceinline__ const bf16_t* b_ptr(const U& u) const { return V2T + (size_t)((u.pm >> 4) * 4 + u.pn) * 65536; }
    static __device__ __forceinline__ int b_row(int bj, int S) { return brow_std(bj, S); }
    __device__ __forceinline__ void epi(Acc& acc, const U& u, int wr, int wc, int fr, int fq) const {
#pragma unroll
        for (int ai = 0; ai < 2; ++ai)
#pragma unroll
            for (int m = 0; m < 4; ++m) {
                const int row = u.pm * 256 + 128 * ai + 64 * wr + 16 * m + fr;
                const f32x4 ps = *(const f32x4*)(psum + (size_t)row * 16 + 4 * u.pn);
                const float inv = 1.f / ((ps.x + ps.y) + (ps.z + ps.w));
#pragma unroll
                for (int bj = 0; bj < 2; ++bj) {
                    float v[8];
#pragma unroll
                    for (int n = 0; n < 2; ++n)
#pragma unroll
                        for (int e = 0; e < 4; ++e) v[n * 4 + e] = acc[ai][bj][m][n][e] * inv;
                    u32x4 w; w.x = pk2(v[0], v[1]); w.y = pk2(v[2], v[3]); w.z = pk2(v[4], v[5]); w.w = pk2(v[6], v[7]);
                    *(u32x4*)(O + (size_t)row * D + 256 * u.pn + 64 * wc + 32 * bj + 8 * fq) = w;
                }
            }
    }
};

struct PRouter : PlainSched {
    static constexpr bool GATHER = false; static constexpr int ID = 6;
    const bf16_t* X; const bf16_t* W; const float* xstat; const float* bg; const float* be; float* rlog; int lda, ldb, K;
    __device__ __forceinline__ const bf16_t* a_ptr(const U& u) const { return X + (size_t)u.pm * 256 * D; }
    __device__ __forceinline__ int a_row(const U&, int R) const { return R; }
    __device__ __forceinline__ const bf16_t* b_ptr(const U&) const { return W; }
    static __device__ __forceinline__ int b_row(int bj, int S) { return brow_std(bj, S); }
    __device__ __forceinline__ void epi(Acc& acc, const U& u, int wr, int wc, int fr, int fq) const {
        if (wc != 0) return;
#pragma unroll
        for (int ai = 0; ai < 2; ++ai)
#pragma unroll
            for (int m = 0; m < 4; ++m) {
                const int row = u.pm * 256 + 128 * ai + 64 * wr + 16 * m + fr;
                const float s = rsqrtf(sum16(xstat + (size_t)row * 16) * (1.f / D) + EPS);
#pragma unroll
                for (int n = 0; n < 2; ++n)
#pragma unroll
                    for (int e = 0; e < 4; ++e) { const int c = 8 * fq + 4 * n + e; rlog[(size_t)row * 40 + c] = acc[ai][0][m][n][e] * s + (c < 4 ? bg[c] : be[c - 4]); }
                if (fq == 0) {
#pragma unroll
                    for (int e = 0; e < 4; ++e) rlog[(size_t)row * 40 + 32 + e] = acc[ai][1][m][0][e] * s + be[28 + e];
                }
            }
    }
};

struct MoeSched {
    const int* cnt; const int* list; volatile LAS int* tpre;
    __device__ __forceinline__ bool unit(int L, U& u) const {
        const int mt = L >> 2; if (mt >= tpre[32]) return false;
        int e = 0;
        for (int j = 1; j < 32; ++j) e = (mt >= tpre[j]) ? j : e;
        u.e = e; u.pm = mt - tpre[e]; u.pn = L & 3; u.cnt = cnt[e]; return true;
    }
    __device__ __forceinline__ int pair_of(const U& u, int R) const { int s = u.pm * 256 + R; s = s < u.cnt ? s : u.cnt - 1; return list[(size_t)u.e * 65536 + s]; }
};
__device__ __forceinline__ void moe_sched_build(const int* cnt, volatile LAS int* tpre) {
    __syncthreads();
    if (threadIdx.x == 0) { int acc = 0; for (int e = 0; e < 32; ++e) { tpre[e] = acc; acc += (cnt[e] + 255) >> 8; } tpre[32] = acc; }
    __syncthreads();
}
struct PMoeUp : MoeSched {
    static constexpr bool GATHER = true; static constexpr int ID = 7;
    const bf16_t* X; const bf16_t* W; const float* xstat; bf16_t* H; int lda, ldb, K;
    __device__ __forceinline__ const bf16_t* a_ptr(const U&) const { return X; }
    __device__ __forceinline__ int a_row(const U& u, int R) const { return pair_of(u, R) >> 1; }
    __device__ __forceinline__ const bf16_t* b_ptr(const U& u) const { return W + (size_t)u.e * (1024 * 1024) + (size_t)u.pn * 128 * 1024; }
    static __device__ __forceinline__ int b_row(int bj, int S) { return 512 * bj + 32 * (S >> 5) + perm32(S & 31); }
    __device__ __forceinline__ void epi(Acc& acc, const U& u, int wr, int wc, int fr, int fq) const {
#pragma unroll
        for (int ai = 0; ai < 2; ++ai)
#pragma unroll
            for (int m = 0; m < 4; ++m) {
                const int pr = pair_of(u, 128 * ai + 64 * wr + 16 * m + fr), tok = pr >> 1;
                const float s = rsqrtf(sum16(xstat + (size_t)tok * 16) * (1.f / D) + EPS);
                float v[8];
#pragma unroll
                for (int n = 0; n < 2; ++n)
#pragma unroll
                    for (int e = 0; e < 4; ++e) { const float g = acc[ai][0][m][n][e] * s, up = acc[ai][1][m][n][e] * s; v[n * 4 + e] = g / (1.f + __expf(-g)) * up; }
                u32x4 w; w.x = pk2(v[0], v[1]); w.y = pk2(v[2], v[3]); w.z = pk2(v[4], v[5]); w.w = pk2(v[6], v[7]);
                *(u32x4*)(H + (size_t)pr * DEXP + 128 * u.pn + 32 * wc + 8 * fq) = w;
            }
    }
};
struct PMoeDown : MoeSched {
    static constexpr bool GATHER = true; static constexpr int ID = 8;
    const bf16_t* H; const bf16_t* W; const float* pairw; bf16_t* Y; int lda, ldb, K;
    __device__ __forceinline__ const bf16_t* a_ptr(const U&) const { return H; }
    __device__ __forceinline__ int a_row(const U& u, int R) const { return pair_of(u, R); }
    __device__ __forceinline__ const bf16_t* b_ptr(const U& u) const { return W + (size_t)u.e * (1024 * 512) + (size_t)u.pn * 256 * 512; }
    static __device__ __forceinline__ int b_row(int bj, int S) { return brow_std(bj, S); }
    __device__ __forceinline__ void epi(Acc& acc, const U& u, int wr, int wc, int fr, int fq) const {
#pragma unroll
        for (int ai = 0; ai < 2; ++ai)
#pragma unroll
            for (int m = 0; m < 4; ++m) {
                const int pr = pair_of(u, 128 * ai + 64 * wr + 16 * m + fr); const float wgt = pairw[pr];
#pragma unroll
                for (int bj = 0; bj < 2; ++bj) {
                    float v[8];
#pragma unroll
                    for (int n = 0; n < 2; ++n)
#pragma unroll
                        for (int e = 0; e < 4; ++e) v[n * 4 + e] = acc[ai][bj][m][n][e] * wgt;
                    u32x4 w; w.x = pk2(v[0], v[1]); w.y = pk2(v[2], v[3]); w.z = pk2(v[4], v[5]); w.w = pk2(v[6], v[7]);
                    *(u32x4*)(Y + (size_t)pr * D + 256 * u.pn + 64 * wc + 32 * bj + 8 * fq) = w;
                }
            }
    }
};
struct PInProj1 : PlainSched {
    static constexpr bool GATHER = false; static constexpr int ID = 9;
    const bf16_t* X; const bf16_t* W; const float* xstat; const float* bias; bf16_t* Ub; bf16_t* V3; float* vstat; int lda, ldb, K;
    __device__ __forceinline__ const bf16_t* a_ptr(const U& u) const { return X + (size_t)u.pm * 256 * D; }
    __device__ __forceinline__ int a_row(const U&, int R) const { return R; }
    __device__ __forceinline__ const bf16_t* b_ptr(const U& u) const { return W + (size_t)u.pn * 256 * D; }
    static __device__ __forceinline__ int b_row(int bj, int S) { return brow_std(bj, S); }
    __device__ __forceinline__ void epi(Acc& acc, const U& u, int wr, int wc, int fr, int fq) const {
        const bool isv = u.pn >= 8; const int pn8 = u.pn & 7; bf16_t* dst = isv ? V3 : Ub;
#pragma unroll
        for (int ai = 0; ai < 2; ++ai)
#pragma unroll
            for (int m = 0; m < 4; ++m) {
                const int row = u.pm * 256 + 128 * ai + 64 * wr + 16 * m + fr; float ss = 0.f;
                const float s = rsqrtf(sum16(xstat + (size_t)row * 16) * (1.f / D) + EPS);
#pragma unroll
                for (int bj = 0; bj < 2; ++bj) {
                    const int lc = 64 * wc + 32 * bj + 8 * fq;
                    const f32x4 b0 = *(const f32x4*)(bias + 256 * u.pn + lc), b1 = *(const f32x4*)(bias + 256 * u.pn + lc + 4);
                    float v[8];
#pragma unroll
                    for (int e = 0; e < 4; ++e) { v[e] = gelu_tanh(acc[ai][bj][m][0][e] * s + b0[e]); v[4 + e] = gelu_tanh(acc[ai][bj][m][1][e] * s + b1[e]); }
                    u32x4 w; w.x = pk2(v[0], v[1]); w.y = pk2(v[2], v[3]); w.z = pk2(v[4], v[5]); w.w = pk2(v[6], v[7]);
                    *(u32x4*)(dst + (size_t)row * CW + 256 * pn8 + lc) = w;
                    const float r[8] = {bf_lo(w.x), bf_hi(w.x), bf_lo(w.y), bf_hi(w.y), bf_lo(w.z), bf_hi(w.z), bf_lo(w.w), bf_hi(w.w)};
#pragma unroll
                    for (int j = 0; j < 8; ++j) ss += r[j] * r[j];
                }
                if (isv) { ss += __shfl_xor(ss, 16); ss += __shfl_xor(ss, 32); if (fq == 0) vstat[(size_t)row * 32 + 4 * pn8 + wc] = ss; }
            }
    }
};

__device__ __forceinline__ int lds_byte(int r, int c) { const int st = (r >> 4) * 2 + (c >> 5), rr = r & 15, cc = c & 31, ob = rr * 64 + cc * 2; return st * 1024 + (ob ^ (((ob >> 9) & 1) << 5)); }
__device__ __forceinline__ void stage_rc(int b, int& R, int& C) { const int st = b / 1024, sb = b % 1024, swz = sb ^ (((sb >> 9) & 1) << 5); R = (st >> 1) * 16 + swz / 64; C = (st & 1) * 32 + (swz % 64) / 2; }

template <class P> __device__ __forceinline__ void gemm_fast(LAS unsigned char* lds, const P& p) {
    constexpr int HTB = 16384;
    const int tid = threadIdx.x, wid = __builtin_amdgcn_readfirstlane(tid >> 6), lane = tid & 63, wr = wid >> 2, wc = wid & 3, fr = lane & 15, fq = lane >> 4;
    const int K = p.K, nt = K / 64, lda = p.lda, ldb = p.ldb;
    const int G = (int)gridDim.x, cu = (int)blockIdx.x;
    int Rs[2], Cs[2];
#pragma unroll
    for (int i = 0; i < 2; ++i) stage_rc(tid * 16 + i * 8192, Rs[i], Cs[i]);
    unsigned boffs[4];
#pragma unroll
    for (int bj = 0; bj < 2; ++bj)
#pragma unroll
        for (int i = 0; i < 2; ++i) boffs[bj * 2 + i] = (unsigned)(P::b_row(bj, Rs[i]) * ldb + Cs[i]) * 2u;
    const unsigned ldsw = (unsigned)wid * 1024u;
    const int aoff_l = lds_byte(wr * 64 + fr, fq * 8), boff_l = lds_byte(wc * 32 + fr, fq * 8);
#define GF_SA(b, h) (((b) * 2 + (h)) * HTB)
#define GF_SB(b, h) ((4 + (b) * 2 + (h)) * HTB)
#define GF_STAGE(bufoff, gbase, o0, o1) do { \
        __builtin_amdgcn_global_load_lds((const unsigned*)((const char*)(gbase) + (o0)), (LAS unsigned*)(lds + (bufoff) + ldsw), 16, 0, 0); \
        __builtin_amdgcn_global_load_lds((const unsigned*)((const char*)(gbase) + (o1)), (LAS unsigned*)(lds + (bufoff) + ldsw + 8192), 16, 0, 0); } while (0)
#define GF_LDA(dst, b, h) do { _Pragma("unroll") for (int m = 0; m < 4; ++m) _Pragma("unroll") for (int k = 0; k < 2; ++k) dst[m][k] = *(const LAS bf16x8*)(lds + GF_SA(b, h) + aoff_l + m * 2048 + k * 1024); } while (0)
#define GF_LDB(dst, b, h) do { _Pragma("unroll") for (int n = 0; n < 2; ++n) _Pragma("unroll") for (int k = 0; k < 2; ++k) dst[n][k] = *(const LAS bf16x8*)(lds + GF_SB(b, h) + boff_l + n * 2048 + k * 1024); } while (0)
#define GF_MMA(ai, bj, At, Bt) do { __builtin_amdgcn_s_setprio(1); _Pragma("unroll") for (int m = 0; m < 4; ++m) _Pragma("unroll") for (int n = 0; n < 2; ++n) _Pragma("unroll") for (int k = 0; k < 2; ++k) \
        acc[ai][bj][m][n] = __builtin_amdgcn_mfma_f32_16x16x32_bf16(Bt[n][k], At[m][k], acc[ai][bj][m][n], 0, 0, 0); __builtin_amdgcn_s_setprio(0); } while (0)
#define GF_WAIT_V(n) asm volatile("s_waitcnt vmcnt(" #n ")" ::: "memory")
#define GF_WAIT_L(n) asm volatile("s_waitcnt lgkmcnt(" #n ")" ::: "memory")
#define GF_BAR __builtin_amdgcn_s_barrier()
#define GF_SCHED __builtin_amdgcn_sched_barrier(0)
#define GF_AOFFS(dst, u) do { _Pragma("unroll") for (int h = 0; h < 2; ++h) _Pragma("unroll") for (int i = 0; i < 2; ++i) dst[h * 2 + i] = (unsigned)(p.a_row(u, 128 * h + Rs[i]) * lda + Cs[i]) * 2u; } while (0)
    U cur, nxt; int ui = 0;
    if (!p.unit(cu, cur)) return;
    Acc acc;
#pragma unroll
    for (int a = 0; a < 2; ++a)
#pragma unroll
        for (int b = 0; b < 2; ++b)
#pragma unroll
            for (int m = 0; m < 4; ++m)
#pragma unroll
                for (int n = 0; n < 2; ++n) acc[a][b][m][n] = (f32x4){0.f, 0.f, 0.f, 0.f};
    bf16x8 At[4][2], B0[2][2], B1[2][2];
    unsigned aoffs[4], naoffs[4];
    GF_AOFFS(aoffs, cur);
    const char* cA = (const char*)p.a_ptr(cur); const char* cB = (const char*)p.b_ptr(cur);
    GF_STAGE(GF_SB(0, 0), cB, boffs[0], boffs[1]); GF_STAGE(GF_SB(0, 1), cB, boffs[2], boffs[3]); GF_STAGE(GF_SA(0, 0), cA, aoffs[0], aoffs[1]); GF_STAGE(GF_SA(0, 1), cA, aoffs[2], aoffs[3]);
    if (wr == 1) GF_BAR;
    GF_WAIT_V(2); GF_BAR;
    GF_STAGE(GF_SB(1, 0), cB + 128, boffs[0], boffs[1]); GF_STAGE(GF_SA(1, 0), cA + 128, aoffs[0], aoffs[1]); GF_STAGE(GF_SB(1, 1), cB + 128, boffs[2], boffs[3]);
    GF_WAIT_V(6); GF_BAR;
    for (;;) {
        const bool has_next = p.unit((ui + 1) * G + cu, nxt);
        const char* nA = cA; const char* nB = cB;
#pragma unroll
        for (int j = 0; j < 4; ++j) naoffs[j] = aoffs[j];
        if (has_next) { nA = (const char*)p.a_ptr(nxt); nB = (const char*)p.b_ptr(nxt); if (P::GATHER) GF_AOFFS(naoffs, nxt); }
        for (int t = 0; t < nt; t += 2) {
            const bool last = (t == nt - 2);
            const char* a1 = cA + (size_t)(t + 1) * 128;
            const char* a2 = last ? nA : cA + (size_t)(t + 2) * 128; const char* b2 = last ? nB : cB + (size_t)(t + 2) * 128;
            const char* a3 = a2 + 128; const char* b3 = b2 + 128;
            unsigned o[4];
#pragma unroll
            for (int j = 0; j < 4; ++j) o[j] = (P::GATHER && last) ? naoffs[j] : aoffs[j];
            GF_LDB(B0, 0, 0); GF_LDB(B1, 0, 1); GF_SCHED; GF_LDA(At, 0, 0); GF_STAGE(GF_SA(1, 1), a1, aoffs[2], aoffs[3]);
            GF_WAIT_V(8); GF_WAIT_L(0); GF_BAR; GF_MMA(0, 0, At, B0); GF_MMA(0, 1, At, B1); GF_BAR; GF_SCHED;
            GF_LDA(At, 0, 1); GF_STAGE(GF_SB(0, 0), b2, boffs[0], boffs[1]); GF_STAGE(GF_SB(0, 1), b2, boffs[2], boffs[3]); GF_STAGE(GF_SA(0, 0), a2, o[0], o[1]);
            GF_WAIT_V(8); GF_WAIT_L(0); GF_BAR; GF_MMA(1, 0, At, B0); GF_MMA(1, 1, At, B1); GF_BAR; GF_SCHED;
            GF_LDB(B0, 1, 0); GF_LDB(B1, 1, 1); GF_SCHED; GF_LDA(At, 1, 0); GF_STAGE(GF_SA(0, 1), a2, o[2], o[3]);
            GF_WAIT_V(8); GF_WAIT_L(0); GF_BAR; GF_MMA(0, 0, At, B0); GF_MMA(0, 1, At, B1); GF_BAR; GF_SCHED;
            GF_LDA(At, 1, 1); GF_STAGE(GF_SB(1, 0), b3, boffs[0], boffs[1]); GF_STAGE(GF_SB(1, 1), b3, boffs[2], boffs[3]); GF_STAGE(GF_SA(1, 0), a3, o[0], o[1]);
            GF_WAIT_V(8); GF_WAIT_L(0); GF_BAR; GF_MMA(1, 0, At, B0); GF_MMA(1, 1, At, B1); GF_BAR; GF_SCHED;
        }
        if (wr == 0) GF_BAR;
        p.epi(acc, cur, wr, wc, fr, fq);
        if (!has_next) break;
#pragma unroll
        for (int a = 0; a < 2; ++a)
#pragma unroll
            for (int b = 0; b < 2; ++b)
#pragma unroll
                for (int m = 0; m < 4; ++m)
#pragma unroll
                    for (int n = 0; n < 2; ++n) acc[a][b][m][n] = (f32x4){0.f, 0.f, 0.f, 0.f};
        cur = nxt; cA = nA; cB = nB; ++ui;
#pragma unroll
        for (int j = 0; j < 4; ++j) aoffs[j] = naoffs[j];
        if (wr == 1) GF_BAR;
    }
    GF_WAIT_V(0);
    GF_BAR;
#undef GF_SA
#undef GF_SB
#undef GF_STAGE
#undef GF_LDA
#undef GF_LDB
#undef GF_MMA
#undef GF_WAIT_V
#undef GF_WAIT_L
#undef GF_BAR
#undef GF_SCHED
#undef GF_AOFFS
}

#ifndef FAST_MASK
#define FAST_MASK 0xffffffffu
#endif
template <class P> __device__ __forceinline__ void run_gemm(LAS unsigned char* lds, const P& p) {
#if FAST_CORE
    if constexpr (((FAST_MASK >> P::ID) & 1u) != 0u) { gemm_fast<P>(lds, p); __syncthreads(); }
    else gemm_naive<P>(p);
#else
    (void)lds;
    gemm_naive<P>(p);
#endif
}

__device__ __forceinline__ void tconv_item(const float* W, int ldw, int n0, bf16_t* dst, int ldd, int drow0, const float* ksc, LAS float* scr, int kb, int nb, int lane) {
    const int k0 = 64 * kb, c0 = n0 + 32 * nb;
#pragma unroll 8
    for (int i = 0; i < 32; ++i) { const int kk = 2 * i + (lane >> 5); scr[kk * 33 + (lane & 31)] = W[(size_t)(k0 + kk) * ldw + c0 + (lane & 31)]; }
    asm volatile("s_waitcnt lgkmcnt(0)" ::: "memory");
    const int c = lane & 7;
    float sc[8];
#pragma unroll
    for (int j = 0; j < 8; ++j) sc[j] = ksc ? ksc[k0 + 8 * c + j] : 1.f;
#pragma unroll
    for (int j = 0; j < 4; ++j) { const int n = (lane >> 3) + 8 * j; const LAS float* s = scr + (8 * c) * 33 + n;
        u32x4 o; o.x = pk2(s[0 * 33] * sc[0], s[1 * 33] * sc[1]); o.y = pk2(s[2 * 33] * sc[2], s[3 * 33] * sc[3]); o.z = pk2(s[4 * 33] * sc[4], s[5 * 33] * sc[5]); o.w = pk2(s[6 * 33] * sc[6], s[7 * 33] * sc[7]);
        *(u32x4*)(dst + (size_t)(drow0 + 32 * nb + n) * ldd + k0 + 8 * c) = o; }
    asm volatile("s_waitcnt lgkmcnt(0)" ::: "memory");
}
__device__ __forceinline__ bool tconv_job(int& r, const float* W, int ldw, int n0, int Kd, int Nc, bf16_t* dst, int drow0, const float* ksc, LAS float* scr, int lane) {
    const int nkb = Kd / 64, nnb = Nc / 32, items = nkb * nnb;
    if (r >= items) { r -= items; return false; }
    const int kb = r / nnb, nb = r - kb * nnb;
    tconv_item(W, ldw, n0, dst, Kd, drow0, ksc, scr, kb, nb, lane);
    return true;
}
__device__ __forceinline__ void conv_moe_layer(const Args& a, int l, LAS unsigned char* lds) {
    const int lane = threadIdx.x & 63, wave = threadIdx.x >> 6;
    LAS float* scr = (LAS float*)(lds + wave * 8448);
    const int gw = blockIdx.x * NWAVES + wave, NGW = gridDim.x * NWAVES;
    bf16_t* WGU = (bf16_t*)(a.ws + WS_W_GU); bf16_t* WDN = (bf16_t*)(a.ws + WS_W_DN);
    const float* g = a.in[I_NFFN] + l * D;
    for (int it = gw; it < 3 * 32 * 256; it += NGW) {
        const int kind = it / 8192, r = it - kind * 8192, e = r >> 8, q = r & 255;
        if (kind == 0) { const float* W = a.in[I_MGATE] + ((size_t)l * 32 + e) * (D * DEXP); tconv_item(W, DEXP, 0, WGU + (size_t)e * 1024 * 1024, D, 0, g, scr, q >> 4, q & 15, lane); }
        else if (kind == 1) { const float* W = a.in[I_MUP] + ((size_t)l * 32 + e) * (D * DEXP); tconv_item(W, DEXP, 0, WGU + (size_t)e * 1024 * 1024, D, 512, g, scr, q >> 4, q & 15, lane); }
        else { const float* W = a.in[I_MDOWN] + ((size_t)l * 32 + e) * (DEXP * D); tconv_item(W, D, 0, WDN + (size_t)e * 1024 * 512, DEXP, 0, nullptr, scr, q >> 5, q & 31, lane); }
    }
}
__device__ __forceinline__ void phase_prologue(const Args& a, LAS unsigned char* lds) {
    const int tid = threadIdx.x, lane = tid & 63, wave = tid >> 6;
    LAS float* scr = (LAS float*)(lds + wave * 8448);
    const int gw = blockIdx.x * NWAVES + wave, NGW = gridDim.x * NWAVES;
    unsigned char* ws = a.ws;
    constexpr int NITEMS = 768 + 512 + 512 + 2048 + 1024 + 2 * 512 + 2 * 1024 + 2 * 512;
    for (int it = gw; it < NITEMS; it += NGW) {
        int r = it;
        if (tconv_job(r, a.in[I_ABWIN], INAB, 0, D, 1536, (bf16_t*)(ws + WS_W_IN0), 0, a.in[I_NMIX], scr, lane)) continue;
        if (tconv_job(r, a.in[I_ABWIN], INAB, 1544, D, 1024, (bf16_t*)(ws + WS_W_IN0), 1536, a.in[I_NMIX], scr, lane)) continue;
        if (tconv_job(r, a.in[I_ABWOUT], D, 0, D, D, (bf16_t*)(ws + WS_W_OUT0), 0, nullptr, scr, lane)) continue;
        if (tconv_job(r, a.in[I_CWIN], 2 * CW, 0, D, 2 * CW, (bf16_t*)(ws + WS_W_IN1), 0, a.in[I_NMIX] + D, scr, lane)) continue;
        if (tconv_job(r, a.in[I_CWOUT], D, 0, CW, D, (bf16_t*)(ws + WS_W_OUT1), 0, nullptr, scr, lane)) continue;
        if (tconv_job(r, a.in[I_XWQ], D, 0, D, D, (bf16_t*)(ws + WS_W_Q), 0, a.in[I_NCROSS], scr, lane)) continue;
        if (tconv_job(r, a.in[I_XWQ] + (size_t)D * D, D, 0, D, D, (bf16_t*)(ws + WS_W_Q) + (size_t)D * D, 0, a.in[I_NCROSS] + D, scr, lane)) continue;
        if (tconv_job(r, a.in[I_XWKV], 2 * D, 0, D, 2 * D, (bf16_t*)(ws + WS_W_KV), 0, a.in[I_NMEM], scr, lane)) continue;
        if (tconv_job(r, a.in[I_XWKV] + (size_t)D * 2 * D, 2 * D, 0, D, 2 * D, (bf16_t*)(ws + WS_W_KV) + (size_t)2 * D * D, 0, a.in[I_NMEM] + D, scr, lane)) continue;
        if (tconv_job(r, a.in[I_XWO], D, 0, D, D, (bf16_t*)(ws + WS_W_O), 0, nullptr, scr, lane)) continue;
        tconv_job(r, a.in[I_XWO] + (size_t)D * D, D, 0, D, D, (bf16_t*)(ws + WS_W_O) + (size_t)D * D, 0, nullptr, scr, lane);
    }
    conv_moe_layer(a, 0, lds);
    const int gt = blockIdx.x * NTHREADS + tid, NGT = gridDim.x * NTHREADS;
    for (int i = gt; i < 2 * 256 * D; i += NGT) {
        const int l = i / (256 * D), n = (i / D) & 255, k = i & (D - 1);
        float v = 0.f;
        if (n < 4) v = a.in[I_MWG][((size_t)l * D + k) * 4 + n] * a.in[I_NFFN][l * D + k];
        else if (n < 36) v = a.in[I_MWE][((size_t)l * D + k) * 32 + (n - 4)] * a.in[I_NFFN][l * D + k];
        ((bf16_t*)(ws + WS_W_R))[i] = f2bf(v);
    }
    for (int i = gt; i < CG * CCH * CCH; i += NGT) { const int t = (i >> 7) & 127, s = i & 127; ((bf16_t*)(ws + WS_TRIL))[i] = f2bf(s <= t ? a.in[I_CWS][i] : 0.f); }
    __syncthreads();
    LAS float* wf = (LAS float*)(lds + 73728);
    for (int i = tid; i < D * 8; i += NTHREADS) { const int k = i >> 3, h = i & 7; wf[i] = a.in[I_ABWIN][(size_t)k * INAB + 1536 + h] * a.in[I_NMIX][k]; }
    __syncthreads();
    bf16_t* X = (bf16_t*)(ws + WS_X); float* xstat = (float*)(ws + WS_XSTAT); float* flog = (float*)(ws + WS_FLOG);
    for (int row = gw; row < T; row += NGW) {
        const f32x4* xr = (const f32x4*)(a.in[I_X] + (size_t)row * D) + lane;
        f32x4 v[4]; float ss = 0.f; float fl[8];
#pragma unroll
        for (int h = 0; h < 8; ++h) fl[h] = 0.f;
#pragma unroll
        for (int j = 0; j < 4; ++j) { v[j] = xr[64 * j]; ss += (v[j].x * v[j].x + v[j].y * v[j].y) + (v[j].z * v[j].z + v[j].w * v[j].w); }
#pragma unroll
        for (int j = 0; j < 4; ++j)
#pragma unroll
            for (int e = 0; e < 4; ++e) { const int k = 4 * lane + 256 * j + e; const f32x4 w0 = *(const LAS f32x4*)(wf + k * 8), w1 = *(const LAS f32x4*)(wf + k * 8 + 4);
#pragma unroll
                for (int h = 0; h < 4; ++h) { fl[h] += v[j][e] * w0[h]; fl[4 + h] += v[j][e] * w1[h]; } }
        ss = wave_sum(ss);
#pragma unroll
        for (int h = 0; h < 8; ++h) fl[h] = wave_sum(fl[h]);
        u32x2* o8 = (u32x2*)(X + (size_t)row * D) + lane;
#pragma unroll
        for (int j = 0; j < 4; ++j) { u32x2 o; o.x = pk2(v[j].x, v[j].y); o.y = pk2(v[j].z, v[j].w); o8[64 * j] = o; }
        if (lane < 16) xstat[(size_t)row * 16 + lane] = lane == 0 ? ss : 0.f;
        const float s = rsqrtf(ss * (1.f / D) + EPS);
        if (lane < 8) { float f = fl[0];
#pragma unroll
            for (int h = 1; h < 8; ++h) f = lane == h ? fl[h] : f;
            flog[(size_t)row * 8 + lane] = f * s; }
    }
    bf16_t* MB = (bf16_t*)(ws + WS_MEMB); float* memstat = (float*)(ws + WS_MISC + MISC_MEMSTAT);
    for (int row = gw; row < NB * MEML; row += NGW) {
        const f32x4* xr = (const f32x4*)(a.in[I_MEM] + (size_t)row * D) + lane; float ss = 0.f;
        u32x2* o8 = (u32x2*)(MB + (size_t)row * D) + lane;
#pragma unroll
        for (int j = 0; j < 4; ++j) { const f32x4 v = xr[64 * j]; ss += (v.x * v.x + v.y * v.y) + (v.z * v.z + v.w * v.w); u32x2 o; o.x = pk2(v.x, v.y); o.y = pk2(v.z, v.w); o8[64 * j] = o; }
        ss = wave_sum(ss);
        if (lane == 0) memstat[row] = ss;
    }
}

__device__ __forceinline__ void phase_cumsum(const Args& a, LAS unsigned char* lds) {
    const int tid = threadIdx.x, lane = tid & 63, wave = tid >> 6;
    const float* flog = (const float*)(a.ws + WS_FLOG); float* csum = (float*)(a.ws + WS_CSUM);
    LAS float* wsum = (LAS float*)lds;
    for (int u = blockIdx.x; u < NB * AH; u += gridDim.x) {
        const int b = u >> 3, h = u & 7; const float fb = a.in[I_FBIAS][h];
        float v[8]; float run = 0.f;
#pragma unroll
        for (int j = 0; j < 8; ++j) { const float x = flog[((size_t)b * SEQ + 8 * tid + j) * 8 + h] + fb; const float lf = fminf(x, 0.f) - log1pf(__expf(-fabsf(x))); run += lf; v[j] = run; }
        float inc = run;
#pragma unroll
        for (int o = 1; o < 64; o <<= 1) { const float t = __shfl_up(inc, o); if (lane >= o) inc += t; }
        __syncthreads();
        if (lane == 63) wsum[wave] = inc;
        __syncthreads();
        float base = inc - run;
        for (int w = 0; w < wave; ++w) base += wsum[w];
#pragma unroll
        for (int j = 0; j < 8; ++j) csum[(size_t)u * SEQ + 8 * tid + j] = base + v[j];
    }
}

__device__ __forceinline__ void phase_k2fin(const Args& a) {
    const int lane = threadIdx.x & 63, wave = threadIdx.x >> 6;
    const int gw = blockIdx.x * NWAVES + wave, NGW = gridDim.x * NWAVES;
    bf16_t* K2 = (bf16_t*)(a.ws + WS_K2); const float* k2stat = (const float*)(a.ws + WS_MISC + MISC_K2STAT);
    for (int it = gw; it < 2 * NB * XH * MEML; it += NGW) {
        const int key = it & 255, h = (it >> 8) & 3, b = (it >> 10) & 7, l = it >> 13;
        const f32x4 st = *(const f32x4*)(k2stat + ((size_t)l * 2048 + b * 256 + key) * 16 + 4 * h);
        const float rn = rsqrtf(((st.x + st.y) + (st.z + st.w)) * (1.f / XHD) + EPS);
        u32x2* p = (u32x2*)(K2 + (size_t)it * 256) + lane; const u32x2 v = *p;
        const float* qg = a.in[I_XQG] + l * XHD + 4 * lane; const float* kg = a.in[I_XKG] + l * XHD + 4 * lane;
        u32x2 o; o.x = pk2(bf_lo(v.x) * rn * qg[0] * kg[0], bf_hi(v.x) * rn * qg[1] * kg[1]); o.y = pk2(bf_lo(v.y) * rn * qg[2] * kg[2], bf_hi(v.y) * rn * qg[3] * kg[3]);
        *p = o;
    }
    const bf16_t* V2 = (const bf16_t*)(a.ws + WS_ARENA + AR_V2TMP); bf16_t* V2T = (bf16_t*)(a.ws + WS_V2T);
    const int gt = blockIdx.x * NTHREADS + threadIdx.x, NGT = gridDim.x * NTHREADS;
    for (int it = gt; it < 64 * 256 * 32; it += NGT) {
        const int d = it & 255, k8 = (it >> 8) & 31, tile = it >> 13;
        const bf16_t* src = V2 + (size_t)tile * 65536 + (size_t)(8 * k8) * 256 + d;
        u32x4 w; w.x = (unsigned)src[0] | ((unsigned)src[256] << 16); w.y = (unsigned)src[512] | ((unsigned)src[768] << 16); w.z = (unsigned)src[1024] | ((unsigned)src[1280] << 16); w.w = (unsigned)src[1536] | ((unsigned)src[1792] << 16);
        *(u32x4*)(V2T + (size_t)tile * 65536 + (size_t)d * 256 + 8 * k8) = w;
    }
}

__device__ __forceinline__ void lru_unit(const Args& a, LAS unsigned char* lds, int b, int g, int ch, int pass) {
    const int tid = threadIdx.x, c = tid & 63, tq = tid >> 6;
    LAS float* xc = (LAS float*)lds;
    LAS float* wA = (LAS float*)(lds + 33792);
    LAS float* wX = (LAS float*)(lds + 33792 + 16384);
    LAS float* seg = (LAS float*)(lds + 33792 + 32768);
    const bf16_t* XB = (const bf16_t*)(a.ws + WS_ARENA + AR_XB); const bf16_t* GATE = (const bf16_t*)(a.ws + WS_ARENA + AR_GATE);
    bf16_t* AR = (bf16_t*)(a.ws + WS_ARENA + AR_AR); float* lsum = (float*)(a.ws + WS_LSUM);
    const int ch0 = 64 * g + c; const size_t row0 = (size_t)b * SEQ + 128 * ch;
    __syncthreads();
    for (int i = tid; i < 4096; i += NTHREADS) { wA[i] = a.in[I_WA][g * 4096 + i]; wX[i] = a.in[I_WX][g * 4096 + i]; }
    {
        const float w0 = a.in[I_CONVW][0 * BW + ch0], w1 = a.in[I_CONVW][1 * BW + ch0], w2 = a.in[I_CONVW][2 * BW + ch0], w3 = a.in[I_CONVW][3 * BW + ch0], cb = a.in[I_CONVB][ch0];
        float xm3, xm2, xm1; const int tl0 = 16 * tq, s0 = 128 * ch + tl0;
        xm3 = s0 >= 3 ? bf2f(XB[(row0 + tl0 - 3) * BW + ch0]) : 0.f; xm2 = s0 >= 2 ? bf2f(XB[(row0 + tl0 - 2) * BW + ch0]) : 0.f; xm1 = s0 >= 1 ? bf2f(XB[(row0 + tl0 - 1) * BW + ch0]) : 0.f;
#pragma unroll 4
        for (int j = 0; j < 16; ++j) { const float x0 = bf2f(XB[(row0 + tl0 + j) * BW + ch0]); xc[(tl0 + j) * 65 + c] = w0 * xm3 + w1 * xm2 + w2 * xm1 + w3 * x0 + cb; xm3 = xm2; xm2 = xm1; xm1 = x0; }
    }
    __syncthreads();
    float ra[16], rx[16];
#pragma unroll
    for (int j = 0; j < 16; ++j) { ra[j] = 0.f; rx[j] = 0.f; }
    for (int k = 0; k < 64; ++k) { const float wa = wA[k * 64 + c], wx = wX[k * 64 + c];
#pragma unroll
        for (int j = 0; j < 16; ++j) { const float x = xc[(16 * tq + j) * 65 + k]; ra[j] += x * wa; rx[j] += x * wx; } }
    const float ba = a.in[I_BA][ch0], bx = a.in[I_BX][ch0], lam = a.in[I_LAM][ch0];
    const float sp = (lam > 0.f ? 0.f : -lam) + log1pf(__expf(-fabsf(lam)));
    float av[16], bv[16]; float Pp = 1.f, hh = 0.f;
#pragma unroll
    for (int j = 0; j < 16; ++j) { const float r = sigmoidf(ra[j] + ba), ig = sigmoidf(rx[j] + bx); const float la = -8.f * r * sp; const float aa = __expf(la);
        const float beta = sqrtf(fmaxf(-expm1f(2.f * la), 0.f)); av[j] = aa; bv[j] = beta * (ig * xc[(16 * tq + j) * 65 + c]); Pp *= aa; hh = aa * hh + bv[j]; }
    seg[(tq * 64 + c) * 2] = Pp; seg[(tq * 64 + c) * 2 + 1] = hh;
    __syncthreads();
    if (pass == 0) {
        if (tq == 0) { float PA = 1.f, H = 0.f;
            for (int q = 0; q < 8; ++q) { const float pq = seg[(q * 64 + c) * 2], hq = seg[(q * 64 + c) * 2 + 1]; H = pq * H + hq; PA *= pq; }
            float* o = lsum + (((size_t)b * 32 + ch) * BW + ch0) * 2; o[0] = PA; o[1] = H; }
    } else {
        float H = 0.f;
        for (int q = 0; q < ch; ++q) { const float* o = lsum + (((size_t)b * 32 + q) * BW + ch0) * 2; H = o[0] * H + o[1]; }
        for (int q = 0; q < tq; ++q) H = seg[(q * 64 + c) * 2] * H + seg[(q * 64 + c) * 2 + 1];
#pragma unroll
        for (int j = 0; j < 16; ++j) { H = av[j] * H + bv[j]; const size_t row = row0 + 16 * tq + j; AR[row * D + 512 + ch0] = f2bf(bf2f(GATE[row * BW + ch0]) * H); }
    }
}
__device__ __forceinline__ void phase_lru(const Args& a, LAS unsigned char* lds, int pass) {
    for (int u = blockIdx.x; u < NB * 8 * 32; u += gridDim.x) { const int ch = u & 31, g = (u >> 5) & 7, b = u >> 8; lru_unit(a, lds, b, g, ch, pass); }
    __syncthreads();
}

__device__ __forceinline__ void phase_attn_naive(const Args& a) {
    const int tid = threadIdx.x;
    const bf16_t* Q = (const bf16_t*)(a.ws + WS_ARENA + AR_Q); const bf16_t* Kb = (const bf16_t*)(a.ws + WS_ARENA + AR_K); const bf16_t* Vb = (const bf16_t*)(a.ws + WS_ARENA + AR_V);
    bf16_t* AR = (bf16_t*)(a.ws + WS_ARENA + AR_AR); const float* csum = (const float*)(a.ws + WS_CSUM);
    const int NU = NB * AH * (SEQ / NTHREADS);
    for (int i = blockIdx.x; i < NU; i += gridDim.x) {
        const int uu = NU - 1 - i;
        const int qb = uu / (NB * AH), bh = uu % (NB * AH), b = bh >> 3, h = bh & 7;
        const int t = qb * NTHREADS + tid; const size_t row = (size_t)b * SEQ + t;
        u32x4 qp[8]; float o[64];
#pragma unroll
        for (int d8 = 0; d8 < 8; ++d8) qp[d8] = *(const u32x4*)(Q + row * AW + h * HD + 8 * d8);
#pragma unroll
        for (int d = 0; d < 64; ++d) o[d] = 0.f;
        const float* cs = csum + (size_t)bh * SEQ; const float ci = cs[t] * LOG2E;
        float mx = -INFINITY, l = 0.f;
        const int jmax = qb * NTHREADS + (tid | 63);
        for (int j = 0; j <= jmax; ++j) {
            const size_t kr = ((size_t)b * SEQ + j) * AW + h * HD;
            float s = 0.f;
#pragma unroll
            for (int d8 = 0; d8 < 8; ++d8) { const u32x4 v = *(const u32x4*)(Kb + kr + 8 * d8); const u32x4 q = qp[d8];
                s += bf_lo(q.x) * bf_lo(v.x) + bf_hi(q.x) * bf_hi(v.x) + bf_lo(q.y) * bf_lo(v.y) + bf_hi(q.y) * bf_hi(v.y) + bf_lo(q.z) * bf_lo(v.z) + bf_hi(q.z) * bf_hi(v.z) + bf_lo(q.w) * bf_lo(v.w) + bf_hi(q.w) * bf_hi(v.w); }
            s += ci - cs[j] * LOG2E;
            if (j > t) s = -INFINITY;
            const float mn = fmaxf(mx, s); const float sc = exp2f(mx - mn), p = exp2f(s - mn);
            l = l * sc + p; mx = mn;
#pragma unroll
            for (int d8 = 0; d8 < 8; ++d8) { const u32x4 v = *(const u32x4*)(Vb + kr + 8 * d8);
                o[8 * d8] = o[8 * d8] * sc + p * bf_lo(v.x); o[8 * d8 + 1] = o[8 * d8 + 1] * sc + p * bf_hi(v.x); o[8 * d8 + 2] = o[8 * d8 + 2] * sc + p * bf_lo(v.y); o[8 * d8 + 3] = o[8 * d8 + 3] * sc + p * bf_hi(v.y);
                o[8 * d8 + 4] = o[8 * d8 + 4] * sc + p * bf_lo(v.z); o[8 * d8 + 5] = o[8 * d8 + 5] * sc + p * bf_hi(v.z); o[8 * d8 + 6] = o[8 * d8 + 6] * sc + p * bf_lo(v.w); o[8 * d8 + 7] = o[8 * d8 + 7] * sc + p * bf_hi(v.w); }
        }
        const float inv = 1.f / l;
#pragma unroll
        for (int d8 = 0; d8 < 8; ++d8) { u32x4 w; w.x = pk2(o[8 * d8] * inv, o[8 * d8 + 1] * inv); w.y = pk2(o[8 * d8 + 2] * inv, o[8 * d8 + 3] * inv); w.z = pk2(o[8 * d8 + 4] * inv, o[8 * d8 + 5] * inv); w.w = pk2(o[8 * d8 + 6] * inv, o[8 * d8 + 7] * inv);
            *(u32x4*)(AR + row * D + h * HD + 8 * d8) = w; }
    }
}

__device__ __forceinline__ void phase_mix_naive(const Args& a, LAS unsigned char* lds) {
    const int tid = threadIdx.x, lane = tid & 63, wave = tid >> 6;
    LAS float* vt = (LAS float*)lds;
    bf16_t* Ub = (bf16_t*)(a.ws + WS_ARENA + AR_U); const bf16_t* V3 = (const bf16_t*)(a.ws + WS_ARENA + AR_V3); const float* vstat = (const float*)(a.ws + WS_VSTAT);
    const bf16_t* tril = (const bf16_t*)(a.ws + WS_TRIL);
    for (int u = blockIdx.x; u < (T / CCH) * CG; u += gridDim.x) {
        const int g = u & 7, n = u >> 3; const size_t row0 = (size_t)n * CCH;
        __syncthreads();
        for (int i = tid; i < 128 * 64; i += NTHREADS) {
            const int s = i >> 6, c4 = (i & 63) * 4; const size_t row = row0 + s;
            const float* st = vstat + row * 32; float tot = 0.f;
#pragma unroll
            for (int j = 0; j < 32; ++j) tot += st[j];
            const float rs = rsqrtf(tot * (1.f / CW) + EPS);
            const u32x2 v = *(const u32x2*)(V3 + row * CW + 256 * g + c4); const float* gn = a.in[I_CVG] + 256 * g + c4;
            *(LAS f32x4*)(vt + s * 256 + c4) = (f32x4){bf_lo(v.x) * rs * gn[0], bf_hi(v.x) * rs * gn[1], bf_lo(v.y) * rs * gn[2], bf_hi(v.y) * rs * gn[3]};
        }
        __syncthreads();
        for (int tt = 0; tt < 16; ++tt) {
            const int t = wave * 16 + tt; const bf16_t* wrow = tril + ((size_t)g * 128 + t) * 128;
            f32x4 acc = (f32x4){0.f, 0.f, 0.f, 0.f};
            for (int s = 0; s <= t; ++s) { const float w = bf2f(wrow[s]); const f32x4 v = *(const LAS f32x4*)(vt + s * 256 + 4 * lane); acc += v * w; }
            const float bs = a.in[I_CBS][g * 128 + t];
            u32x2* up = (u32x2*)(Ub + (row0 + t) * CW + 256 * g + 4 * lane); const u32x2 uv = *up;
            u32x2 o; o.x = pk2(bf_lo(uv.x) * (acc.x + bs), bf_hi(uv.x) * (acc.y + bs)); o.y = pk2(bf_lo(uv.y) * (acc.z + bs), bf_hi(uv.y) * (acc.w + bs));
            *up = o;
        }
    }
    __syncthreads();
}

__device__ __forceinline__ void phase_route(const Args& a, LAS unsigned char* lds, int l) {
    const int tid = threadIdx.x;
    LAS int* hist = (LAS int*)lds; LAS int* base = hist + 32;
    const float* rlog = (const float*)(a.ws + WS_RLOG); float* pairw = (float*)(a.ws + WS_PAIRW); int* list = (int*)(a.ws + WS_LIST); int* cnt = (int*)(a.ws + WS_CTL) + 64 * l;
    for (int cb = blockIdx.x; cb < T / 256; cb += gridDim.x) {
        __syncthreads();
        if (tid < 32) hist[tid] = 0;
        __syncthreads();
        int e0 = 0, e1 = 0, r0 = 0, r1 = 0; const int tok = cb * 256 + (tid & 255);
        if (tid < 256) {
            const float* lg = rlog + (size_t)tok * 40;
            int gi = 0; float gm = lg[0];
#pragma unroll
            for (int j = 1; j < 4; ++j) if (lg[j] > gm) { gm = lg[j]; gi = j; }
            float gs = 0.f;
#pragma unroll
            for (int j = 0; j < 4; ++j) gs += __expf(lg[j] - gm);
            const float gw = 1.f / gs;
            const float* el = lg + 4 + 8 * gi;
            int i0 = 0; float v0 = el[0];
#pragma unroll
            for (int j = 1; j < 8; ++j) if (el[j] > v0) { v0 = el[j]; i0 = j; }
            int i1 = -1; float v1 = -INFINITY;
#pragma unroll
            for (int j = 0; j < 8; ++j) if (j != i0 && el[j] > v1) { v1 = el[j]; i1 = j; }
            const float ex = __expf(v1 - v0), den = 1.f / (1.f + ex);
            pairw[2 * tok] = gw * den; pairw[2 * tok + 1] = gw * ex * den;
            e0 = gi * 8 + i0; e1 = gi * 8 + i1;
            r0 = atomicAdd((int*)&hist[e0], 1); r1 = atomicAdd((int*)&hist[e1], 1);
        }
        __syncthreads();
        if (tid < 32) base[tid] = hist[tid] ? atomicAdd(&cnt[tid], hist[tid]) : 0;
        __syncthreads();
        if (tid < 256) { list[(size_t)e0 * 65536 + base[e0] + r0] = 2 * tok; list[(size_t)e1 * 65536 + base[e1] + r1] = 2 * tok + 1; }
    }
    __syncthreads();
}

__device__ __forceinline__ void phase_combine(const Args& a, bool last) {
    const int lane = threadIdx.x & 63, wave = threadIdx.x >> 6;
    const int gw = blockIdx.x * NWAVES + wave, NGW = gridDim.x * NWAVES;
    bf16_t* X = (bf16_t*)(a.ws + WS_X); const bf16_t* Y = (const bf16_t*)(a.ws + WS_ARENA + AR_Y); float* xstat = (float*)(a.ws + WS_XSTAT);
    for (int row = gw; row < T; row += NGW) {
        float ss = 0.f;
#pragma unroll
        for (int hlf = 0; hlf < 2; ++hlf) {
            const int c0 = 512 * hlf + 8 * lane;
            const u32x4 xv = *(const u32x4*)(X + (size_t)row * D + c0), y0 = *(const u32x4*)(Y + (size_t)(2 * row) * D + c0), y1 = *(const u32x4*)(Y + (size_t)(2 * row + 1) * D + c0);
            float v[8] = {bf_lo(xv.x), bf_hi(xv.x), bf_lo(xv.y), bf_hi(xv.y), bf_lo(xv.z), bf_hi(xv.z), bf_lo(xv.w), bf_hi(xv.w)};
            const float p[8] = {bf_lo(y0.x), bf_hi(y0.x), bf_lo(y0.y), bf_hi(y0.y), bf_lo(y0.z), bf_hi(y0.z), bf_lo(y0.w), bf_hi(y0.w)};
            const float q[8] = {bf_lo(y1.x), bf_hi(y1.x), bf_lo(y1.y), bf_hi(y1.y), bf_lo(y1.z), bf_hi(y1.z), bf_lo(y1.w), bf_hi(y1.w)};
#pragma unroll
            for (int j = 0; j < 8; ++j) v[j] = (v[j] + p[j]) + q[j];
            if (last) { float* o = a.out + (size_t)row * D + c0; *(f32x4*)o = (f32x4){v[0], v[1], v[2], v[3]}; *(f32x4*)(o + 4) = (f32x4){v[4], v[5], v[6], v[7]}; }
            else { u32x4 w; w.x = pk2(v[0], v[1]); w.y = pk2(v[2], v[3]); w.z = pk2(v[4], v[5]); w.w = pk2(v[6], v[7]); *(u32x4*)(X + (size_t)row * D + c0) = w;
                const float r[8] = {bf_lo(w.x), bf_hi(w.x), bf_lo(w.y), bf_hi(w.y), bf_lo(w.z), bf_hi(w.z), bf_lo(w.w), bf_hi(w.w)};
#pragma unroll
                for (int j = 0; j < 8; ++j) ss += r[j] * r[j]; }
        }
        if (!last) { ss = wave_sum(ss); if (lane < 16) xstat[(size_t)row * 16 + lane] = lane == 0 ? ss : 0.f; }
    }
}

constexpr int NPHASES = 26;
#ifdef ONLY_PHASE
#define PH(k) if (((k) == ONLY_PHASE || (k) == ONLY_PHASE2) && a.ph_lo <= (k) && (k) < a.ph_hi)
#else
#define PH(k) if (a.ph_lo <= (k) && (k) < a.ph_hi)
#endif
#define SYNC(k) do { if ((k) + 1 < a.ph_hi) cg::this_grid().sync(); } while (0)

template <int L> __device__ __forceinline__ void layer_tail(const Args& a, LAS unsigned char* lds, const int base) {
    unsigned char* ws = a.ws; unsigned char* ar = ws + WS_ARENA;
    bf16_t* X = (bf16_t*)(ws + WS_X); float* xstat = (float*)(ws + WS_XSTAT);
    volatile LAS int* tpre = (volatile LAS int*)(lds + 131072);
    PH(base + 0) { PCrossQ p; p.nM = T / 256; p.nN = 4; p.X = X; p.W = (const bf16_t*)(ws + WS_W_Q) + (size_t)L * D * D; p.xstat = xstat; p.Q2 = (bf16_t*)(ar + AR_Q2); p.qstat = (float*)(ws + WS_QSTAT); p.lda = D; p.ldb = D; p.K = D; run_gemm(lds, p); SYNC(base + 0); }
    PH(base + 1) { PCrossS p; p.nM = T / 256; p.nN = 4; p.Q2 = (const bf16_t*)(ar + AR_Q2); p.K2 = (const bf16_t*)(ws + WS_K2) + (size_t)L * 2048 * 1024; p.qstat = (const float*)(ws + WS_QSTAT); p.P = (bf16_t*)(ar + AR_P); p.psum = (float*)(ws + WS_PSUM); p.lda = D; p.ldb = 256; p.K = 256; run_gemm(lds, p); SYNC(base + 1); }
    PH(base + 2) { PCrossPV p; p.nM = T / 256; p.nN = 4; p.P = (const bf16_t*)(ar + AR_P); p.V2T = (const bf16_t*)(ws + WS_V2T) + (size_t)L * 2048 * 1024; p.psum = (const float*)(ws + WS_PSUM); p.O = (bf16_t*)(ar + AR_O); p.lda = D; p.ldb = 256; p.K = 256; run_gemm(lds, p); SYNC(base + 2); }
    PH(base + 3) { PResid p; p.nM = T / 256; p.nN = 4; p.A = (const bf16_t*)(ar + AR_O); p.W = (const bf16_t*)(ws + WS_W_O) + (size_t)L * D * D; p.X = X; p.xstat = xstat; p.lda = D; p.ldb = D; p.K = D; run_gemm(lds, p); SYNC(base + 3); }
    PH(base + 4) { PRouter p; p.nM = T / 256; p.nN = 1; p.X = X; p.W = (const bf16_t*)(ws + WS_W_R) + (size_t)L * 256 * D; p.xstat = xstat; p.bg = a.in[I_MBG] + L * 4; p.be = a.in[I_MBE] + L * 32; p.rlog = (float*)(ws + WS_RLOG); p.lda = D; p.ldb = D; p.K = D; run_gemm(lds, p); SYNC(base + 4); }
    PH(base + 5) { phase_route(a, lds, L); SYNC(base + 5); }
    PH(base + 6) { PMoeUp p; p.cnt = (const int*)(ws + WS_CTL) + 64 * L; p.list = (const int*)(ws + WS_LIST); p.tpre = tpre; p.X = X; p.W = (const bf16_t*)(ws + WS_W_GU); p.xstat = xstat; p.H = (bf16_t*)(ar + AR_H); p.lda = D; p.ldb = D; p.K = D;
        moe_sched_build(p.cnt, tpre); run_gemm(lds, p); SYNC(base + 6); }
    PH(base + 7) { PMoeDown p; p.cnt = (const int*)(ws + WS_CTL) + 64 * L; p.list = (const int*)(ws + WS_LIST); p.tpre = tpre; p.H = (const bf16_t*)(ar + AR_H); p.W = (const bf16_t*)(ws + WS_W_DN); p.pairw = (const float*)(ws + WS_PAIRW); p.Y = (bf16_t*)(ar + AR_Y); p.lda = DEXP; p.ldb = DEXP; p.K = DEXP;
        moe_sched_build(p.cnt, tpre); run_gemm(lds, p); SYNC(base + 7); }
    PH(base + 8) { phase_combine(a, L == 1); SYNC(base + 8); }
}

__global__ void __launch_bounds__(NTHREADS, 2) fwd_kernel(Args a) {
    extern __shared__ __attribute__((aligned(16))) unsigned char lds_raw[];
    LAS unsigned char* lds = (LAS unsigned char*)lds_raw;
    unsigned char* ws = a.ws;
    bf16_t* X = (bf16_t*)(ws + WS_X); float* xstat = (float*)(ws + WS_XSTAT);
    unsigned char* ar = ws + WS_ARENA;
    PH(0) { phase_prologue(a, lds); SYNC(0); }
    PH(1) {
        phase_cumsum(a, lds);
        { PInProj0 p; p.nM = T / 256; p.nN = 10; p.X = X; p.W = (const bf16_t*)(ws + WS_W_IN0); p.xstat = xstat; p.qg = a.in[I_AQG]; p.kg = a.in[I_AKG];
          p.Q = (bf16_t*)(ar + AR_Q); p.Kq = (bf16_t*)(ar + AR_K); p.V = (bf16_t*)(ar + AR_V); p.XB = (bf16_t*)(ar + AR_XB); p.GATE = (bf16_t*)(ar + AR_GATE); p.lda = D; p.ldb = D; p.K = D;
          run_gemm(lds, p); }
        { PMemKV m; m.nM = 8; m.nN = 16; m.A = (const bf16_t*)(ws + WS_MEMB); m.W = (const bf16_t*)(ws + WS_W_KV); m.memstat = (const float*)(ws + WS_MISC + MISC_MEMSTAT);
          m.k2stat_ = (float*)(ws + WS_MISC + MISC_K2STAT); m.K2_ = (bf16_t*)(ws + WS_K2); m.V2T_ = (bf16_t*)(ws + WS_ARENA + AR_V2TMP); m.lda = D; m.ldb = D; m.K = D;
          run_gemm(lds, m); }
        SYNC(1);
    }
    PH(2) { phase_k2fin(a); phase_lru(a, lds, 0); SYNC(2); }
    PH(3) { phase_lru(a, lds, 1); phase_attn_naive(a); SYNC(3); }
    PH(4) { PResid p; p.nM = T / 256; p.nN = 4; p.A = (const bf16_t*)(ar + AR_AR); p.W = (const bf16_t*)(ws + WS_W_OUT0); p.X = X; p.xstat = xstat; p.lda = D; p.ldb = D; p.K = D; run_gemm(lds, p); SYNC(4); }
    layer_tail<0>(a, lds, 5);
    PH(14) { conv_moe_layer(a, 1, lds);
        PInProj1 p; p.nM = T / 256; p.nN = 16; p.X = X; p.W = (const bf16_t*)(ws + WS_W_IN1); p.xstat = xstat; p.bias = a.in[I_CBIN]; p.Ub = (bf16_t*)(ar + AR_U); p.V3 = (bf16_t*)(ar + AR_V3); p.vstat = (float*)(ws + WS_VSTAT); p.lda = D; p.ldb = D; p.K = D;
        __syncthreads(); run_gemm(lds, p); SYNC(14); }
    PH(15) { phase_mix_naive(a, lds); SYNC(15); }
    PH(16) { PResid p; p.nM = T / 256; p.nN = 4; p.A = (const bf16_t*)(ar + AR_U); p.W = (const bf16_t*)(ws + WS_W_OUT1); p.X = X; p.xstat = xstat; p.lda = CW; p.ldb = CW; p.K = CW; run_gemm(lds, p); SYNC(16); }
    layer_tail<1>(a, lds, 17);
}

extern "C" void kernel_launch(void* const* d_in, const int* in_sizes, int n_in, void* d_out, int out_size, void* d_ws, size_t ws_size, hipStream_t stream) {
    static int grid = 0;
    if (grid == 0) {
        if (n_in != 36 || out_size != T * D || ws_size < WS_END) { fprintf(stderr, "kernel_launch: unexpected sizes n_in %d out %d ws %zu\n", n_in, out_size, ws_size); grid = -1; return; }
        int dev = 0, cus = 0, per_cu = 0;
        hipGetDevice(&dev); hipDeviceGetAttribute(&cus, hipDeviceAttributeMultiprocessorCount, dev);
        hipFuncSetAttribute((const void*)fwd_kernel, hipFuncAttributeMaxDynamicSharedMemorySize, LDS_BYTES);
        hipOccupancyMaxActiveBlocksPerMultiprocessor(&per_cu, (const void*)fwd_kernel, NTHREADS, LDS_BYTES);
        if (per_cu < 1) { fprintf(stderr, "kernel_launch: occupancy query says %d blocks per CU\n", per_cu); per_cu = 1; }
        (void)hipGetLastError();
        grid = cus;
    }
    if (grid < 0) return;
    hipMemsetAsync((char*)d_ws + WS_CTL, 0, 4096, stream);
    Args a{};
    for (int i = 0; i < 36; ++i) a.in[i] = (const float*)d_in[i];
    a.out = (float*)d_out; a.ws = (unsigned char*)d_ws;
#if ONE_LAUNCH
    a.ph_lo = 0; a.ph_hi = NPHASES;
    void* args[] = {&a};
    hipError_t e = hipLaunchCooperativeKernel((const void*)fwd_kernel, dim3(grid), dim3(NTHREADS), args, LDS_BYTES, stream);
    if (e != hipSuccess) fprintf(stderr, "cooperative launch failed: %s (grid %d)\n", hipGetErrorString(e), grid);
#else
    for (int ph = 0; ph < NPHASES; ++ph) { a.ph_lo = ph; a.ph_hi = ph + 1; hipLaunchKernelGGL(fwd_kernel, dim3(grid), dim3(NTHREADS), LDS_BYTES, stream, a); }
#endif
}
```

```cpp
#include <hip/hip_runtime.h>
#include <hip/hip_cooperative_groups.h>
#include <cstdint>
#include <cstdio>
namespace cg = cooperative_groups;

#ifndef FAST_CORE
#define FAST_CORE 1
#endif
#ifndef FAST_ATTN
#define FAST_ATTN 1
#endif
#ifndef ATTN_THRL
#define ATTN_THRL 32
#endif
#ifndef ONLY_PHASE2
#define ONLY_PHASE2 -1
#endif
#ifndef ONE_LAUNCH
#define ONE_LAUNCH 1
#endif

#define LAS __attribute__((address_space(3)))
typedef unsigned short bf16_t;
typedef short bf16x8 __attribute__((ext_vector_type(8)));
typedef float f32x4 __attribute__((ext_vector_type(4)));
typedef float f32x2 __attribute__((ext_vector_type(2)));
typedef unsigned u32x4 __attribute__((ext_vector_type(4)));
typedef unsigned u32x2 __attribute__((ext_vector_type(2)));

constexpr int NB = 8, SEQ = 4096, T = NB * SEQ, D = 1024;
constexpr int AH = 8, HD = 64, AW = 512, BW = 512;
constexpr int INAB = 2568;
constexpr int CW = 2048, CG = 8, CCH = 128;
constexpr int MEML = 256, XH = 4, XHD = 256;
constexpr int NGRP = 4, EPG = 8, NEXP = 32, DEXP = 512;
constexpr float EPS = 1e-6f;
constexpr float LOG2E = 1.4426950408889634f;
constexpr float C2 = 0.125f * LOG2E;
constexpr float C3 = 0.0625f * LOG2E;
constexpr int NTHREADS = 512, NWAVES = 8;
constexpr int LDS_BYTES = 147456;

constexpr size_t MiB = 1ull << 20;
constexpr size_t WS_CTL = 0;
constexpr size_t WS_W_IN0 = 1 * MiB, WS_W_OUT0 = 6 * MiB, WS_W_IN1 = 8 * MiB, WS_W_OUT1 = 16 * MiB;
constexpr size_t WS_W_Q = 20 * MiB, WS_W_KV = 24 * MiB, WS_W_O = 32 * MiB, WS_W_R = 36 * MiB, WS_TRIL = 37 * MiB;
constexpr size_t WS_W_GU = 38 * MiB, WS_W_DN = 102 * MiB;
constexpr size_t WS_X = 134 * MiB, WS_MEMB = 198 * MiB, WS_K2 = 202 * MiB, WS_V2T = 210 * MiB;
constexpr size_t WS_XSTAT = 218 * MiB, WS_VSTAT = 220 * MiB, WS_QSTAT = 224 * MiB, WS_PSUM = 226 * MiB;
constexpr size_t WS_FLOG = 228 * MiB, WS_CSUM = 229 * MiB, WS_LSUM = 230 * MiB, WS_MISC = 231 * MiB;
constexpr size_t WS_RLOG = 232 * MiB, WS_PAIRW = 238 * MiB, WS_LIST = 239 * MiB, WS_ARENA = 248 * MiB, WS_END = 504 * MiB;
constexpr size_t AR_Q = 0, AR_K = 32 * MiB, AR_V = 64 * MiB, AR_XB = 96 * MiB, AR_GATE = 128 * MiB, AR_AR = 160 * MiB;
constexpr size_t AR_V2TMP = 224 * MiB;
constexpr size_t AR_Q2 = 0, AR_P = 64 * MiB, AR_O = 128 * MiB;
constexpr size_t AR_H = 0, AR_Y = 64 * MiB;
constexpr size_t AR_U = 0, AR_V3 = 128 * MiB;
constexpr size_t MISC_MEMSTAT = 0, MISC_K2STAT = 65536;

struct Args { const float* in[36]; float* out; unsigned char* ws; int ph_lo, ph_hi; };
enum { I_X = 0, I_MEM, I_NMIX, I_NCROSS, I_NMEM, I_NFFN, I_ABWIN, I_FBIAS, I_AQG, I_AKG, I_CONVW, I_CONVB, I_WA, I_BA, I_WX, I_BX, I_LAM, I_ABWOUT,
       I_CWIN, I_CBIN, I_CVG, I_CWS, I_CBS, I_CWOUT, I_XWQ, I_XWKV, I_XWO, I_XQG, I_XKG, I_MWG, I_MBG, I_MWE, I_MBE, I_MGATE, I_MUP, I_MDOWN };

__device__ __forceinline__ float bf_lo(unsigned u) { return __uint_as_float(u << 16); }
__device__ __forceinline__ float bf_hi(unsigned u) { return __uint_as_float(u & 0xffff0000u); }
__device__ __forceinline__ float bf2f(bf16_t v) { return __uint_as_float((unsigned)v << 16); }
__device__ __forceinline__ unsigned pk2(float lo, float hi) { typedef __bf16 bf2_t __attribute__((ext_vector_type(2))); f32x2 v = {lo, hi}; bf2_t b = __builtin_convertvector(v, bf2_t); return __builtin_bit_cast(unsigned, b); }
__device__ __forceinline__ bf16_t f2bf(float f) { return (bf16_t)(pk2(f, 0.f) & 0xffffu); }
__device__ __forceinline__ float wave_sum(float v) {
#pragma unroll
    for (int o = 1; o < 64; o <<= 1) v += __shfl_xor(v, o);
    return v;
}
__device__ __forceinline__ float gelu_tanh(float x) { const float u = 0.7978845608028654f * (x + 0.044715f * x * x * x); return x / (1.f + __expf(-2.f * u)); }
__device__ __forceinline__ float sigmoidf(float x) { return 1.f / (1.f + __expf(-x)); }
__device__ __forceinline__ float sum16(const float* p) { const f32x4 a = *(const f32x4*)p, b = *(const f32x4*)(p + 4), c = *(const f32x4*)(p + 8), d = *(const f32x4*)(p + 12);
    return ((a.x + a.y) + (a.z + a.w)) + ((b.x + b.y) + (b.z + b.w)) + ((c.x + c.y) + (c.z + c.w)) + ((d.x + d.y) + (d.z + d.w)); }
__device__ __forceinline__ int perm32(int rho) { const int n = rho >> 4, i = rho & 15; return 8 * (i >> 2) + 4 * n + (i & 3); }

struct U { int pm, pn, e, cnt; };
__device__ __forceinline__ int brow_std(int bj, int S) { return 64 * (S >> 5) + 32 * bj + perm32(S & 31); }
typedef f32x4 Acc[2][2][4][2];

template <class P> __device__ __forceinline__ void gemm_naive(const P& p) {
    const int tid = threadIdx.x, wid = tid >> 6, lane = tid & 63, wr = wid >> 2, wc = wid & 3, fr = lane & 15, fq = lane >> 4;
    for (int i = 0;; ++i) {
        U u; if (!p.unit(i * (int)gridDim.x + (int)blockIdx.x, u)) break;
        Acc acc;
#pragma unroll
        for (int a = 0; a < 2; ++a)
#pragma unroll
            for (int b = 0; b < 2; ++b)
#pragma unroll
                for (int m = 0; m < 4; ++m)
#pragma unroll
                    for (int n = 0; n < 2; ++n) acc[a][b][m][n] = (f32x4){0.f, 0.f, 0.f, 0.f};
        const bf16_t* A = p.a_ptr(u); const bf16_t* B = p.b_ptr(u); const int lda = p.lda, ldb = p.ldb, K = p.K;
        unsigned aoff[8], boff[16];
#pragma unroll
        for (int ai = 0; ai < 2; ++ai)
#pragma unroll
            for (int m = 0; m < 4; ++m) aoff[ai * 4 + m] = (unsigned)p.a_row(u, 128 * ai + 64 * wr + 16 * m + fr) * (unsigned)lda;
#pragma unroll
        for (int bj = 0; bj < 2; ++bj)
#pragma unroll
            for (int n = 0; n < 2; ++n)
#pragma unroll
                for (int e = 0; e < 4; ++e) boff[bj * 8 + n * 4 + e] = (unsigned)P::b_row(bj, 32 * wc + 16 * n + 4 * fq + e) * (unsigned)ldb;
        for (int k0 = 0; k0 < K; k0 += 2) {
            float af[8][2];
#pragma unroll
            for (int r = 0; r < 8; ++r) { const unsigned v = *(const unsigned*)(A + aoff[r] + k0); af[r][0] = bf_lo(v); af[r][1] = bf_hi(v); }
#pragma unroll
            for (int bj = 0; bj < 2; ++bj)
#pragma unroll
                for (int n = 0; n < 2; ++n)
#pragma unroll
                    for (int e = 0; e < 4; ++e) {
                        const unsigned v = *(const unsigned*)(B + boff[bj * 8 + n * 4 + e] + k0);
                        const float b0 = bf_lo(v), b1 = bf_hi(v);
#pragma unroll
                        for (int ai = 0; ai < 2; ++ai)
#pragma unroll
                            for (int m = 0; m < 4; ++m) { const float* x = af[ai * 4 + m]; acc[ai][bj][m][n][e] += x[0] * b0 + x[1] * b1; }
                    }
        }
        p.epi(acc, u, wr, wc, fr, fq);
    }
}

struct PlainSched {
    int nM, nN;
    __device__ __forceinline__ bool unit(int L, U& u) const { if (L >= nM * nN) return false; u.pm = L / nN; u.pn = L - u.pm * nN; u.e = 0; u.cnt = 0; return true; }
};

struct PInProj0 : PlainSched {
    static constexpr bool GATHER = false; static constexpr int ID = 0;
    const bf16_t* X; const bf16_t* W; const float* xstat; const float* qg; const float* kg; bf16_t *Q, *Kq, *V, *XB, *GATE; int lda, ldb, K;
    __device__ __forceinline__ const bf16_t* a_ptr(const U& u) const { return X + (size_t)u.pm * 256 * D; }
    __device__ __forceinline__ int a_row(const U&, int R) const { return R; }
    __device__ __forceinline__ const bf16_t* b_ptr(const U& u) const { return W + (size_t)u.pn * 256 * D; }
    static __device__ __forceinline__ int b_row(int bj, int S) { return brow_std(bj, S); }
    __device__ __forceinline__ void epi(Acc& acc, const U& u, int wr, int wc, int fr, int fq) const {
        const int kind = u.pn >> 1, half = u.pn & 1;
        bf16_t* dst = kind == 0 ? Q : kind == 1 ? Kq : kind == 2 ? V : kind == 3 ? XB : GATE;
        const float* gain = kind == 0 ? qg : kg;
        float sc[8];
#pragma unroll
        for (int ai = 0; ai < 2; ++ai)
#pragma unroll
            for (int m = 0; m < 4; ++m) {
                const int row = u.pm * 256 + 128 * ai + 64 * wr + 16 * m + fr;
                const float s = rsqrtf(sum16(xstat + (size_t)row * 16) * (1.f / D) + EPS);
                float r = s;
                if (kind <= 1) {
                    float ss = 0.f;
#pragma unroll
                    for (int bj = 0; bj < 2; ++bj)
#pragma unroll
                        for (int n = 0; n < 2; ++n)
#pragma unroll
                            for (int e = 0; e < 4; ++e) { const float v = acc[ai][bj][m][n][e] * s; ss += v * v; }
                    ss += __shfl_xor(ss, 16); ss += __shfl_xor(ss, 32);
                    r = s * rsqrtf(ss * (1.f / HD) + EPS) * (kind == 0 ? C2 : 1.f);
                }
                sc[ai * 4 + m] = r;
            }
#pragma unroll
        for (int bj = 0; bj < 2; ++bj) {
            float g[8];
#pragma unroll
            for (int j = 0; j < 8; ++j) g[j] = kind <= 1 ? gain[32 * bj + 8 * fq + j] : 1.f;
#pragma unroll
            for (int ai = 0; ai < 2; ++ai)
#pragma unroll
                for (int m = 0; m < 4; ++m) {
                    const int row = u.pm * 256 + 128 * ai + 64 * wr + 16 * m + fr;
                    float v[8];
#pragma unroll
                    for (int j = 0; j < 8; ++j) v[j] = acc[ai][bj][m][j >> 2][j & 3] * sc[ai * 4 + m] * g[j];
                    if (kind == 4) {
#pragma unroll
                        for (int j = 0; j < 8; ++j) v[j] = gelu_tanh(v[j]);
                    }
                    u32x4 w; w.x = pk2(v[0], v[1]); w.y = pk2(v[2], v[3]); w.z = pk2(v[4], v[5]); w.w = pk2(v[6], v[7]);
                    *(u32x4*)(dst + (size_t)row * 512 + 256 * half + 64 * wc + 32 * bj + 8 * fq) = w;
                }
        }
    }
};

struct PMemKV : PlainSched {
    static constexpr bool GATHER = false; static constexpr int ID = 1;
    const bf16_t* A; const bf16_t* W; const float* memstat; float* k2stat_; bf16_t* K2_; bf16_t* V2T_; int lda, ldb, K;
    __device__ __forceinline__ const bf16_t* a_ptr(const U& u) const { return A + (size_t)u.pm * 256 * D; }
    __device__ __forceinline__ int a_row(const U&, int R) const { return R; }
    __device__ __forceinline__ const bf16_t* b_ptr(const U& u) const { return W + (size_t)u.pn * 256 * D; }
    static __device__ __forceinline__ int b_row(int bj, int S) { return brow_std(bj, S); }
    __device__ __forceinline__ void epi(Acc& acc, const U& u, int wr, int wc, int fr, int fq) const {
        const int b = u.pm, h = u.pn & 3, ly = u.pn >> 3; const bool isv = (u.pn & 4) != 0;
        float* k2stat = k2stat_ + (size_t)ly * 2048 * 16; bf16_t* K2 = K2_ + (size_t)ly * 2048 * 1024; bf16_t* V2T = V2T_ + (size_t)ly * 2048 * 1024;
        bf16_t* dst = (isv ? V2T : K2) + (size_t)(b * 4 + h) * 65536;
        int lrow = 64 * wr + fr; asm volatile("" : "+v"(lrow));
#pragma unroll
        for (int ai = 0; ai < 2; ++ai)
#pragma unroll
            for (int m = 0; m < 4; ++m) {
                const int key = 128 * ai + 16 * m + lrow, row = b * 256 + key;
                const float s = rsqrtf(memstat[row] * (1.f / D) + EPS);
                float ss = 0.f;
#pragma unroll
                for (int bj = 0; bj < 2; ++bj) {
                    float v[8];
#pragma unroll
                    for (int j = 0; j < 8; ++j) { v[j] = acc[ai][bj][m][j >> 2][j & 3] * s; ss += v[j] * v[j]; }
                    u32x4 w; w.x = pk2(v[0], v[1]); w.y = pk2(v[2], v[3]); w.z = pk2(v[4], v[5]); w.w = pk2(v[6], v[7]);
                    *(u32x4*)(dst + (size_t)key * 256 + 64 * wc + 32 * bj + 8 * fq) = w;
                }
                ss += __shfl_xor(ss, 16); ss += __shfl_xor(ss, 32);
                if (fq == 0 && !isv) k2stat[(size_t)row * 16 + 4 * h + wc] = ss;
            }
    }
};

struct PResid : PlainSched {
    static constexpr bool GATHER = false; static constexpr int ID = 2;
    const bf16_t* A; const bf16_t* W; bf16_t* X; float* xstat; int lda, ldb, K;
    __device__ __forceinline__ const bf16_t* a_ptr(const U& u) const { return A + (size_t)u.pm * 256 * lda; }
    __device__ __forceinline__ int a_row(const U&, int R) const { return R; }
    __device__ __forceinline__ const bf16_t* b_ptr(const U& u) const { return W + (size_t)u.pn * 256 * ldb; }
    static __device__ __forceinline__ int b_row(int bj, int S) { return brow_std(bj, S); }
    __device__ __forceinline__ void epi(Acc& acc, const U& u, int wr, int wc, int fr, int fq) const {
#pragma unroll
        for (int ai = 0; ai < 2; ++ai)
#pragma unroll
            for (int m = 0; m < 4; ++m) {
                const int row = u.pm * 256 + 128 * ai + 64 * wr + 16 * m + fr; float ss = 0.f;
#pragma unroll
                for (int bj = 0; bj < 2; ++bj) {
                    bf16_t* xp = X + (size_t)row * D + 256 * u.pn + 64 * wc + 32 * bj + 8 * fq;
                    const u32x4 o = *(const u32x4*)xp;
                    float v[8] = {bf_lo(o.x), bf_hi(o.x), bf_lo(o.y), bf_hi(o.y), bf_lo(o.z), bf_hi(o.z), bf_lo(o.w), bf_hi(o.w)};
#pragma unroll
                    for (int n = 0; n < 2; ++n)
#pragma unroll
                        for (int e = 0; e < 4; ++e) v[n * 4 + e] += acc[ai][bj][m][n][e];
                    u32x4 w; w.x = pk2(v[0], v[1]); w.y = pk2(v[2], v[3]); w.z = pk2(v[4], v[5]); w.w = pk2(v[6], v[7]);
                    *(u32x4*)xp = w;
                    const float r[8] = {bf_lo(w.x), bf_hi(w.x), bf_lo(w.y), bf_hi(w.y), bf_lo(w.z), bf_hi(w.z), bf_lo(w.w), bf_hi(w.w)};
#pragma unroll
                    for (int j = 0; j < 8; ++j) ss += r[j] * r[j];
                }
                ss += __shfl_xor(ss, 16); ss += __shfl_xor(ss, 32);
                if (fq == 0) xstat[(size_t)row * 16 + 4 * u.pn + wc] = ss;
            }
    }
};

struct PCrossQ : PlainSched {
    static constexpr bool GATHER = false; static constexpr int ID = 3;
    const bf16_t* X; const bf16_t* W; const float* xstat; bf16_t* Q2; float* qstat; int lda, ldb, K;
    __device__ __forceinline__ const bf16_t* a_ptr(const U& u) const { return X + (size_t)u.pm * 256 * D; }
    __device__ __forceinline__ int a_row(const U&, int R) const { return R; }
    __device__ __forceinline__ const bf16_t* b_ptr(const U& u) const { return W + (size_t)u.pn * 256 * D; }
    static __device__ __forceinline__ int b_row(int bj, int S) { return brow_std(bj, S); }
    __device__ __forceinline__ void epi(Acc& acc, const U& u, int wr, int wc, int fr, int fq) const {
#pragma unroll
        for (int ai = 0; ai < 2; ++ai)
#pragma unroll
            for (int m = 0; m < 4; ++m) {
                const int row = u.pm * 256 + 128 * ai + 64 * wr + 16 * m + fr; float ss = 0.f;
                const float s = rsqrtf(sum16(xstat + (size_t)row * 16) * (1.f / D) + EPS);
#pragma unroll
                for (int bj = 0; bj < 2; ++bj) {
                    float v[8];
#pragma unroll
                    for (int n = 0; n < 2; ++n)
#pragma unroll
                        for (int e = 0; e < 4; ++e) v[n * 4 + e] = acc[ai][bj][m][n][e] * s;
                    u32x4 w; w.x = pk2(v[0], v[1]); w.y = pk2(v[2], v[3]); w.z = pk2(v[4], v[5]); w.w = pk2(v[6], v[7]);
                    *(u32x4*)(Q2 + (size_t)row * D + 256 * u.pn + 64 * wc + 32 * bj + 8 * fq) = w;
                    const float r[8] = {bf_lo(w.x), bf_hi(w.x), bf_lo(w.y), bf_hi(w.y), bf_lo(w.z), bf_hi(w.z), bf_lo(w.w), bf_hi(w.w)};
#pragma unroll
                    for (int j = 0; j < 8; ++j) ss += r[j] * r[j];
                }
                ss += __shfl_xor(ss, 16); ss += __shfl_xor(ss, 32);
                if (fq == 0) qstat[(size_t)row * 16 + 4 * u.pn + wc] = ss;
            }
    }
};

struct PCrossS : PlainSched {
    static constexpr bool GATHER = false; static constexpr int ID = 4;
    const bf16_t* Q2; const bf16_t* K2; const float* qstat; bf16_t* P; float* psum; int lda, ldb, K;
    __device__ __forceinline__ const bf16_t* a_ptr(const U& u) const { return Q2 + (size_t)u.pm * 256 * D + 256 * u.pn; }
    __device__ __forceinline__ int a_row(const U&, int R) const { return R; }
    __device__ __forceinline__ const bf16_t* b_ptr(const U& u) const { return K2 + (size_t)((u.pm >> 4) * 4 + u.pn) * 65536; }
    static __device__ __forceinline__ int b_row(int bj, int S) { return brow_std(bj, S); }
    __device__ __forceinline__ void epi(Acc& acc, const U& u, int wr, int wc, int fr, int fq) const {
#pragma unroll
        for (int ai = 0; ai < 2; ++ai)
#pragma unroll
            for (int m = 0; m < 4; ++m) {
                const int row = u.pm * 256 + 128 * ai + 64 * wr + 16 * m + fr; float ss = 0.f;
                const f32x4 qs = *(const f32x4*)(qstat + (size_t)row * 16 + 4 * u.pn);
                const float rn = rsqrtf(((qs.x + qs.y) + (qs.z + qs.w)) * (1.f / XHD) + EPS) * C3;
#pragma unroll
                for (int bj = 0; bj < 2; ++bj) {
                    float v[8];
#pragma unroll
                    for (int n = 0; n < 2; ++n)
#pragma unroll
                        for (int e = 0; e < 4; ++e) v[n * 4 + e] = exp2f(acc[ai][bj][m][n][e] * rn);
                    u32x4 w; w.x = pk2(v[0], v[1]); w.y = pk2(v[2], v[3]); w.z = pk2(v[4], v[5]); w.w = pk2(v[6], v[7]);
                    *(u32x4*)(P + (size_t)row * D + 256 * u.pn + 64 * wc + 32 * bj + 8 * fq) = w;
                    const float r[8] = {bf_lo(w.x), bf_hi(w.x), bf_lo(w.y), bf_hi(w.y), bf_lo(w.z), bf_hi(w.z), bf_lo(w.w), bf_hi(w.w)};
#pragma unroll
                    for (int j = 0; j < 8; ++j) ss += r[j];
                }
                ss += __shfl_xor(ss, 16); ss += __shfl_xor(ss, 32);
                if (fq == 0) psum[(size_t)row * 16 + 4 * u.pn + wc] = ss;
            }
    }
};

struct PCrossPV : PlainSched {
    static constexpr bool GATHER = false; static constexpr int ID = 5;
    const bf16_t* P; const bf16_t* V2T; const float* psum; bf16_t* O; int lda, ldb, K;
    __device__ __forceinline__ const bf16_t* a_ptr(const U& u) const { return P + (size_t)u.pm * 256 * D + 256 * u.pn; }
    __device__ __forceinline__ int a_row(const U&, int R) const { return R; }
    __device__ __forceinline__ const bf16_t* b_ptr(const U& u) const { return V2T + (size_t)((u.pm >> 4) * 4 + u.pn) * 65536; }
    static __device__ __forceinline__ int b_row(int bj, int S) { return brow_std(bj, S); }
    __device__ __forceinline__ void epi(Acc& acc, const U& u, int wr, int wc, int fr, int fq) const {
#pragma unroll
        for (int ai = 0; ai < 2; ++ai)
#pragma unroll
            for (int m = 0; m < 4; ++m) {
                const int row = u.pm * 256 + 128 * ai + 64 * wr + 16 * m + fr;
                const f32x4 ps = *(const f32x4*)(psum + (size_t)row * 16 + 4 * u.pn);
                const float inv = 1.f / ((ps.x + ps.y) + (ps.z + ps.w));
#pragma unroll
                for (int bj = 0; bj < 2; ++bj) {
                    float v[8];
#pragma unroll
                    for (int n = 0; n < 2; ++n)
#pragma unroll
                        for (int e = 0; e < 4; ++e) v[n * 4 + e] = acc[ai][bj][m][n][e] * inv;
                    u32x4 w; w.x = pk2(v[0], v[1]); w.y = pk2(v[2], v[3]); w.z = pk2(v[4], v[5]); w.w = pk2(v[6], v[7]);
                    *(u32x4*)(O + (size_t)row * D + 256 * u.pn + 64 * wc + 32 * bj + 8 * fq) = w;
                }
            }
    }
};

struct PRouter : PlainSched {
    static constexpr bool GATHER = false; static constexpr int ID = 6;
    const bf16_t* X; const bf16_t* W; const float* xstat; const float* bg; const float* be; float* rlog; int lda, ldb, K;
    __device__ __forceinline__ const bf16_t* a_ptr(const U& u) const { return X + (size_t)u.pm * 256 * D; }
    __device__ __forceinline__ int a_row(const U&, int R) const { return R; }
    __device__ __forceinline__ const bf16_t* b_ptr(const U&) const { return W; }
    static __device__ __forceinline__ int b_row(int bj, int S) { return brow_std(bj, S); }
    __device__ __forceinline__ void epi(Acc& acc, const U& u, int wr, int wc, int fr, int fq) const {
        if (wc != 0) return;
#pragma unroll
        for (int ai = 0; ai < 2; ++ai)
#pragma unroll
            for (int m = 0; m < 4; ++m) {
                const int row = u.pm * 256 + 128 * ai + 64 * wr + 16 * m + fr;
                const float s = rsqrtf(sum16(xstat + (size_t)row * 16) * (1.f / D) + EPS);
#pragma unroll
                for (int n = 0; n < 2; ++n)
#pragma unroll
                    for (int e = 0; e < 4; ++e) { const int c = 8 * fq + 4 * n + e; rlog[(size_t)row * 40 + c] = acc[ai][0][m][n][e] * s + (c < 4 ? bg[c] : be[c - 4]); }
                if (fq == 0) {
#pragma unroll
                    for (int e = 0; e < 4; ++e) rlog[(size_t)row * 40 + 32 + e] = acc[ai][1][m][0][e] * s + be[28 + e];
                }
            }
    }
};

struct MoeSched {
    const int* cnt; const int* list; volatile LAS int* tpre;
    __device__ __forceinline__ bool unit(int L, U& u) const {
        const int mt = L >> 2; if (mt >= tpre[32]) return false;
        int e = 0;
        for (int j = 1; j < 32; ++j) e = (mt >= tpre[j]) ? j : e;
        u.e = e; u.pm = mt - tpre[e]; u.pn = L & 3; u.cnt = cnt[e]; return true;
    }
    __device__ __forceinline__ int pair_of(const U& u, int R) const { int s = u.pm * 256 + R; s = s < u.cnt ? s : u.cnt - 1; return list[(size_t)u.e * 65536 + s]; }
};
__device__ __forceinline__ void moe_sched_build(const int* cnt, volatile LAS int* tpre) {
    __syncthreads();
    if (threadIdx.x == 0) { int acc = 0; for (int e = 0; e < 32; ++e) { tpre[e] = acc; acc += (cnt[e] + 255) >> 8; } tpre[32] = acc; }
    __syncthreads();
}
struct PMoeUp : MoeSched {
    static constexpr bool GATHER = true; static constexpr int ID = 7;
    const bf16_t* X; const bf16_t* W; const float* xstat; bf16_t* H; int lda, ldb, K;
    __device__ __forceinline__ const bf16_t* a_ptr(const U&) const { return X; }
    __device__ __forceinline__ int a_row(const U& u, int R) const { return pair_of(u, R) >> 1; }
    __device__ __forceinline__ const bf16_t* b_ptr(const U& u) const { return W + (size_t)u.e * (1024 * 1024) + (size_t)u.pn * 128 * 1024; }
    static __device__ __forceinline__ int b_row(int bj, int S) { return 512 * bj + 32 * (S >> 5) + perm32(S & 31); }
    __device__ __forceinline__ void epi(Acc& acc, const U& u, int wr, int wc, int fr, int fq) const {
#pragma unroll
        for (int ai = 0; ai < 2; ++ai)
#pragma unroll
            for (int m = 0; m < 4; ++m) {
                const int pr = pair_of(u, 128 * ai + 64 * wr + 16 * m + fr), tok = pr >> 1;
                const float s = rsqrtf(sum16(xstat + (size_t)tok * 16) * (1.f / D) + EPS);
                float v[8];
#pragma unroll
                for (int n = 0; n < 2; ++n)
#pragma unroll
                    for (int e = 0; e < 4; ++e) { const float g = acc[ai][0][m][n][e] * s, up = acc[ai][1][m][n][e] * s; v[n * 4 + e] = g / (1.f + __expf(-g)) * up; }
                u32x4 w; w.x = pk2(v[0], v[1]); w.y = pk2(v[2], v[3]); w.z = pk2(v[4], v[5]); w.w = pk2(v[6], v[7]);
                *(u32x4*)(H + (size_t)pr * DEXP + 128 * u.pn + 32 * wc + 8 * fq) = w;
            }
    }
};
struct PMoeDown : MoeSched {
    static constexpr bool GATHER = true; static constexpr int ID = 8;
    const bf16_t* H; const bf16_t* W; const float* pairw; bf16_t* Y; int lda, ldb, K;
    __device__ __forceinline__ const bf16_t* a_ptr(const U&) const { return H; }
    __device__ __forceinline__ int a_row(const U& u, int R) const { return pair_of(u, R); }
    __device__ __forceinline__ const bf16_t* b_ptr(const U& u) const { return W + (size_t)u.e * (1024 * 512) + (size_t)u.pn * 256 * 512; }
    static __device__ __forceinline__ int b_row(int bj, int S) { return brow_std(bj, S); }
    __device__ __forceinline__ void epi(Acc& acc, const U& u, int wr, int wc, int fr, int fq) const {
#pragma unroll
        for (int ai = 0; ai < 2; ++ai)
#pragma unroll
            for (int m = 0; m < 4; ++m) {
                const int pr = pair_of(u, 128 * ai + 64 * wr + 16 * m + fr); const float wgt = pairw[pr];
#pragma unroll
                for (int bj = 0; bj < 2; ++bj) {
                    float v[8];
#pragma unroll
                    for (int n = 0; n < 2; ++n)
#pragma unroll
                        for (int e = 0; e < 4; ++e) v[n * 4 + e] = acc[ai][bj][m][n][e] * wgt;
                    u32x4 w; w.x = pk2(v[0], v[1]); w.y = pk2(v[2], v[3]); w.z = pk2(v[4], v[5]); w.w = pk2(v[6], v[7]);
                    *(u32x4*)(Y + (size_t)pr * D + 256 * u.pn + 64 * wc + 32 * bj + 8 * fq) = w;
                }
            }
    }
};
struct PInProj1 : PlainSched {
    static constexpr bool GATHER = false; static constexpr int ID = 9;
    const bf16_t* X; const bf16_t* W; const float* xstat; const float* bias; bf16_t* Ub; bf16_t* V3; float* vstat; int lda, ldb, K;
    __device__ __forceinline__ const bf16_t* a_ptr(const U& u) const { return X + (size_t)u.pm * 256 * D; }
    __device__ __forceinline__ int a_row(const U&, int R) const { return R; }
    __device__ __forceinline__ const bf16_t* b_ptr(const U& u) const { return W + (size_t)u.pn * 256 * D; }
    static __device__ __forceinline__ int b_row(int bj, int S) { return brow_std(bj, S); }
    __device__ __forceinline__ void epi(Acc& acc, const U& u, int wr, int wc, int fr, int fq) const {
        const bool isv = u.pn >= 8; const int pn8 = u.pn & 7; bf16_t* dst = isv ? V3 : Ub;
#pragma unroll
        for (int ai = 0; ai < 2; ++ai)
#pragma unroll
            for (int m = 0; m < 4; ++m) {
                const int row = u.pm * 256 + 128 * ai + 64 * wr + 16 * m + fr; float ss = 0.f;
                const float s = rsqrtf(sum16(xstat + (size_t)row * 16) * (1.f / D) + EPS);
#pragma unroll
                for (int bj = 0; bj < 2; ++bj) {
                    const int lc = 64 * wc + 32 * bj + 8 * fq;
                    const f32x4 b0 = *(const f32x4*)(bias + 256 * u.pn + lc), b1 = *(const f32x4*)(bias + 256 * u.pn + lc + 4);
                    float v[8];
#pragma unroll
                    for (int e = 0; e < 4; ++e) { v[e] = gelu_tanh(acc[ai][bj][m][0][e] * s + b0[e]); v[4 + e] = gelu_tanh(acc[ai][bj][m][1][e] * s + b1[e]); }
                    u32x4 w; w.x = pk2(v[0], v[1]); w.y = pk2(v[2], v[3]); w.z = pk2(v[4], v[5]); w.w = pk2(v[6], v[7]);
                    *(u32x4*)(dst + (size_t)row * CW + 256 * pn8 + lc) = w;
                    const float r[8] = {bf_lo(w.x), bf_hi(w.x), bf_lo(w.y), bf_hi(w.y), bf_lo(w.z), bf_hi(w.z), bf_lo(w.w), bf_hi(w.w)};
#pragma unroll
                    for (int j = 0; j < 8; ++j) ss += r[j] * r[j];
                }
                if (isv) { ss += __shfl_xor(ss, 16); ss += __shfl_xor(ss, 32); if (fq == 0) vstat[(size_t)row * 32 + 4 * pn8 + wc] = ss; }
            }
    }
};

__device__ __forceinline__ int lds_byte(int r, int c) { const int st = (r >> 4) * 2 + (c >> 5), rr = r & 15, cc = c & 31, ob = rr * 64 + cc * 2; return st * 1024 + (ob ^ (((ob >> 9) & 1) << 5)); }
__device__ __forceinline__ void stage_rc(int b, int& R, int& C) { const int st = b / 1024, sb = b % 1024, swz = sb ^ (((sb >> 9) & 1) << 5); R = (st >> 1) * 16 + swz / 64; C = (st & 1) * 32 + (swz % 64) / 2; }

template <class P> __device__ __forceinline__ void gemm_fast(LAS unsigned char* lds, const P& p) {
    constexpr int HTB = 16384;
    const int tid = threadIdx.x, wid = __builtin_amdgcn_readfirstlane(tid >> 6), lane = tid & 63, wr = wid >> 2, wc = wid & 3, fr = lane & 15, fq = lane >> 4;
    const int K = p.K, nt = K / 64, lda = p.lda, ldb = p.ldb;
    const int G = (int)gridDim.x, cu = (int)blockIdx.x;
    int Rs[2], Cs[2];
#pragma unroll
    for (int i = 0; i < 2; ++i) stage_rc(tid * 16 + i * 8192, Rs[i], Cs[i]);
    unsigned boffs[4];
#pragma unroll
    for (int bj = 0; bj < 2; ++bj)
#pragma unroll
        for (int i = 0; i < 2; ++i) boffs[bj * 2 + i] = (unsigned)(P::b_row(bj, Rs[i]) * ldb + Cs[i]) * 2u;
    const unsigned ldsw = (unsigned)wid * 1024u;
    const int aoff_l = lds_byte(wr * 64 + fr, fq * 8), boff_l = lds_byte(wc * 32 + fr, fq * 8);
#define GF_SA(b, h) (((b) * 2 + (h)) * HTB)
#define GF_SB(b, h) ((4 + (b) * 2 + (h)) * HTB)
#define GF_STAGE(bufoff, gbase, o0, o1) do { \
        __builtin_amdgcn_global_load_lds((const unsigned*)((const char*)(gbase) + (o0)), (LAS unsigned*)(lds + (bufoff) + ldsw), 16, 0, 0); \
        __builtin_amdgcn_global_load_lds((const unsigned*)((const char*)(gbase) + (o1)), (LAS unsigned*)(lds + (bufoff) + ldsw + 8192), 16, 0, 0); } while (0)
#define GF_LDA(dst, b, h) do { _Pragma("unroll") for (int m = 0; m < 4; ++m) _Pragma("unroll") for (int k = 0; k < 2; ++k) dst[m][k] = *(const LAS bf16x8*)(lds + GF_SA(b, h) + aoff_l + m * 2048 + k * 1024); } while (0)
#define GF_LDB(dst, b, h) do { _Pragma("unroll") for (int n = 0; n < 2; ++n) _Pragma("unroll") for (int k = 0; k < 2; ++k) dst[n][k] = *(const LAS bf16x8*)(lds + GF_SB(b, h) + boff_l + n * 2048 + k * 1024); } while (0)
#define GF_MMA(ai, bj, At, Bt) do { __builtin_amdgcn_s_setprio(1); _Pragma("unroll") for (int m = 0; m < 4; ++m) _Pragma("unroll") for (int n = 0; n < 2; ++n) _Pragma("unroll") for (int k = 0; k < 2; ++k) \
        acc[ai][bj][m][n] = __builtin_amdgcn_mfma_f32_16x16x32_bf16(Bt[n][k], At[m][k], acc[ai][bj][m][n], 0, 0, 0); __builtin_amdgcn_s_setprio(0); } while (0)
#define GF_WAIT_V(n) asm volatile("s_waitcnt vmcnt(" #n ")" ::: "memory")
#define GF_WAIT_L(n) asm volatile("s_waitcnt lgkmcnt(" #n ")" ::: "memory")
#define GF_BAR __builtin_amdgcn_s_barrier()
#define GF_SCHED __builtin_amdgcn_sched_barrier(0)
#define GF_AOFFS(dst, u) do { _Pragma("unroll") for (int h = 0; h < 2; ++h) _Pragma("unroll") for (int i = 0; i < 2; ++i) dst[h * 2 + i] = (unsigned)(p.a_row(u, 128 * h + Rs[i]) * lda + Cs[i]) * 2u; } while (0)
    U cur, nxt; int ui = 0;
    if (!p.unit(cu, cur)) return;
    Acc acc;
#pragma unroll
    for (int a = 0; a < 2; ++a)
#pragma unroll
        for (int b = 0; b < 2; ++b)
#pragma unroll
            for (int m = 0; m < 4; ++m)
#pragma unroll
                for (int n = 0; n < 2; ++n) acc[a][b][m][n] = (f32x4){0.f, 0.f, 0.f, 0.f};
    bf16x8 At[4][2], B0[2][2], B1[2][2];
    unsigned aoffs[4], naoffs[4];
    GF_AOFFS(aoffs, cur);
    const char* cA = (const char*)p.a_ptr(cur); const char* cB = (const char*)p.b_ptr(cur);
    GF_STAGE(GF_SB(0, 0), cB, boffs[0], boffs[1]); GF_STAGE(GF_SB(0, 1), cB, boffs[2], boffs[3]); GF_STAGE(GF_SA(0, 0), cA, aoffs[0], aoffs[1]); GF_STAGE(GF_SA(0, 1), cA, aoffs[2], aoffs[3]);
    if (wr == 1) GF_BAR;
    GF_WAIT_V(2); GF_BAR;
    GF_STAGE(GF_SB(1, 0), cB + 128, boffs[0], boffs[1]); GF_STAGE(GF_SA(1, 0), cA + 128, aoffs[0], aoffs[1]); GF_STAGE(GF_SB(1, 1), cB + 128, boffs[2], boffs[3]);
    GF_WAIT_V(6); GF_BAR;
    for (;;) {
        const bool has_next = p.unit((ui + 1) * G + cu, nxt);
        const char* nA = cA; const char* nB = cB;
#pragma unroll
        for (int j = 0; j < 4; ++j) naoffs[j] = aoffs[j];
        if (has_next) { nA = (const char*)p.a_ptr(nxt); nB = (const char*)p.b_ptr(nxt); if (P::GATHER) GF_AOFFS(naoffs, nxt); }
        for (int t = 0; t < nt; t += 2) {
            const bool last = (t == nt - 2);
            const char* a1 = cA + (size_t)(t + 1) * 128;
            const char* a2 = last ? nA : cA + (size_t)(t + 2) * 128; const char* b2 = last ? nB : cB + (size_t)(t + 2) * 128;
            const char* a3 = a2 + 128; const char* b3 = b2 + 128;
            unsigned o[4];
#pragma unroll
            for (int j = 0; j < 4; ++j) o[j] = (P::GATHER && last) ? naoffs[j] : aoffs[j];
            GF_LDB(B0, 0, 0); GF_LDB(B1, 0, 1); GF_SCHED; GF_LDA(At, 0, 0); GF_STAGE(GF_SA(1, 1), a1, aoffs[2], aoffs[3]);
            GF_WAIT_V(8); GF_WAIT_L(0); GF_BAR; GF_MMA(0, 0, At, B0); GF_MMA(0, 1, At, B1); GF_BAR; GF_SCHED;
            GF_LDA(At, 0, 1); GF_STAGE(GF_SB(0, 0), b2, boffs[0], boffs[1]); GF_STAGE(GF_SB(0, 1), b2, boffs[2], boffs[3]); GF_STAGE(GF_SA(0, 0), a2, o[0], o[1]);
            GF_WAIT_V(8); GF_WAIT_L(0); GF_BAR; GF_MMA(1, 0, At, B0); GF_MMA(1, 1, At, B1); GF_BAR; GF_SCHED;
            GF_LDB(B0, 1, 0); GF_LDB(B1, 1, 1); GF_SCHED; GF_LDA(At, 1, 0); GF_STAGE(GF_SA(0, 1), a2, o[2], o[3]);
            GF_WAIT_V(8); GF_WAIT_L(0); GF_BAR; GF_MMA(0, 0, At, B0); GF_MMA(0, 1, At, B1); GF_BAR; GF_SCHED;
            GF_LDA(At, 1, 1); GF_STAGE(GF_SB(1, 0), b3, boffs[0], boffs[1]); GF_STAGE(GF_SB(1, 1), b3, boffs[2], boffs[3]); GF_STAGE(GF_SA(1, 0), a3, o[0], o[1]);
            GF_WAIT_V(8); GF_WAIT_L(0); GF_BAR; GF_MMA(1, 0, At, B0); GF_MMA(1, 1, At, B1); GF_BAR; GF_SCHED;
        }
        if (wr == 0) GF_BAR;
        p.epi(acc, cur, wr, wc, fr, fq);
        if (!has_next) break;
#pragma unroll
        for (int a = 0; a < 2; ++a)
#pragma unroll
            for (int b = 0; b < 2; ++b)
#pragma unroll
                for (int m = 0; m < 4; ++m)
#pragma unroll
                    for (int n = 0; n < 2; ++n) acc[a][b][m][n] = (f32x4){0.f, 0.f, 0.f, 0.f};
        cur = nxt; cA = nA; cB = nB; ++ui;
#pragma unroll
        for (int j = 0; j < 4; ++j) aoffs[j] = naoffs[j];
        if (wr == 1) GF_BAR;
    }
    GF_WAIT_V(0);
    GF_BAR;
#undef GF_SA
#undef GF_SB
#undef GF_STAGE
#undef GF_LDA
#undef GF_LDB
#undef GF_MMA
#undef GF_WAIT_V
#undef GF_WAIT_L
#undef GF_BAR
#undef GF_SCHED
#undef GF_AOFFS
}

#ifndef FAST_MASK
#define FAST_MASK 0xffffffffu
#endif
template <class P> __device__ __forceinline__ void run_gemm(LAS unsigned char* lds, const P& p) {
#if FAST_CORE
    if constexpr (((FAST_MASK >> P::ID) & 1u) != 0u) { gemm_fast<P>(lds, p); __syncthreads(); }
    else gemm_naive<P>(p);
#else
    (void)lds;
    gemm_naive<P>(p);
#endif
}

__device__ __forceinline__ void tconv_item(const float* W, int ldw, int n0, bf16_t* dst, int ldd, int drow0, const float* ksc, LAS float* scr, int kb, int nb, int lane) {
    const int k0 = 64 * kb, c0 = n0 + 32 * nb;
#pragma unroll 8
    for (int i = 0; i < 32; ++i) { const int kk = 2 * i + (lane >> 5); scr[kk * 33 + (lane & 31)] = W[(size_t)(k0 + kk) * ldw + c0 + (lane & 31)]; }
    asm volatile("s_waitcnt lgkmcnt(0)" ::: "memory");
    const int c = lane & 7;
    float sc[8];
#pragma unroll
    for (int j = 0; j < 8; ++j) sc[j] = ksc ? ksc[k0 + 8 * c + j] : 1.f;
#pragma unroll
    for (int j = 0; j < 4; ++j) { const int n = (lane >> 3) + 8 * j; const LAS float* s = scr + (8 * c) * 33 + n;
        u32x4 o; o.x = pk2(s[0 * 33] * sc[0], s[1 * 33] * sc[1]); o.y = pk2(s[2 * 33] * sc[2], s[3 * 33] * sc[3]); o.z = pk2(s[4 * 33] * sc[4], s[5 * 33] * sc[5]); o.w = pk2(s[6 * 33] * sc[6], s[7 * 33] * sc[7]);
        *(u32x4*)(dst + (size_t)(drow0 + 32 * nb + n) * ldd + k0 + 8 * c) = o; }
    asm volatile("s_waitcnt lgkmcnt(0)" ::: "memory");
}
__device__ __forceinline__ bool tconv_job(int& r, const float* W, int ldw, int n0, int Kd, int Nc, bf16_t* dst, int drow0, const float* ksc, LAS float* scr, int lane) {
    const int nkb = Kd / 64, nnb = Nc / 32, items = nkb * nnb;
    if (r >= items) { r -= items; return false; }
    const int kb = r / nnb, nb = r - kb * nnb;
    tconv_item(W, ldw, n0, dst, Kd, drow0, ksc, scr, kb, nb, lane);
    return true;
}
__device__ __forceinline__ void conv_moe_layer(const Args& a, int l, LAS unsigned char* lds) {
    const int lane = threadIdx.x & 63, wave = threadIdx.x >> 6;
    LAS float* scr = (LAS float*)(lds + wave * 8448);
    const int gw = blockIdx.x * NWAVES + wave, NGW = gridDim.x * NWAVES;
    bf16_t* WGU = (bf16_t*)(a.ws + WS_W_GU); bf16_t* WDN = (bf16_t*)(a.ws + WS_W_DN);
    const float* g = a.in[I_NFFN] + l * D;
    for (int it = gw; it < 3 * 32 * 256; it += NGW) {
        const int kind = it / 8192, r = it - kind * 8192, e = r >> 8, q = r & 255;
        if (kind == 0) { const float* W = a.in[I_MGATE] + ((size_t)l * 32 + e) * (D * DEXP); tconv_item(W, DEXP, 0, WGU + (size_t)e * 1024 * 1024, D, 0, g, scr, q >> 4, q & 15, lane); }
        else if (kind == 1) { const float* W = a.in[I_MUP] + ((size_t)l * 32 + e) * (D * DEXP); tconv_item(W, DEXP, 0, WGU + (size_t)e * 1024 * 1024, D, 512, g, scr, q >> 4, q & 15, lane); }
        else { const float* W = a.in[I_MDOWN] + ((size_t)l * 32 + e) * (DEXP * D); tconv_item(W, D, 0, WDN + (size_t)e * 1024 * 512, DEXP, 0, nullptr, scr, q >> 5, q & 31, lane); }
    }
}
__device__ __forceinline__ void phase_prologue(const Args& a, LAS unsigned char* lds) {
    const int tid = threadIdx.x, lane = tid & 63, wave = tid >> 6;
    LAS float* scr = (LAS float*)(lds + wave * 8448);
    const int gw = blockIdx.x * NWAVES + wave, NGW = gridDim.x * NWAVES;
    unsigned char* ws = a.ws;
    constexpr int NITEMS = 768 + 512 + 512 + 2048 + 1024 + 2 * 512 + 2 * 1024 + 2 * 512;
    for (int it = gw; it < NITEMS; it += NGW) {
        int r = it;
        if (tconv_job(r, a.in[I_ABWIN], INAB, 0, D, 1536, (bf16_t*)(ws + WS_W_IN0), 0, a.in[I_NMIX], scr, lane)) continue;
        if (tconv_job(r, a.in[I_ABWIN], INAB, 1544, D, 1024, (bf16_t*)(ws + WS_W_IN0), 1536, a.in[I_NMIX], scr, lane)) continue;
        if (tconv_job(r, a.in[I_ABWOUT], D, 0, D, D, (bf16_t*)(ws + WS_W_OUT0), 0, nullptr, scr, lane)) continue;
        if (tconv_job(r, a.in[I_CWIN], 2 * CW, 0, D, 2 * CW, (bf16_t*)(ws + WS_W_IN1), 0, a.in[I_NMIX] + D, scr, lane)) continue;
        if (tconv_job(r, a.in[I_CWOUT], D, 0, CW, D, (bf16_t*)(ws + WS_W_OUT1), 0, nullptr, scr, lane)) continue;
        if (tconv_job(r, a.in[I_XWQ], D, 0, D, D, (bf16_t*)(ws + WS_W_Q), 0, a.in[I_NCROSS], scr, lane)) continue;
        if (tconv_job(r, a.in[I_XWQ] + (size_t)D * D, D, 0, D, D, (bf16_t*)(ws + WS_W_Q) + (size_t)D * D, 0, a.in[I_NCROSS] + D, scr, lane)) continue;
        if (tconv_job(r, a.in[I_XWKV], 2 * D, 0, D, 2 * D, (bf16_t*)(ws + WS_W_KV), 0, a.in[I_NMEM], scr, lane)) continue;
        if (tconv_job(r, a.in[I_XWKV] + (size_t)D * 2 * D, 2 * D, 0, D, 2 * D, (bf16_t*)(ws + WS_W_KV) + (size_t)2 * D * D, 0, a.in[I_NMEM] + D, scr, lane)) continue;
        if (tconv_job(r, a.in[I_XWO], D, 0, D, D, (bf16_t*)(ws + WS_W_O), 0, nullptr, scr, lane)) continue;
        tconv_job(r, a.in[I_XWO] + (size_t)D * D, D, 0, D, D, (bf16_t*)(ws + WS_W_O) + (size_t)D * D, 0, nullptr, scr, lane);
    }
    conv_moe_layer(a, 0, lds);
    const int gt = blockIdx.x * NTHREADS + tid, NGT = gridDim.x * NTHREADS;
    for (int i = gt; i < 2 * 256 * D; i += NGT) {
        const int l = i / (256 * D), n = (i / D) & 255, k = i & (D - 1);
        float v = 0.f;
        if (n < 4) v = a.in[I_MWG][((size_t)l * D + k) * 4 + n] * a.in[I_NFFN][l * D + k];
        else if (n < 36) v = a.in[I_MWE][((size_t)l * D + k) * 32 + (n - 4)] * a.in[I_NFFN][l * D + k];
        ((bf16_t*)(ws + WS_W_R))[i] = f2bf(v);
    }
    for (int i = gt; i < CG * CCH * CCH; i += NGT) { const int t = (i >> 7) & 127, s = i & 127; ((bf16_t*)(ws + WS_TRIL))[i] = f2bf(s <= t ? a.in[I_CWS][i] : 0.f); }
    __syncthreads();
    LAS float* wf = (LAS float*)(lds + 73728);
    for (int i = tid; i < D * 8; i += NTHREADS) { const int k = i >> 3, h = i & 7; wf[i] = a.in[I_ABWIN][(size_t)k * INAB + 1536 + h] * a.in[I_NMIX][k]; }
    __syncthreads();
    bf16_t* X = (bf16_t*)(ws + WS_X); float* xstat = (float*)(ws + WS_XSTAT); float* flog = (float*)(ws + WS_FLOG);
    for (int row = gw; row < T; row += NGW) {
        const f32x4* xr = (const f32x4*)(a.in[I_X] + (size_t)row * D) + lane;
        f32x4 v[4]; float ss = 0.f; float fl[8];
#pragma unroll
        for (int h = 0; h < 8; ++h) fl[h] = 0.f;
#pragma unroll
        for (int j = 0; j < 4; ++j) { v[j] = xr[64 * j]; ss += (v[j].x * v[j].x + v[j].y * v[j].y) + (v[j].z * v[j].z + v[j].w * v[j].w); }
#pragma unroll
        for (int j = 0; j < 4; ++j)
#pragma unroll
            for (int e = 0; e < 4; ++e) { const int k = 4 * lane + 256 * j + e; const f32x4 w0 = *(const LAS f32x4*)(wf + k * 8), w1 = *(const LAS f32x4*)(wf + k * 8 + 4);
#pragma unroll
                for (int h = 0; h < 4; ++h) { fl[h] += v[j][e] * w0[h]; fl[4 + h] += v[j][e] * w1[h]; } }
        ss = wave_sum(ss);
#pragma unroll
        for (int h = 0; h < 8; ++h) fl[h] = wave_sum(fl[h]);
        u32x2* o8 = (u32x2*)(X + (size_t)row * D) + lane;
#pragma unroll
        for (int j = 0; j < 4; ++j) { u32x2 o; o.x = pk2(v[j].x, v[j].y); o.y = pk2(v[j].z, v[j].w); o8[64 * j] = o; }
        if (lane < 16) xstat[(size_t)row * 16 + lane] = lane == 0 ? ss : 0.f;
        const float s = rsqrtf(ss * (1.f / D) + EPS);
        if (lane < 8) { float f = fl[0];
#pragma unroll
            for (int h = 1; h < 8; ++h) f = lane == h ? fl[h] : f;
            flog[(size_t)row * 8 + lane] = f * s; }
    }
    bf16_t* MB = (bf16_t*)(ws + WS_MEMB); float* memstat = (float*)(ws + WS_MISC + MISC_MEMSTAT);
    for (int row = gw; row < NB * MEML; row += NGW) {
        const f32x4* xr = (const f32x4*)(a.in[I_MEM] + (size_t)row * D) + lane; float ss = 0.f;
        u32x2* o8 = (u32x2*)(MB + (size_t)row * D) + lane;
#pragma unroll
        for (int j = 0; j < 4; ++j) { const f32x4 v = xr[64 * j]; ss += (v.x * v.x + v.y * v.y) + (v.z * v.z + v.w * v.w); u32x2 o; o.x = pk2(v.x, v.y); o.y = pk2(v.z, v.w); o8[64 * j] = o; }
        ss = wave_sum(ss);
        if (lane == 0) memstat[row] = ss;
    }
}

__device__ __forceinline__ void phase_cumsum(const Args& a, LAS unsigned char* lds) {
    const int tid = threadIdx.x, lane = tid & 63, wave = tid >> 6;
    const float* flog = (const float*)(a.ws + WS_FLOG); float* csum = (float*)(a.ws + WS_CSUM);
    LAS float* wsum = (LAS float*)lds;
    for (int u = blockIdx.x; u < NB * AH; u += gridDim.x) {
        const int b = u >> 3, h = u & 7; const float fb = a.in[I_FBIAS][h];
        float v[8]; float run = 0.f;
#pragma unroll
        for (int j = 0; j < 8; ++j) { const float x = flog[((size_t)b * SEQ + 8 * tid + j) * 8 + h] + fb; const float lf = fminf(x, 0.f) - log1pf(__expf(-fabsf(x))); run += lf; v[j] = run; }
        float inc = run;
#pragma unroll
        for (int o = 1; o < 64; o <<= 1) { const float t = __shfl_up(inc, o); if (lane >= o) inc += t; }
        __syncthreads();
        if (lane == 63) wsum[wave] = inc;
        __syncthreads();
        float base = inc - run;
        for (int w = 0; w < wave; ++w) base += wsum[w];
#pragma unroll
        for (int j = 0; j < 8; ++j) csum[(size_t)u * SEQ + 8 * tid + j] = base + v[j];
    }
}

__device__ __forceinline__ void phase_k2fin(const Args& a) {
    const int lane = threadIdx.x & 63, wave = threadIdx.x >> 6;
    const int gw = blockIdx.x * NWAVES + wave, NGW = gridDim.x * NWAVES;
    bf16_t* K2 = (bf16_t*)(a.ws + WS_K2); const float* k2stat = (const float*)(a.ws + WS_MISC + MISC_K2STAT);
    for (int it = gw; it < 2 * NB * XH * MEML; it += NGW) {
        const int key = it & 255, h = (it >> 8) & 3, b = (it >> 10) & 7, l = it >> 13;
        const f32x4 st = *(const f32x4*)(k2stat + ((size_t)l * 2048 + b * 256 + key) * 16 + 4 * h);
        const float rn = rsqrtf(((st.x + st.y) + (st.z + st.w)) * (1.f / XHD) + EPS);
        u32x2* p = (u32x2*)(K2 + (size_t)it * 256) + lane; const u32x2 v = *p;
        const float* qg = a.in[I_XQG] + l * XHD + 4 * lane; const float* kg = a.in[I_XKG] + l * XHD + 4 * lane;
        u32x2 o; o.x = pk2(bf_lo(v.x) * rn * qg[0] * kg[0], bf_hi(v.x) * rn * qg[1] * kg[1]); o.y = pk2(bf_lo(v.y) * rn * qg[2] * kg[2], bf_hi(v.y) * rn * qg[3] * kg[3]);
        *p = o;
    }
    const bf16_t* V2 = (const bf16_t*)(a.ws + WS_ARENA + AR_V2TMP); bf16_t* V2T = (bf16_t*)(a.ws + WS_V2T);
    const int gt = blockIdx.x * NTHREADS + threadIdx.x, NGT = gridDim.x * NTHREADS;
    for (int it = gt; it < 64 * 256 * 32; it += NGT) {
        const int d = it & 255, k8 = (it >> 8) & 31, tile = it >> 13;
        const bf16_t* src = V2 + (size_t)tile * 65536 + (size_t)(8 * k8) * 256 + d;
        u32x4 w; w.x = (unsigned)src[0] | ((unsigned)src[256] << 16); w.y = (unsigned)src[512] | ((unsigned)src[768] << 16); w.z = (unsigned)src[1024] | ((unsigned)src[1280] << 16); w.w = (unsigned)src[1536] | ((unsigned)src[1792] << 16);
        *(u32x4*)(V2T + (size_t)tile * 65536 + (size_t)d * 256 + 8 * k8) = w;
    }
}

__device__ __forceinline__ void lru_unit(const Args& a, LAS unsigned char* lds, int b, int g, int ch, int pass) {
    const int tid = threadIdx.x, c = tid & 63, tq = tid >> 6;
    LAS float* xc = (LAS float*)lds;
    LAS float* wA = (LAS float*)(lds + 33792);
    LAS float* wX = (LAS float*)(lds + 33792 + 16384);
    LAS float* seg = (LAS float*)(lds + 33792 + 32768);
    const bf16_t* XB = (const bf16_t*)(a.ws + WS_ARENA + AR_XB); const bf16_t* GATE = (const bf16_t*)(a.ws + WS_ARENA + AR_GATE);
    bf16_t* AR = (bf16_t*)(a.ws + WS_ARENA + AR_AR); float* lsum = (float*)(a.ws + WS_LSUM);
    const int ch0 = 64 * g + c; const size_t row0 = (size_t)b * SEQ + 128 * ch;
    __syncthreads();
    for (int i = tid; i < 4096; i += NTHREADS) { wA[i] = a.in[I_WA][g * 4096 + i]; wX[i] = a.in[I_WX][g * 4096 + i]; }
    {
        const float w0 = a.in[I_CONVW][0 * BW + ch0], w1 = a.in[I_CONVW][1 * BW + ch0], w2 = a.in[I_CONVW][2 * BW + ch0], w3 = a.in[I_CONVW][3 * BW + ch0], cb = a.in[I_CONVB][ch0];
        float xm3, xm2, xm1; const int tl0 = 16 * tq, s0 = 128 * ch + tl0;
        xm3 = s0 >= 3 ? bf2f(XB[(row0 + tl0 - 3) * BW + ch0]) : 0.f; xm2 = s0 >= 2 ? bf2f(XB[(row0 + tl0 - 2) * BW + ch0]) : 0.f; xm1 = s0 >= 1 ? bf2f(XB[(row0 + tl0 - 1) * BW + ch0]) : 0.f;
#pragma unroll 4
        for (int j = 0; j < 16; ++j) { const float x0 = bf2f(XB[(row0 + tl0 + j) * BW + ch0]); xc[(tl0 + j) * 65 + c] = w0 * xm3 + w1 * xm2 + w2 * xm1 + w3 * x0 + cb; xm3 = xm2; xm2 = xm1; xm1 = x0; }
    }
    __syncthreads();
    float ra[16], rx[16];
#pragma unroll
    for (int j = 0; j < 16; ++j) { ra[j] = 0.f; rx[j] = 0.f; }
    for (int k = 0; k < 64; ++k) { const float wa = wA[k * 64 + c], wx = wX[k * 64 + c];
#pragma unroll
        for (int j = 0; j < 16; ++j) { const float x = xc[(16 * tq + j) * 65 + k]; ra[j] += x * wa; rx[j] += x * wx; } }
    const float ba = a.in[I_BA][ch0], bx = a.in[I_BX][ch0], lam = a.in[I_LAM][ch0];
    const float sp = (lam > 0.f ? 0.f : -lam) + log1pf(__expf(-fabsf(lam)));
    float av[16], bv[16]; float Pp = 1.f, hh = 0.f;
#pragma unroll
    for (int j = 0; j < 16; ++j) { const float r = sigmoidf(ra[j] + ba), ig = sigmoidf(rx[j] + bx); const float la = -8.f * r * sp; const float aa = __expf(la);
        const float beta = sqrtf(fmaxf(-expm1f(2.f * la), 0.f)); av[j] = aa; bv[j] = beta * (ig * xc[(16 * tq + j) * 65 + c]); Pp *= aa; hh = aa * hh + bv[j]; }
    seg[(tq * 64 + c) * 2] = Pp; seg[(tq * 64 + c) * 2 + 1] = hh;
    __syncthreads();
    if (pass == 0) {
        if (tq == 0) { float PA = 1.f, H = 0.f;
            for (int q = 0; q < 8; ++q) { const float pq = seg[(q * 64 + c) * 2], hq = seg[(q * 64 + c) * 2 + 1]; H = pq * H + hq; PA *= pq; }
            float* o = lsum + (((size_t)b * 32 + ch) * BW + ch0) * 2; o[0] = PA; o[1] = H; }
    } else {
        float H = 0.f;
        for (int q = 0; q < ch; ++q) { const float* o = lsum + (((size_t)b * 32 + q) * BW + ch0) * 2; H = o[0] * H + o[1]; }
        for (int q = 0; q < tq; ++q) H = seg[(q * 64 + c) * 2] * H + seg[(q * 64 + c) * 2 + 1];
#pragma unroll
        for (int j = 0; j < 16; ++j) { H = av[j] * H + bv[j]; const size_t row = row0 + 16 * tq + j; AR[row * D + 512 + ch0] = f2bf(bf2f(GATE[row * BW + ch0]) * H); }
    }
}
__device__ __forceinline__ void phase_lru(const Args& a, LAS unsigned char* lds, int pass) {
    for (int u = blockIdx.x; u < NB * 8 * 32; u += gridDim.x) { const int ch = u & 31, g = (u >> 5) & 7, b = u >> 8; lru_unit(a, lds, b, g, ch, pass); }
    __syncthreads();
}

__device__ __forceinline__ void phase_attn_naive(const Args& a) {
    const int tid = threadIdx.x;
    const bf16_t* Q = (const bf16_t*)(a.ws + WS_ARENA + AR_Q); const bf16_t* Kb = (const bf16_t*)(a.ws + WS_ARENA + AR_K); const bf16_t* Vb = (const bf16_t*)(a.ws + WS_ARENA + AR_V);
    bf16_t* AR = (bf16_t*)(a.ws + WS_ARENA + AR_AR); const float* csum = (const float*)(a.ws + WS_CSUM);
    const int NU = NB * AH * (SEQ / NTHREADS);
    for (int i = blockIdx.x; i < NU; i += gridDim.x) {
        const int uu = NU - 1 - i;
        const int qb = uu / (NB * AH), bh = uu % (NB * AH), b = bh >> 3, h = bh & 7;
        const int t = qb * NTHREADS + tid; const size_t row = (size_t)b * SEQ + t;
        u32x4 qp[8]; float o[64];
#pragma unroll
        for (int d8 = 0; d8 < 8; ++d8) qp[d8] = *(const u32x4*)(Q + row * AW + h * HD + 8 * d8);
#pragma unroll
        for (int d = 0; d < 64; ++d) o[d] = 0.f;
        const float* cs = csum + (size_t)bh * SEQ; const float ci = cs[t] * LOG2E;
        float mx = -INFINITY, l = 0.f;
        const int jmax = qb * NTHREADS + (tid | 63);
        for (int j = 0; j <= jmax; ++j) {
            const size_t kr = ((size_t)b * SEQ + j) * AW + h * HD;
            float s = 0.f;
#pragma unroll
            for (int d8 = 0; d8 < 8; ++d8) { const u32x4 v = *(const u32x4*)(Kb + kr + 8 * d8); const u32x4 q = qp[d8];
                s += bf_lo(q.x) * bf_lo(v.x) + bf_hi(q.x) * bf_hi(v.x) + bf_lo(q.y) * bf_lo(v.y) + bf_hi(q.y) * bf_hi(v.y) + bf_lo(q.z) * bf_lo(v.z) + bf_hi(q.z) * bf_hi(v.z) + bf_lo(q.w) * bf_lo(v.w) + bf_hi(q.w) * bf_hi(v.w); }
            s += ci - cs[j] * LOG2E;
            if (j > t) s = -INFINITY;
            const float mn = fmaxf(mx, s); const float sc = exp2f(mx - mn), p = exp2f(s - mn);
            l = l * sc + p; mx = mn;
#pragma unroll
            for (int d8 = 0; d8 < 8; ++d8) { const u32x4 v = *(const u32x4*)(Vb + kr + 8 * d8);
                o[8 * d8] = o[8 * d8] * sc + p * bf_lo(v.x); o[8 * d8 + 1] = o[8 * d8 + 1] * sc + p * bf_hi(v.x); o[8 * d8 + 2] = o[8 * d8 + 2] * sc + p * bf_lo(v.y); o[8 * d8 + 3] = o[8 * d8 + 3] * sc + p * bf_hi(v.y);
                o[8 * d8 + 4] = o[8 * d8 + 4] * sc + p * bf_lo(v.z); o[8 * d8 + 5] = o[8 * d8 + 5] * sc + p * bf_hi(v.z); o[8 * d8 + 6] = o[8 * d8 + 6] * sc + p * bf_lo(v.w); o[8 * d8 + 7] = o[8 * d8 + 7] * sc + p * bf_hi(v.w); }
        }
        const float inv = 1.f / l;
#pragma unroll
        for (int d8 = 0; d8 < 8; ++d8) { u32x4 w; w.x = pk2(o[8 * d8] * inv, o[8 * d8 + 1] * inv); w.y = pk2(o[8 * d8 + 2] * inv, o[8 * d8 + 3] * inv); w.z = pk2(o[8 * d8 + 4] * inv, o[8 * d8 + 5] * inv); w.w = pk2(o[8 * d8 + 6] * inv, o[8 * d8 + 7] * inv);
            *(u32x4*)(AR + row * D + h * HD + 8 * d8) = w; }
    }
}

#include <hip/hip_bf16.h>
#include <cmath>
namespace attn_body {
using bf16=__hip_bfloat16;
using bf16x8=__attribute__((ext_vector_type(8)))short;
using s16x4=__attribute__((ext_vector_type(4)))short;
using f32x16=__attribute__((ext_vector_type(16)))float;
using u32x4=__attribute__((ext_vector_type(4)))unsigned;
using f32x4_t=__attribute__((ext_vector_type(4)))float;
constexpr int BATCH=8,NHEAD=8,SEQ=4096,D=64,DM=NHEAD*D,DMO=1024;
constexpr int NW=8,QBLK=32,QB=QBLK*NW,KVBLK=64,NQB=SEQ/QB;
constexpr int ATTN_PITCH=DM, ATTN_UNIT_ROWS=QB;
__device__ __forceinline__ int crow(int r,int hi){return (r&3)+8*(r>>2)+4*hi;}
#define SBAR() __builtin_amdgcn_sched_barrier(0)
__device__ __forceinline__ void cmask(f32x16&p0,f32x16&p1,int jb,int qrel,int hi){
  const float NEG=-INFINITY; int kb=64*jb+4*hi;
  #pragma unroll
  for(int r=0;r<16;++r){int kv=kb+(r&3)+8*(r>>2); if(kv>qrel)p0[r]=NEG; if(kv+32>qrel)p1[r]=NEG;}
}

constexpr int NSLOT=3, SLOTB=8192;
constexpr int LDS_K=0, LDS_V=NSLOT*SLOTB, LDS_WS=2*NSLOT*SLOTB, LDS_OST=LDS_WS+NW*64*4, LDS_CB=LDS_OST+NW*4096, LDS_BYTES=LDS_CB+SEQ*4;
constexpr float C2=0.125f*1.4426950408889634f;
__device__ __forceinline__ void glds16(const void*gsrc,unsigned lds_dst){unsigned keep;
  asm volatile("s_mov_b32 %0, m0\n\ts_mov_b32 m0, %2\n\ts_nop 0\n\tglobal_load_lds_dwordx4 %1, off\n\ts_mov_b32 m0, %0":"=&s"(keep):"v"(gsrc),"s"(lds_dst):"memory");}
__device__ __forceinline__ float max3f(float a,float b,float c){float r;asm("v_max3_f32 %0, %1, %2, %3":"=v"(r):"v"(a),"v"(b),"v"(c));return r;}
__device__ __forceinline__ float max2f(float a,float b){float r;asm("v_max_f32_e32 %0, %1, %2":"=v"(r):"v"(a),"v"(b));return r;}
__device__ __forceinline__ float fadd_s(float a,float b){float r;asm("v_add_f32_e32 %0, %1, %2":"=v"(r):"v"(a),"v"(b));return r;}
__device__ __forceinline__ float fsub_s(float a,float b){float r;asm("v_sub_f32_e32 %0, %1, %2":"=v"(r):"v"(a),"v"(b));return r;}
typedef float f32x2_t __attribute__((ext_vector_type(2))); typedef __bf16 bf16x2_t __attribute__((ext_vector_type(2)));
__device__ __forceinline__ unsigned cvtpk_s(float lo,float hi){f32x2_t v={lo,hi};bf16x2_t b=__builtin_convertvector(v,bf16x2_t);return __builtin_bit_cast(unsigned,b);}
#define WAIT_BAR(N) asm volatile("s_waitcnt vmcnt(" #N ") lgkmcnt(0)\n\ts_barrier":::"memory")

__device__ __forceinline__ void qkt(f32x16&p0,f32x16&p1,const char*Kslot,const bf16x8*qr,int r32,int hi){
  const char*kb=Kslot+hi*1024+r32*16;
  #pragma unroll
  for(int d0=0;d0<4;++d0){
    const bf16x8 b0=*reinterpret_cast<const bf16x8*>(kb+d0*2048);
    const bf16x8 b1=*reinterpret_cast<const bf16x8*>(kb+d0*2048+512);
    {p0=__builtin_amdgcn_mfma_f32_32x32x16_bf16(b0,qr[d0],p0,0,0,0);p1=__builtin_amdgcn_mfma_f32_32x32x16_bf16(b1,qr[d0],p1,0,0,0);}}
}
typedef __attribute__((address_space(3))) const char* lds_cptr;
typedef short v4i16_t __attribute__((ext_vector_type(4)));
__device__ __forceinline__ void kload8(bf16x8*kf,lds_cptr kp){
  kf[0]=*(const __attribute__((address_space(3))) bf16x8*)(kp);      kf[1]=*(const __attribute__((address_space(3))) bf16x8*)(kp+512);
  kf[2]=*(const __attribute__((address_space(3))) bf16x8*)(kp+2048); kf[3]=*(const __attribute__((address_space(3))) bf16x8*)(kp+2560);
  kf[4]=*(const __attribute__((address_space(3))) bf16x8*)(kp+4096); kf[5]=*(const __attribute__((address_space(3))) bf16x8*)(kp+4608);
  kf[6]=*(const __attribute__((address_space(3))) bf16x8*)(kp+6144); kf[7]=*(const __attribute__((address_space(3))) bf16x8*)(kp+6656);
}
__device__ __forceinline__ void kload2(bf16x8*kf,lds_cptr kp,int j){ kf[2*j]=*(const __attribute__((address_space(3))) bf16x8*)(kp+j*2048); kf[2*j+1]=*(const __attribute__((address_space(3))) bf16x8*)(kp+j*2048+512); }
__device__ __forceinline__ s16x4 vtr(lds_cptr p){ return __builtin_bit_cast(s16x4,__builtin_amdgcn_ds_read_tr16_b64_v4i16((__attribute__((address_space(3))) v4i16_t*)p)); }
__device__ __forceinline__ float rowmax(const f32x16&p0,const f32x16&p1){
  float a=max3f(p0[0],p0[1],p1[0]),b=max3f(p0[2],p0[3],p1[1]);a=max3f(a,p1[2],p1[3]);
  #pragma unroll
  for(int r=4;r<16;r+=4){a=max3f(a,p0[r],p0[r+1]);b=max3f(b,p0[r+2],p0[r+3]);a=max3f(a,p1[r],p1[r+1]);b=max3f(b,p1[r+2],p1[r+3]);}
  const float m=max2f(a,b);
  auto rr=__builtin_amdgcn_permlane32_swap(__float_as_uint(m),__float_as_uint(m),false,false);
  return max2f(__uint_as_float(rr[0]),__uint_as_float(rr[1]));
}
__device__ __forceinline__ void pv(f32x16*o,int vb,bf16x8 pa0,bf16x8 pa1,bf16x8 pa2,bf16x8 pa3){
  #pragma unroll
  for(int d0=0;d0<2;++d0){s16x4 lo[4],hi[4];
    #pragma unroll
    for(int ks=0;ks<4;++ks){
      asm volatile("ds_read_b64_tr_b16 %0,%1 offset:%c2":"=&v"(lo[ks]):"v"(vb),"i"(d0*4096+ks*1024):"memory");
      asm volatile("ds_read_b64_tr_b16 %0,%1 offset:%c2":"=&v"(hi[ks]):"v"(vb),"i"(d0*4096+ks*1024+512):"memory");}
    asm volatile("s_waitcnt lgkmcnt(0)":::"memory");SBAR();
    #define PK(k) (bf16x8){lo[k][0],lo[k][1],lo[k][2],lo[k][3],hi[k][0],hi[k][1],hi[k][2],hi[k][3]}
    o[d0]=__builtin_amdgcn_mfma_f32_32x32x16_bf16(pa0,PK(0),o[d0],0,0,0);
    o[d0]=__builtin_amdgcn_mfma_f32_32x32x16_bf16(pa1,PK(1),o[d0],0,0,0);
    o[d0]=__builtin_amdgcn_mfma_f32_32x32x16_bf16(pa2,PK(2),o[d0],0,0,0);
    o[d0]=__builtin_amdgcn_mfma_f32_32x32x16_bf16(pa3,PK(3),o[d0],0,0,0);
    #undef PK
  }
}

#ifndef ATTN_STORE16
#define ATTN_STORE16(p,v) (*(u32x4*)(p)=(v))
#endif
template<int THRL> __device__ __forceinline__ void attn_unit(int b,int h,int qb,const bf16*Q,const bf16*__restrict__ K,const bf16*__restrict__ V,bf16*O,const float*__restrict__ csum,char*shm){
  int tid_=threadIdx.x; asm volatile("":"+v"(tid_));
  const int tid=tid_,lane=tid&63,r32=lane&31,hi=lane>>5; const int wid=__builtin_amdgcn_readfirstlane(tid>>6);
  const lds_cptr shm3=(lds_cptr)shm;
  const long rowbase=(long)b*SEQ; const int q0=qb*QB;
  const bf16*Qw=Q+(rowbase+q0+wid*QBLK)*DM+h*D;
  const bf16*Kh=K+rowbase*DM+h*D,*Vh=V+rowbase*DM+h*D;
  const unsigned lds0=(unsigned)(uintptr_t)shm;
  float*wsf=(float*)(shm+LDS_WS)+wid*64;
  const bf16*ksrc=Kh+(long)lane*DM+wid*8;
  const bf16*vsrc=Vh+(long)(16*(wid&3)+(lane>>2))*DM+(wid>>2)*32+(lane&3)*8;
  const unsigned kdst=lds0+LDS_K+wid*1024, vdst=lds0+LDS_V+wid*1024;
  #define DMA_K(t,slot) glds16(ksrc+(long)(t)*KVBLK*DM,(unsigned)__builtin_amdgcn_readfirstlane(kdst+(slot)))
  #define DMA_V(t,slot) glds16(vsrc+(long)(t)*KVBLK*DM,(unsigned)__builtin_amdgcn_readfirstlane(vdst+(slot)))
  const int vb0=(int)(lds0+LDS_V)+((lane>>4)&1)*32+(lane&3)*8+(4*hi+((lane&15)>>2))*64;
  const char*Kbase=shm+LDS_K; bf16x8 kf[8];
  const lds_cptr kp0=shm3+LDS_K+hi*1024+r32*16; const lds_cptr vp0=shm3+LDS_V+((lane>>4)&1)*32+(lane&3)*8+(4*hi+((lane&15)>>2))*64;
  const int NT=(q0+QB)/KVBLK;
  { const float*cs=csum+(long)(b*NHEAD+h)*SEQ; const float cref=cs[q0]; float*cbw=(float*)(shm+LDS_CB);
    for(int j=tid;j<q0+QB;j+=NW*64)cbw[j]=(cref-cs[j])*1.4426950408889634f; }
  const __attribute__((address_space(3))) f32x4_t* cbp=(const __attribute__((address_space(3))) f32x4_t*)(shm3+LDS_CB+16*hi);
  #define LOADB(X0,X1,t) do{ _Pragma("unroll") for(int g_=0;g_<4;++g_){ const f32x4_t b0_=cbp[16*(t)+2*g_], b1_=cbp[16*(t)+2*g_+8]; \
      X0[4*g_]=b0_[0];X0[4*g_+1]=b0_[1];X0[4*g_+2]=b0_[2];X0[4*g_+3]=b0_[3]; X1[4*g_]=b1_[0];X1[4*g_+1]=b1_[1];X1[4*g_+2]=b1_[2];X1[4*g_+3]=b1_[3]; } }while(0)
  DMA_K(0,0);DMA_V(0,0);DMA_K(1,SLOTB);
  bf16x8 qr[4];
  #pragma unroll
  for(int d0=0;d0<4;++d0)qr[d0]=*reinterpret_cast<const bf16x8*>(&Qw[(long)r32*DM+d0*16+hi*8]);
  float mhat=0.f,l_reg=0.f;f32x16 o[2];o[0]=f32x16{};o[1]=f32x16{};
  const int qrel=wid*QBLK+r32;
  #define CMASK(P0,P1,t) do{int jb_=(t)-(NT-4); if(jb_>=0)cmask(P0,P1,jb_,qrel,hi);}while(0)
  bool resc=false;
  #define START(P0,P1) do{ const float rm=rowmax(P0,P1); resc=false; \
    { const float dl=rm; mhat=fadd_s(mhat,dl); \
      _Pragma("unroll") for(int r=0;r<16;++r){P0[r]=fsub_s(P0[r],dl);P1[r]=fsub_s(P1[r],dl);} } \
    _Pragma("unroll") for(int r=0;r<16;++r)P0[r]=__builtin_amdgcn_exp2f(P0[r]); }while(0)
  #define RESC() do{ if(resc){ asm volatile("s_waitcnt lgkmcnt(0)":::"memory"); \
      _Pragma("unroll") for(int d_=0;d_<2;++d_) _Pragma("unroll") for(int r=0;r<16;++r)o[d_][r]*=wsf[crow(r,hi)]; } }while(0)
  f32x16 pA0,pA1,pB0,pB1;
  int sl_prev=0,sl_cur=0,sl_next=SLOTB;
  #define ROT() do{sl_prev=sl_cur;sl_cur=sl_next;sl_next=(sl_next==(NSLOT-1)*SLOTB)?0:sl_next+SLOTB;}while(0)
  DMA_K(2,2*SLOTB);
  WAIT_BAR(3);
  LOADB(pA0,pA1,0);qkt(pA0,pA1,Kbase,qr,r32,hi);asm volatile("s_nop 15\n\ts_nop 7":"+v"(pA0),"+v"(pA1));CMASK(pA0,pA1,0);
  START(pA0,pA1);
  LOADB(pB0,pB1,1);
  _Pragma("unroll") for(int r=0;r<16;++r)pA1[r]=__builtin_amdgcn_exp2f(pA1[r]);
  WAIT_BAR(0);
  DMA_K(3,0);DMA_V(1,SLOTB);
  ROT();
  kload8(kf,kp0+sl_cur);
  WAIT_BAR(2);
  s16x4 vlo[8],vhi[8]; u32x4 pw0,pw1,pw2,pw3;
  #define PKW(P,B) cvtpk_s(P[B],P[B+1])
  #define PAF(k) __builtin_bit_cast(bf16x8,pw##k)
  #define VFR(i) (bf16x8){vlo[i][0],vlo[i][1],vlo[i][2],vlo[i][3],vhi[i][0],vhi[i][1],vhi[i][2],vhi[i][3]}
  #define PIN(x) asm volatile("":"+v"(x))
  #define MX3(a,b,c) __builtin_fmaxf(__builtin_fmaxf((a),(b)),(c))
  #define GAPA(MF,A0,A1,A2,A3,W0,W1,PW) do{ MF; sacc+=A0; sacc+=A1; sacc+=A2; sacc+=A3; PIN(sacc); W0; W1; PIN(PW); SBAR(); }while(0)
  #define EX(v) __builtin_amdgcn_exp2f(v)
  #define GAPB(MF,X,B) do{ MF; X[B]=EX(X[B]); X[B+1]=EX(X[B+1]); X[B+2]=EX(X[B+2]); X[B+3]=EX(X[B+3]); PIN(X); SBAR(); }while(0)
  #define VRD(i) do{ vlo[i]=vtr(vp_+(((i)>>2)*4096+((i)&3)*1024)); vhi[i]=vtr(vp_+(((i)>>2)*4096+((i)&3)*1024+512)); }while(0)
  #define KRD(G,j) do{ if(G){ kload2(kf,kp0+sl_next,j); SBAR(); } }while(0)
  #define STEP(C0,C1,P0,P1,t,GK,GV,GL) do{ SBAR(); \
    _Pragma("unroll") for(int r=0;r<16;++r){C0[r]-=mhat;C1[r]-=mhat;} \
    const lds_cptr vp_=vp0+sl_prev; \
    VRD(0); SBAR(); float sacc=(P0[0]+P0[1]); \
    GAPA(C0=__builtin_amdgcn_mfma_f32_32x32x16_bf16(kf[0],qr[0],C0,0,0,0), P0[2],P0[3],P0[4],P0[5],     pw0[0]=PKW(P0,0), pw0[1]=PKW(P0,2), pw0); \
    VRD(4); SBAR(); GAPA(C1=__builtin_amdgcn_mfma_f32_32x32x16_bf16(kf[1],qr[0],C1,0,0,0), P0[6],P0[7],P0[8],P0[9],     pw0[2]=PKW(P0,4), pw0[3]=PKW(P0,6), pw0); \
    VRD(1); SBAR(); GAPA(C0=__builtin_amdgcn_mfma_f32_32x32x16_bf16(kf[2],qr[1],C0,0,0,0),   P0[10],P0[11],P0[12],P0[13], pw1[0]=PKW(P0,8), pw1[1]=PKW(P0,10), pw1); \
    VRD(5); SBAR(); GAPA(C1=__builtin_amdgcn_mfma_f32_32x32x16_bf16(kf[3],qr[1],C1,0,0,0),   P0[14],P0[15],P1[0],P1[1],   pw1[2]=PKW(P0,12),pw1[3]=PKW(P0,14), pw1); \
    VRD(2); SBAR(); GAPA(C0=__builtin_amdgcn_mfma_f32_32x32x16_bf16(kf[4],qr[2],C0,0,0,0),   P1[2],P1[3],P1[4],P1[5],     pw2[0]=PKW(P1,0), pw2[1]=PKW(P1,2), pw2); \
    VRD(6); SBAR(); GAPA(C1=__builtin_amdgcn_mfma_f32_32x32x16_bf16(kf[5],qr[2],C1,0,0,0),   P1[6],P1[7],P1[8],P1[9],     pw2[2]=PKW(P1,4), pw2[3]=PKW(P1,6), pw2); \
    VRD(3); SBAR(); GAPA(C0=__builtin_amdgcn_mfma_f32_32x32x16_bf16(kf[6],qr[3],C0,0,0,0),   P1[10],P1[11],P1[12],P1[13], pw3[0]=PKW(P1,8), pw3[1]=PKW(P1,10), pw3); \
    VRD(7); SBAR(); GAPA(C1=__builtin_amdgcn_mfma_f32_32x32x16_bf16(kf[7],qr[3],C1,0,0,0),   P1[14],P1[15],0.f,0.f,       pw3[2]=PKW(P1,12),pw3[3]=PKW(P1,14), pw3); \
    l_reg+=sacc; LOADB(P0,P1,(t)+1); \
    if(GK){DMA_K((t)+3,sl_cur);} if(GV){DMA_V((t)+1,sl_next);} \
    CMASK(C0,C1,t); \
    { float a=MX3(C0[0],C0[1],C1[0]),b=MX3(C0[2],C0[3],C1[1]); a=MX3(a,C1[2],C1[3]); \
      _Pragma("unroll") for(int r=4;r<16;r+=4){a=MX3(a,C0[r],C0[r+1]);b=MX3(b,C0[r+2],C0[r+3]);a=MX3(a,C1[r],C1[r+1]);b=MX3(b,C1[r+2],C1[r+3]);} \
      float rm=__builtin_fmaxf(a,b); { auto rr=__builtin_amdgcn_permlane32_swap(__float_as_uint(rm),__float_as_uint(rm),false,false); rm=__builtin_fmaxf(__uint_as_float(rr[0]),__uint_as_float(rr[1])); } \
      resc=false; \
      if(__builtin_expect(__any(rm>(float)THRL),0)){ const float dl=__builtin_fmaxf(rm,0.f); mhat+=dl; \
        _Pragma("unroll") for(int r=0;r<16;++r){C0[r]-=dl;C1[r]-=dl;} \
        const float f=__builtin_amdgcn_exp2f(-dl); l_reg*=f; if(hi==0)wsf[r32]=f; resc=true; } } \
    SBAR(); \
    GAPB(o[0]=__builtin_amdgcn_mfma_f32_32x32x16_bf16(PAF(0),VFR(0),o[0],0,0,0), C0,0); \
    GAPB(o[1]=__builtin_amdgcn_mfma_f32_32x32x16_bf16(PAF(0),VFR(4),o[1],0,0,0), C0,4); \
    KRD(GL,0); GAPB(o[0]=__builtin_amdgcn_mfma_f32_32x32x16_bf16(PAF(1),VFR(1),o[0],0,0,0), C0,8); \
    KRD(GL,1); GAPB(o[1]=__builtin_amdgcn_mfma_f32_32x32x16_bf16(PAF(1),VFR(5),o[1],0,0,0), C0,12); \
    KRD(GL,2); GAPB(o[0]=__builtin_amdgcn_mfma_f32_32x32x16_bf16(PAF(2),VFR(2),o[0],0,0,0), C1,0); \
    KRD(GL,3); GAPB(o[1]=__builtin_amdgcn_mfma_f32_32x32x16_bf16(PAF(2),VFR(6),o[1],0,0,0), C1,4); \
    GAPB(o[0]=__builtin_amdgcn_mfma_f32_32x32x16_bf16(PAF(3),VFR(3),o[0],0,0,0), C1,8); \
    GAPB(o[1]=__builtin_amdgcn_mfma_f32_32x32x16_bf16(PAF(3),VFR(7),o[1],0,0,0), C1,12); \
    }while(0)
  int t=1;
  #undef CMASK
  #define CMASK(P0,P1,t) do{}while(0)
  for(;t+5<NT;t+=2){
    STEP(pB0,pB1,pA0,pA1,t,true,true,true);     WAIT_BAR(2); RESC(); ROT();
    STEP(pA0,pA1,pB0,pB1,t+1,true,true,true);   WAIT_BAR(2); RESC(); ROT();
  }
  #undef CMASK
  #define CMASK(P0,P1,t) do{int jb_=(t)-(NT-4); if(jb_>=0)cmask(P0,P1,jb_,qrel,hi);}while(0)
  #define ENDW(tt) do{ if((tt)+3<NT){WAIT_BAR(2);} else if((tt)+2<NT){WAIT_BAR(1);} else {WAIT_BAR(0);} }while(0)
  for(;t+1<NT;t+=2){
    STEP(pB0,pB1,pA0,pA1,t,(t+3<NT),(t+1<NT),(t+1<NT));       ENDW(t);   RESC(); ROT();
    STEP(pA0,pA1,pB0,pB1,t+1,(t+4<NT),(t+2<NT),(t+2<NT));     ENDW(t+1); RESC(); ROT();
  }
  STEP(pB0,pB1,pA0,pA1,NT-1,false,false,false); RESC();
  { float sacc=pB0[0]+pB0[1]; _Pragma("unroll") for(int r=2;r<16;++r)sacc+=pB0[r]; _Pragma("unroll") for(int r=0;r<16;++r)sacc+=pB1[r]; l_reg+=sacc;
    pw0=(u32x4){PKW(pB0,0),PKW(pB0,2),PKW(pB0,4),PKW(pB0,6)};pw1=(u32x4){PKW(pB0,8),PKW(pB0,10),PKW(pB0,12),PKW(pB0,14)};pw2=(u32x4){PKW(pB1,0),PKW(pB1,2),PKW(pB1,4),PKW(pB1,6)};pw3=(u32x4){PKW(pB1,8),PKW(pB1,10),PKW(pB1,12),PKW(pB1,14)};
    SBAR(); pv(o,vb0+sl_cur,PAF(0),PAF(1),PAF(2),PAF(3)); }
  #undef PKW
  #undef PAF
  #undef VFR
  #undef PIN
  #undef MX3
  #undef GAPA
  #undef GAPB
  #undef EX
  #undef VRD
  #undef KRD
  #undef STEP
  #undef ENDW
  {auto rr=__builtin_amdgcn_permlane32_swap(__float_as_uint(l_reg),__float_as_uint(l_reg),false,false);l_reg=__uint_as_float(rr[0])+__uint_as_float(rr[1]);}
  if(hi==0)wsf[32+r32]=l_reg;asm volatile("s_waitcnt lgkmcnt(0)":::"memory");
  float rli[16];
  #pragma unroll
  for(int r=0;r<16;++r)rli[r]=__builtin_amdgcn_rcpf(wsf[32+crow(r,hi)]);
  bf16*Ow=O+(rowbase+q0+wid*QBLK)*DMO+h*D;
  { bf16*stg=(bf16*)(shm+LDS_OST)+wid*2048;
    #pragma unroll
    for(int r=0;r<16;++r){const int orow=crow(r,hi);
      #pragma unroll
      for(int d0=0;d0<2;++d0)stg[orow*64+d0*32+r32]=__float2bfloat16(o[d0][r]*rli[r]);}
    asm volatile("s_waitcnt lgkmcnt(0)":::"memory");
    #pragma unroll
    for(int i=0;i<4;++i){const int row=i*8+(lane>>3),ch=lane&7; const u32x4 v=*(const u32x4*)(stg+row*64+ch*8); ATTN_STORE16(Ow+(long)row*DMO+ch*8,v);} }
  asm volatile("s_waitcnt lgkmcnt(0)\n\ts_barrier":::"memory");
  #undef LOADB
  #undef DMA_K
  #undef DMA_V
  #undef CMASK
  #undef START
  #undef RESC
  #undef ROT
}
constexpr int ATTN_LDS_BYTES=LDS_BYTES;
struct AttnTensors { const bf16* Q; const bf16* K; const bf16* V; bf16* O; const float* csum; };
struct AttnUnit { int bh; int qb; };
template<int THRL> __device__ __forceinline__ void attn_phase(char*lds,const AttnTensors&T){
  const int G=gridDim.x,bx=blockIdx.x; const int vcu=(G%8==0)?(bx%8)*(G/8)+bx/8:bx;
  for(int v=vcu;v<256;v+=G){ const int s=v&3,bh=v>>2;
    for(int i=0;i<4;++i){ const int qb=(i==0)?15-s:(i==1)?8+s:(i==2)?7-s:s; attn_unit<THRL>(bh/NHEAD,bh%NHEAD,qb,T.Q,T.K,T.V,T.O,T.csum,lds); } }
}
#undef SBAR
#undef WAIT_BAR
}

__device__ __forceinline__ void phase_mix_naive(const Args& a, LAS unsigned char* lds) {
    const int tid = threadIdx.x, lane = tid & 63, wave = tid >> 6;
    LAS float* vt = (LAS float*)lds;
    bf16_t* Ub = (bf16_t*)(a.ws + WS_ARENA + AR_U); const bf16_t* V3 = (const bf16_t*)(a.ws + WS_ARENA + AR_V3); const float* vstat = (const float*)(a.ws + WS_VSTAT);
    const bf16_t* tril = (const bf16_t*)(a.ws + WS_TRIL);
    for (int u = blockIdx.x; u < (T / CCH) * CG; u += gridDim.x) {
        const int g = u & 7, n = u >> 3; const size_t row0 = (size_t)n * CCH;
        __syncthreads();
        for (int i = tid; i < 128 * 64; i += NTHREADS) {
            const int s = i >> 6, c4 = (i & 63) * 4; const size_t row = row0 + s;
            const float* st = vstat + row * 32; float tot = 0.f;
#pragma unroll
            for (int j = 0; j < 32; ++j) tot += st[j];
            const float rs = rsqrtf(tot * (1.f / CW) + EPS);
            const u32x2 v = *(const u32x2*)(V3 + row * CW + 256 * g + c4); const float* gn = a.in[I_CVG] + 256 * g + c4;
            *(LAS f32x4*)(vt + s * 256 + c4) = (f32x4){bf_lo(v.x) * rs * gn[0], bf_hi(v.x) * rs * gn[1], bf_lo(v.y) * rs * gn[2], bf_hi(v.y) * rs * gn[3]};
        }
        __syncthreads();
        for (int tt = 0; tt < 16; ++tt) {
            const int t = wave * 16 + tt; const bf16_t* wrow = tril + ((size_t)g * 128 + t) * 128;
            f32x4 acc = (f32x4){0.f, 0.f, 0.f, 0.f};
            for (int s = 0; s <= t; ++s) { const float w = bf2f(wrow[s]); const f32x4 v = *(const LAS f32x4*)(vt + s * 256 + 4 * lane); acc += v * w; }
            const float bs = a.in[I_CBS][g * 128 + t];
            u32x2* up = (u32x2*)(Ub + (row0 + t) * CW + 256 * g + 4 * lane); const u32x2 uv = *up;
            u32x2 o; o.x = pk2(bf_lo(uv.x) * (acc.x + bs), bf_hi(uv.x) * (acc.y + bs)); o.y = pk2(bf_lo(uv.y) * (acc.z + bs), bf_hi(uv.y) * (acc.w + bs));
            *up = o;
        }
    }
    __syncthreads();
}

__device__ __forceinline__ void phase_route(const Args& a, LAS unsigned char* lds, int l) {
    const int tid = threadIdx.x;
    LAS int* hist = (LAS int*)lds; LAS int* base = hist + 32;
    const float* rlog = (const float*)(a.ws + WS_RLOG); float* pairw = (float*)(a.ws + WS_PAIRW); int* list = (int*)(a.ws + WS_LIST); int* cnt = (int*)(a.ws + WS_CTL) + 64 * l;
    for (int cb = blockIdx.x; cb < T / 256; cb += gridDim.x) {
        __syncthreads();
        if (tid < 32) hist[tid] = 0;
        __syncthreads();
        int e0 = 0, e1 = 0, r0 = 0, r1 = 0; const int tok = cb * 256 + (tid & 255);
        if (tid < 256) {
            const float* lg = rlog + (size_t)tok * 40;
            int gi = 0; float gm = lg[0];
#pragma unroll
            for (int j = 1; j < 4; ++j) if (lg[j] > gm) { gm = lg[j]; gi = j; }
            float gs = 0.f;
#pragma unroll
            for (int j = 0; j < 4; ++j) gs += __expf(lg[j] - gm);
            const float gw = 1.f / gs;
            const float* el = lg + 4 + 8 * gi;
            int i0 = 0; float v0 = el[0];
#pragma unroll
            for (int j = 1; j < 8; ++j) if (el[j] > v0) { v0 = el[j]; i0 = j; }
            int i1 = -1; float v1 = -INFINITY;
#pragma unroll
            for (int j = 0; j < 8; ++j) if (j != i0 && el[j] > v1) { v1 = el[j]; i1 = j; }
            const float ex = __expf(v1 - v0), den = 1.f / (1.f + ex);
            pairw[2 * tok] = gw * den; pairw[2 * tok + 1] = gw * ex * den;
            e0 = gi * 8 + i0; e1 = gi * 8 + i1;
            r0 = atomicAdd((int*)&hist[e0], 1); r1 = atomicAdd((int*)&hist[e1], 1);
        }
        __syncthreads();
        if (tid < 32) base[tid] = hist[tid] ? atomicAdd(&cnt[tid], hist[tid]) : 0;
        __syncthreads();
        if (tid < 256) { list[(size_t)e0 * 65536 + base[e0] + r0] = 2 * tok; list[(size_t)e1 * 65536 + base[e1] + r1] = 2 * tok + 1; }
    }
    __syncthreads();
}

__device__ __forceinline__ void phase_combine(const Args& a, bool last) {
    const int lane = threadIdx.x & 63, wave = threadIdx.x >> 6;
    const int gw = blockIdx.x * NWAVES + wave, NGW = gridDim.x * NWAVES;
    bf16_t* X = (bf16_t*)(a.ws + WS_X); const bf16_t* Y = (const bf16_t*)(a.ws + WS_ARENA + AR_Y); float* xstat = (float*)(a.ws + WS_XSTAT);
    for (int row = gw; row < T; row += NGW) {
        float ss = 0.f;
#pragma unroll
        for (int hlf = 0; hlf < 2; ++hlf) {
            const int c0 = 512 * hlf + 8 * lane;
            const u32x4 xv = *(const u32x4*)(X + (size_t)row * D + c0), y0 = *(const u32x4*)(Y + (size_t)(2 * row) * D + c0), y1 = *(const u32x4*)(Y + (size_t)(2 * row + 1) * D + c0);
            float v[8] = {bf_lo(xv.x), bf_hi(xv.x), bf_lo(xv.y), bf_hi(xv.y), bf_lo(xv.z), bf_hi(xv.z), bf_lo(xv.w), bf_hi(xv.w)};
            const float p[8] = {bf_lo(y0.x), bf_hi(y0.x), bf_lo(y0.y), bf_hi(y0.y), bf_lo(y0.z), bf_hi(y0.z), bf_lo(y0.w), bf_hi(y0.w)};
            const float q[8] = {bf_lo(y1.x), bf_hi(y1.x), bf_lo(y1.y), bf_hi(y1.y), bf_lo(y1.z), bf_hi(y1.z), bf_lo(y1.w), bf_hi(y1.w)};
#pragma unroll
            for (int j = 0; j < 8; ++j) v[j] = (v[j] + p[j]) + q[j];
            if (last) { float* o = a.out + (size_t)row * D + c0; *(f32x4*)o = (f32x4){v[0], v[1], v[2], v[3]}; *(f32x4*)(o + 4) = (f32x4){v[4], v[5], v[6], v[7]}; }
            else { u32x4 w; w.x = pk2(v[0], v[1]); w.y = pk2(v[2], v[3]); w.z = pk2(v[4], v[5]); w.w = pk2(v[6], v[7]); *(u32x4*)(X + (size_t)row * D + c0) = w;
                const float r[8] = {bf_lo(w.x), bf_hi(w.x), bf_lo(w.y), bf_hi(w.y), bf_lo(w.z), bf_hi(w.z), bf_lo(w.w), bf_hi(w.w)};
#pragma unroll
                for (int j = 0; j < 8; ++j) ss += r[j] * r[j]; }
        }
        if (!last) { ss = wave_sum(ss); if (lane < 16) xstat[(size_t)row * 16 + lane] = lane == 0 ? ss : 0.f; }
    }
}

constexpr int NPHASES = 26;
#ifdef ONLY_PHASE
#define PH(k) if (((k) == ONLY_PHASE || (k) == ONLY_PHASE2) && a.ph_lo <= (k) && (k) < a.ph_hi)
#else
#define PH(k) if (a.ph_lo <= (k) && (k) < a.ph_hi)
#endif
#define SYNC(k) do { if ((k) + 1 < a.ph_hi) cg::this_grid().sync(); } while (0)

template <int L> __device__ __forceinline__ void layer_tail(const Args& a, LAS unsigned char* lds, const int base) {
    unsigned char* ws = a.ws; unsigned char* ar = ws + WS_ARENA;
    bf16_t* X = (bf16_t*)(ws + WS_X); float* xstat = (float*)(ws + WS_XSTAT);
    volatile LAS int* tpre = (volatile LAS int*)(lds + 131072);
    PH(base + 0) { PCrossQ p; p.nM = T / 256; p.nN = 4; p.X = X; p.W = (const bf16_t*)(ws + WS_W_Q) + (size_t)L * D * D; p.xstat = xstat; p.Q2 = (bf16_t*)(ar + AR_Q2); p.qstat = (float*)(ws + WS_QSTAT); p.lda = D; p.ldb = D; p.K = D; run_gemm(lds, p); SYNC(base + 0); }
    PH(base + 1) { PCrossS p; p.nM = T / 256; p.nN = 4; p.Q2 = (const bf16_t*)(ar + AR_Q2); p.K2 = (const bf16_t*)(ws + WS_K2) + (size_t)L * 2048 * 1024; p.qstat = (const float*)(ws + WS_QSTAT); p.P = (bf16_t*)(ar + AR_P); p.psum = (float*)(ws + WS_PSUM); p.lda = D; p.ldb = 256; p.K = 256; run_gemm(lds, p); SYNC(base + 1); }
    PH(base + 2) { PCrossPV p; p.nM = T / 256; p.nN = 4; p.P = (const bf16_t*)(ar + AR_P); p.V2T = (const bf16_t*)(ws + WS_V2T) + (size_t)L * 2048 * 1024; p.psum = (const float*)(ws + WS_PSUM); p.O = (bf16_t*)(ar + AR_O); p.lda = D; p.ldb = 256; p.K = 256; run_gemm(lds, p); SYNC(base + 2); }
    PH(base + 3) { PResid p; p.nM = T / 256; p.nN = 4; p.A = (const bf16_t*)(ar + AR_O); p.W = (const bf16_t*)(ws + WS_W_O) + (size_t)L * D * D; p.X = X; p.xstat = xstat; p.lda = D; p.ldb = D; p.K = D; run_gemm(lds, p); SYNC(base + 3); }
    PH(base + 4) { PRouter p; p.nM = T / 256; p.nN = 1; p.X = X; p.W = (const bf16_t*)(ws + WS_W_R) + (size_t)L * 256 * D; p.xstat = xstat; p.bg = a.in[I_MBG] + L * 4; p.be = a.in[I_MBE] + L * 32; p.rlog = (float*)(ws + WS_RLOG); p.lda = D; p.ldb = D; p.K = D; run_gemm(lds, p); SYNC(base + 4); }
    PH(base + 5) { phase_route(a, lds, L); SYNC(base + 5); }
    PH(base + 6) { PMoeUp p; p.cnt = (const int*)(ws + WS_CTL) + 64 * L; p.list = (const int*)(ws + WS_LIST); p.tpre = tpre; p.X = X; p.W = (const bf16_t*)(ws + WS_W_GU); p.xstat = xstat; p.H = (bf16_t*)(ar + AR_H); p.lda = D; p.ldb = D; p.K = D;
        moe_sched_build(p.cnt, tpre); run_gemm(lds, p); SYNC(base + 6); }
    PH(base + 7) { PMoeDown p; p.cnt = (const int*)(ws + WS_CTL) + 64 * L; p.list = (const int*)(ws + WS_LIST); p.tpre = tpre; p.H = (const bf16_t*)(ar + AR_H); p.W = (const bf16_t*)(ws + WS_W_DN); p.pairw = (const float*)(ws + WS_PAIRW); p.Y = (bf16_t*)(ar + AR_Y); p.lda = DEXP; p.ldb = DEXP; p.K = DEXP;
        moe_sched_build(p.cnt, tpre); run_gemm(lds, p); SYNC(base + 7); }
    PH(base + 8) { phase_combine(a, L == 1); SYNC(base + 8); }
}

__global__ void __launch_bounds__(NTHREADS, 2) fwd_kernel(Args a) {
    extern __shared__ __attribute__((aligned(16))) unsigned char lds_raw[];
    LAS unsigned char* lds = (LAS unsigned char*)lds_raw;
    unsigned char* ws = a.ws;
    bf16_t* X = (bf16_t*)(ws + WS_X); float* xstat = (float*)(ws + WS_XSTAT);
    unsigned char* ar = ws + WS_ARENA;
    PH(0) { phase_prologue(a, lds); SYNC(0); }
    PH(1) {
        phase_cumsum(a, lds);
        { PInProj0 p; p.nM = T / 256; p.nN = 10; p.X = X; p.W = (const bf16_t*)(ws + WS_W_IN0); p.xstat = xstat; p.qg = a.in[I_AQG]; p.kg = a.in[I_AKG];
          p.Q = (bf16_t*)(ar + AR_Q); p.Kq = (bf16_t*)(ar + AR_K); p.V = (bf16_t*)(ar + AR_V); p.XB = (bf16_t*)(ar + AR_XB); p.GATE = (bf16_t*)(ar + AR_GATE); p.lda = D; p.ldb = D; p.K = D;
          run_gemm(lds, p); }
        { PMemKV m; m.nM = 8; m.nN = 16; m.A = (const bf16_t*)(ws + WS_MEMB); m.W = (const bf16_t*)(ws + WS_W_KV); m.memstat = (const float*)(ws + WS_MISC + MISC_MEMSTAT);
          m.k2stat_ = (float*)(ws + WS_MISC + MISC_K2STAT); m.K2_ = (bf16_t*)(ws + WS_K2); m.V2T_ = (bf16_t*)(ws + WS_ARENA + AR_V2TMP); m.lda = D; m.ldb = D; m.K = D;
          run_gemm(lds, m); }
        SYNC(1);
    }
    PH(2) { phase_k2fin(a); phase_lru(a, lds, 0); SYNC(2); }
    PH(3) { phase_lru(a, lds, 1);
#if FAST_ATTN
        { const attn_body::AttnTensors AT{(const attn_body::bf16*)(ar + AR_Q), (const attn_body::bf16*)(ar + AR_K), (const attn_body::bf16*)(ar + AR_V), (attn_body::bf16*)(ar + AR_AR), (const float*)(ws + WS_CSUM)};
          __syncthreads(); attn_body::attn_phase<ATTN_THRL>((char*)lds_raw, AT); __syncthreads(); }
#else
        phase_attn_naive(a);
#endif
        SYNC(3); }
    PH(4) { PResid p; p.nM = T / 256; p.nN = 4; p.A = (const bf16_t*)(ar + AR_AR); p.W = (const bf16_t*)(ws + WS_W_OUT0); p.X = X; p.xstat = xstat; p.lda = D; p.ldb = D; p.K = D; run_gemm(lds, p); SYNC(4); }
    layer_tail<0>(a, lds, 5);
    PH(14) { conv_moe_layer(a, 1, lds);
        PInProj1 p; p.nM = T / 256; p.nN = 16; p.X = X; p.W = (const bf16_t*)(ws + WS_W_IN1); p.xstat = xstat; p.bias = a.in[I_CBIN]; p.Ub = (bf16_t*)(ar + AR_U); p.V3 = (bf16_t*)(ar + AR_V3); p.vstat = (float*)(ws + WS_VSTAT); p.lda = D; p.ldb = D; p.K = D;
        __syncthreads(); run_gemm(lds, p); SYNC(14); }
    PH(15) { phase_mix_naive(a, lds); SYNC(15); }
    PH(16) { PResid p; p.nM = T / 256; p.nN = 4; p.A = (const bf16_t*)(ar + AR_U); p.W = (const bf16_t*)(ws + WS_W_OUT1); p.X = X; p.xstat = xstat; p.lda = CW; p.ldb = CW; p.K = CW; run_gemm(lds, p); SYNC(16); }
    layer_tail<1>(a, lds, 17);
}

extern "C" void kernel_launch(void* const* d_in, const int* in_sizes, int n_in, void* d_out, int out_size, void* d_ws, size_t ws_size, hipStream_t stream) {
    static int grid = 0;
    if (grid == 0) {
        if (n_in != 36 || out_size != T * D || ws_size < WS_END) { fprintf(stderr, "kernel_launch: unexpected sizes n_in %d out %d ws %zu\n", n_in, out_size, ws_size); grid = -1; return; }
        int dev = 0, cus = 0, per_cu = 0;
        hipGetDevice(&dev); hipDeviceGetAttribute(&cus, hipDeviceAttributeMultiprocessorCount, dev);
        hipFuncSetAttribute((const void*)fwd_kernel, hipFuncAttributeMaxDynamicSharedMemorySize, LDS_BYTES);
        hipOccupancyMaxActiveBlocksPerMultiprocessor(&per_cu, (const void*)fwd_kernel, NTHREADS, LDS_BYTES);
        if (per_cu < 1) { fprintf(stderr, "kernel_launch: occupancy query says %d blocks per CU\n", per_cu); per_cu = 1; }
        (void)hipGetLastError();
        grid = cus;
    }
    if (grid < 0) return;
    hipMemsetAsync((char*)d_ws + WS_CTL, 0, 4096, stream);
    Args a{};
    for (int i = 0; i < 36; ++i) a.in[i] = (const float*)d_in[i];
    a.out = (float*)d_out; a.ws = (unsigned char*)d_ws;
#if ONE_LAUNCH
    a.ph_lo = 0; a.ph_hi = NPHASES;
    void* args[] = {&a};
    hipError_t e = hipLaunchCooperativeKernel((const void*)fwd_kernel, dim3(grid), dim3(NTHREADS), args, LDS_BYTES, stream);
    if (e != hipSuccess) fprintf(stderr, "cooperative launch failed: %s (grid %d)\n", hipGetErrorString(e), grid);
#else
    for (int ph = 0; ph < NPHASES; ++ph) { a.ph_lo = ph; a.ph_hi = ph + 1; hipLaunchKernelGGL(fwd_kernel, dim3(grid), dim3(NTHREADS), LDS_BYTES, stream, a); }
#endif
}
```

```cpp
#include <hip/hip_runtime.h>
#include <hip/hip_cooperative_groups.h>
#include <cstdint>
#include <cstdio>
namespace cg = cooperative_groups;

#ifndef FAST_CORE
#define FAST_CORE 1
#endif
#ifndef FAST_MIX
#define FAST_MIX 1
#endif
#ifndef USE_CG_SYNC
#define USE_CG_SYNC 0
#endif
#ifndef FAST_ATTN
#define FAST_ATTN 1
#endif
#ifndef ATTN_THRL
#define ATTN_THRL 32
#endif
#ifndef ONLY_PHASE2
#define ONLY_PHASE2 -1
#endif
#ifndef ONE_LAUNCH
#define ONE_LAUNCH 1
#endif

#define LAS __attribute__((address_space(3)))
typedef unsigned short bf16_t;
typedef short bf16x8 __attribute__((ext_vector_type(8)));
typedef float f32x4 __attribute__((ext_vector_type(4)));
typedef float f32x2 __attribute__((ext_vector_type(2)));
typedef unsigned u32x4 __attribute__((ext_vector_type(4)));
typedef unsigned u32x2 __attribute__((ext_vector_type(2)));

constexpr int NB = 8, SEQ = 4096, T = NB * SEQ, D = 1024;
constexpr int AH = 8, HD = 64, AW = 512, BW = 512;
constexpr int INAB = 2568;
constexpr int CW = 2048, CG = 8, CCH = 128;
constexpr int MEML = 256, XH = 4, XHD = 256;
constexpr int NGRP = 4, EPG = 8, NEXP = 32, DEXP = 512;
constexpr float EPS = 1e-6f;
constexpr float LOG2E = 1.4426950408889634f;
constexpr float C2 = 0.125f * LOG2E;
constexpr float C3 = 0.0625f * LOG2E;
constexpr int NTHREADS = 512, NWAVES = 8;
constexpr int LDS_BYTES = 147456;

constexpr size_t MiB = 1ull << 20;
constexpr size_t WS_CTL = 0;
constexpr size_t WS_W_IN0 = 1 * MiB, WS_W_OUT0 = 6 * MiB, WS_W_IN1 = 8 * MiB, WS_W_OUT1 = 16 * MiB;
constexpr size_t WS_W_Q = 20 * MiB, WS_W_KV = 24 * MiB, WS_W_O = 32 * MiB, WS_W_R = 36 * MiB, WS_TRIL = 37 * MiB;
constexpr size_t WS_W_GU = 38 * MiB, WS_W_DN = 102 * MiB;
constexpr size_t WS_X = 134 * MiB, WS_MEMB = 198 * MiB, WS_K2 = 202 * MiB, WS_V2T = 210 * MiB;
constexpr size_t WS_XSTAT = 218 * MiB, WS_VSTAT = 220 * MiB, WS_QSTAT = 224 * MiB, WS_PSUM = 226 * MiB;
constexpr size_t WS_FLOG = 228 * MiB, WS_CSUM = 229 * MiB, WS_LSUM = 230 * MiB, WS_MISC = 231 * MiB;
constexpr size_t WS_RLOG = 232 * MiB, WS_PAIRW = 238 * MiB, WS_LIST = 239 * MiB, WS_ARENA = 248 * MiB, WS_END = 504 * MiB;
constexpr size_t AR_Q = 0, AR_K = 32 * MiB, AR_V = 64 * MiB, AR_XB = 96 * MiB, AR_GATE = 128 * MiB, AR_AR = 160 * MiB;
constexpr size_t AR_V2TMP = 224 * MiB;
constexpr size_t AR_Q2 = 0, AR_P = 64 * MiB, AR_O = 128 * MiB;
constexpr size_t AR_H = 0, AR_Y = 64 * MiB;
constexpr size_t AR_U = 0, AR_V3 = 128 * MiB;
constexpr size_t MISC_MEMSTAT = 0, MISC_K2STAT = 65536;

struct Args { const float* in[36]; float* out; unsigned char* ws; int ph_lo, ph_hi; };
enum { I_X = 0, I_MEM, I_NMIX, I_NCROSS, I_NMEM, I_NFFN, I_ABWIN, I_FBIAS, I_AQG, I_AKG, I_CONVW, I_CONVB, I_WA, I_BA, I_WX, I_BX, I_LAM, I_ABWOUT,
       I_CWIN, I_CBIN, I_CVG, I_CWS, I_CBS, I_CWOUT, I_XWQ, I_XWKV, I_XWO, I_XQG, I_XKG, I_MWG, I_MBG, I_MWE, I_MBE, I_MGATE, I_MUP, I_MDOWN };

__device__ __forceinline__ float bf_lo(unsigned u) { return __uint_as_float(u << 16); }
__device__ __forceinline__ float bf_hi(unsigned u) { return __uint_as_float(u & 0xffff0000u); }
__device__ __forceinline__ float bf2f(bf16_t v) { return __uint_as_float((unsigned)v << 16); }
__device__ __forceinline__ unsigned pk2(float lo, float hi) { typedef __bf16 bf2_t __attribute__((ext_vector_type(2))); f32x2 v = {lo, hi}; bf2_t b = __builtin_convertvector(v, bf2_t); return __builtin_bit_cast(unsigned, b); }
__device__ __forceinline__ bf16_t f2bf(float f) { return (bf16_t)(pk2(f, 0.f) & 0xffffu); }
__device__ __forceinline__ float wave_sum(float v) {
#pragma unroll
    for (int o = 1; o < 64; o <<= 1) v += __shfl_xor(v, o);
    return v;
}
__device__ __forceinline__ float gelu_tanh(float x) { const float u = 0.7978845608028654f * (x + 0.044715f * x * x * x); return x / (1.f + __expf(-2.f * u)); }
__device__ __forceinline__ float sigmoidf(float x) { return 1.f / (1.f + __expf(-x)); }
__device__ __forceinline__ float sum16(const float* p) { const f32x4 a = *(const f32x4*)p, b = *(const f32x4*)(p + 4), c = *(const f32x4*)(p + 8), d = *(const f32x4*)(p + 12);
    return ((a.x + a.y) + (a.z + a.w)) + ((b.x + b.y) + (b.z + b.w)) + ((c.x + c.y) + (c.z + c.w)) + ((d.x + d.y) + (d.z + d.w)); }
__device__ __forceinline__ int perm32(int rho) { const int n = rho >> 4, i = rho & 15; return 8 * (i >> 2) + 4 * n + (i & 3); }

struct U { int pm, pn, e, cnt; };
__device__ __forceinline__ int brow_std(int bj, int S) { return 64 * (S >> 5) + 32 * bj + perm32(S & 31); }
typedef f32x4 Acc[2][2][4][2];

template <class P> __device__ __forceinline__ void gemm_naive(const P& p) {
    const int tid = threadIdx.x, wid = tid >> 6, lane = tid & 63, wr = wid >> 2, wc = wid & 3, fr = lane & 15, fq = lane >> 4;
    for (int i = 0;; ++i) {
        U u; if (!p.unit(i * (int)gridDim.x + (int)blockIdx.x, u)) break;
        Acc acc;
#pragma unroll
        for (int a = 0; a < 2; ++a)
#pragma unroll
            for (int b = 0; b < 2; ++b)
#pragma unroll
                for (int m = 0; m < 4; ++m)
#pragma unroll
                    for (int n = 0; n < 2; ++n) acc[a][b][m][n] = (f32x4){0.f, 0.f, 0.f, 0.f};
        const bf16_t* A = p.a_ptr(u); const bf16_t* B = p.b_ptr(u); const int lda = p.lda, ldb = p.ldb, K = p.K;
        unsigned aoff[8], boff[16];
#pragma unroll
        for (int ai = 0; ai < 2; ++ai)
#pragma unroll
            for (int m = 0; m < 4; ++m) aoff[ai * 4 + m] = (unsigned)p.a_row(u, 128 * ai + 64 * wr + 16 * m + fr) * (unsigned)lda;
#pragma unroll
        for (int bj = 0; bj < 2; ++bj)
#pragma unroll
            for (int n = 0; n < 2; ++n)
#pragma unroll
                for (int e = 0; e < 4; ++e) boff[bj * 8 + n * 4 + e] = (unsigned)P::b_row(bj, 32 * wc + 16 * n + 4 * fq + e) * (unsigned)ldb;
        for (int k0 = 0; k0 < K; k0 += 2) {
            float af[8][2];
#pragma unroll
            for (int r = 0; r < 8; ++r) { const unsigned v = *(const unsigned*)(A + aoff[r] + k0); af[r][0] = bf_lo(v); af[r][1] = bf_hi(v); }
#pragma unroll
            for (int bj = 0; bj < 2; ++bj)
#pragma unroll
                for (int n = 0; n < 2; ++n)
#pragma unroll
                    for (int e = 0; e < 4; ++e) {
                        const unsigned v = *(const unsigned*)(B + boff[bj * 8 + n * 4 + e] + k0);
                        const float b0 = bf_lo(v), b1 = bf_hi(v);
#pragma unroll
                        for (int ai = 0; ai < 2; ++ai)
#pragma unroll
                            for (int m = 0; m < 4; ++m) { const float* x = af[ai * 4 + m]; acc[ai][bj][m][n][e] += x[0] * b0 + x[1] * b1; }
                    }
        }
        p.epi(acc, u, wr, wc, fr, fq);
    }
}

struct PlainSched {
    int nM, nN;
    __device__ __forceinline__ bool unit(int L, U& u) const { if (L >= nM * nN) return false; u.pm = L / nN; u.pn = L - u.pm * nN; u.e = 0; u.cnt = 0; return true; }
};

struct PInProj0 : PlainSched {
    static constexpr bool GATHER = false; static constexpr int ID = 0;
    const bf16_t* X; const bf16_t* W; const float* xstat; const float* qg; const float* kg; bf16_t *Q, *Kq, *V, *XB, *GATE; int lda, ldb, K;
    __device__ __forceinline__ const bf16_t* a_ptr(const U& u) const { return X + (size_t)u.pm * 256 * D; }
    __device__ __forceinline__ int a_row(const U&, int R) const { return R; }
    __device__ __forceinline__ const bf16_t* b_ptr(const U& u) const { return W + (size_t)u.pn * 256 * D; }
    static __device__ __forceinline__ int b_row(int bj, int S) { return brow_std(bj, S); }
    __device__ __forceinline__ void epi(Acc& acc, const U& u, int wr, int wc, int fr, int fq) const {
        const int kind = u.pn >> 1, half = u.pn & 1;
        bf16_t* dst = kind == 0 ? Q : kind == 1 ? Kq : kind == 2 ? V : kind == 3 ? XB : GATE;
        const float* gain = kind == 0 ? qg : kg;
        float sc[8];
#pragma unroll
        for (int ai = 0; ai < 2; ++ai)
#pragma unroll
            for (int m = 0; m < 4; ++m) {
                const int row = u.pm * 256 + 128 * ai + 64 * wr + 16 * m + fr;
                const float s = rsqrtf(sum16(xstat + (size_t)row * 16) * (1.f / D) + EPS);
                float r = s;
                if (kind <= 1) {
                    float ss = 0.f;
#pragma unroll
                    for (int bj = 0; bj < 2; ++bj)
#pragma unroll
                        for (int n = 0; n < 2; ++n)
#pragma unroll
                            for (int e = 0; e < 4; ++e) { const float v = acc[ai][bj][m][n][e] * s; ss += v * v; }
                    ss += __shfl_xor(ss, 16); ss += __shfl_xor(ss, 32);
                    r = s * rsqrtf(ss * (1.f / HD) + EPS) * (kind == 0 ? C2 : 1.f);
                }
                sc[ai * 4 + m] = r;
            }
#pragma unroll
        for (int bj = 0; bj < 2; ++bj) {
            float g[8];
#pragma unroll
            for (int j = 0; j < 8; ++j) g[j] = kind <= 1 ? gain[32 * bj + 8 * fq + j] : 1.f;
#pragma unroll
            for (int ai = 0; ai < 2; ++ai)
#pragma unroll
                for (int m = 0; m < 4; ++m) {
                    const int row = u.pm * 256 + 128 * ai + 64 * wr + 16 * m + fr;
                    float v[8];
#pragma unroll
                    for (int j = 0; j < 8; ++j) v[j] = acc[ai][bj][m][j >> 2][j & 3] * sc[ai * 4 + m] * g[j];
                    if (kind == 4) {
#pragma unroll
                        for (int j = 0; j < 8; ++j) v[j] = gelu_tanh(v[j]);
                    }
                    u32x4 w; w.x = pk2(v[0], v[1]); w.y = pk2(v[2], v[3]); w.z = pk2(v[4], v[5]); w.w = pk2(v[6], v[7]);
                    *(u32x4*)(dst + (size_t)row * 512 + 256 * half + 64 * wc + 32 * bj + 8 * fq) = w;
                }
        }
    }
};

struct PMemKV : PlainSched {
    static constexpr bool GATHER = false; static constexpr int ID = 1;
    const bf16_t* A; const bf16_t* W; const float* memstat; float* k2stat_; bf16_t* K2_; bf16_t* V2T_; int lda, ldb, K;
    __device__ __forceinline__ const bf16_t* a_ptr(const U& u) const { return A + (size_t)u.pm * 256 * D; }
    __device__ __forceinline__ int a_row(const U&, int R) const { return R; }
    __device__ __forceinline__ const bf16_t* b_ptr(const U& u) const { return W + (size_t)u.pn * 256 * D; }
    static __device__ __forceinline__ int b_row(int bj, int S) { return brow_std(bj, S); }
    __device__ __forceinline__ void epi(Acc& acc, const U& u, int wr, int wc, int fr, int fq) const {
        const int b = u.pm, h = u.pn & 3, ly = u.pn >> 3; const bool isv = (u.pn & 4) != 0;
        float* k2stat = k2stat_ + (size_t)ly * 2048 * 16; bf16_t* K2 = K2_ + (size_t)ly * 2048 * 1024; bf16_t* V2T = V2T_ + (size_t)ly * 2048 * 1024;
        bf16_t* dst = (isv ? V2T : K2) + (size_t)(b * 4 + h) * 65536;
        int lrow = 64 * wr + fr; asm volatile("" : "+v"(lrow));
#pragma unroll
        for (int ai = 0; ai < 2; ++ai)
#pragma unroll
            for (int m = 0; m < 4; ++m) {
                const int key = 128 * ai + 16 * m + lrow, row = b * 256 + key;
                const float s = rsqrtf(memstat[row] * (1.f / D) + EPS);
                float ss = 0.f;
#pragma unroll
                for (int bj = 0; bj < 2; ++bj) {
                    float v[8];
#pragma unroll
                    for (int j = 0; j < 8; ++j) { v[j] = acc[ai][bj][m][j >> 2][j & 3] * s; ss += v[j] * v[j]; }
                    u32x4 w; w.x = pk2(v[0], v[1]); w.y = pk2(v[2], v[3]); w.z = pk2(v[4], v[5]); w.w = pk2(v[6], v[7]);
                    *(u32x4*)(dst + (size_t)key * 256 + 64 * wc + 32 * bj + 8 * fq) = w;
                }
                ss += __shfl_xor(ss, 16); ss += __shfl_xor(ss, 32);
                if (fq == 0 && !isv) k2stat[(size_t)row * 16 + 4 * h + wc] = ss;
            }
    }
};

struct PResid : PlainSched {
    static constexpr bool GATHER = false; static constexpr int ID = 2;
    const bf16_t* A; const bf16_t* W; bf16_t* X; float* xstat; int lda, ldb, K;
    __device__ __forceinline__ const bf16_t* a_ptr(const U& u) const { return A + (size_t)u.pm * 256 * lda; }
    __device__ __forceinline__ int a_row(const U&, int R) const { return R; }
    __device__ __forceinline__ const bf16_t* b_ptr(const U& u) const { return W + (size_t)u.pn * 256 * ldb; }
    static __device__ __forceinline__ int b_row(int bj, int S) { return brow_std(bj, S); }
    __device__ __forceinline__ void epi(Acc& acc, const U& u, int wr, int wc, int fr, int fq) const {
#pragma unroll
        for (int ai = 0; ai < 2; ++ai)
#pragma unroll
            for (int m = 0; m < 4; ++m) {
                const int row = u.pm * 256 + 128 * ai + 64 * wr + 16 * m + fr; float ss = 0.f;
#pragma unroll
                for (int bj = 0; bj < 2; ++bj) {
                    bf16_t* xp = X + (size_t)row * D + 256 * u.pn + 64 * wc + 32 * bj + 8 * fq;
                    const u32x4 o = *(const u32x4*)xp;
                    float v[8] = {bf_lo(o.x), bf_hi(o.x), bf_lo(o.y), bf_hi(o.y), bf_lo(o.z), bf_hi(o.z), bf_lo(o.w), bf_hi(o.w)};
#pragma unroll
                    for (int n = 0; n < 2; ++n)
#pragma unroll
                        for (int e = 0; e < 4; ++e) v[n * 4 + e] += acc[ai][bj][m][n][e];
                    u32x4 w; w.x = pk2(v[0], v[1]); w.y = pk2(v[2], v[3]); w.z = pk2(v[4], v[5]); w.w = pk2(v[6], v[7]);
                    *(u32x4*)xp = w;
                    const float r[8] = {bf_lo(w.x), bf_hi(w.x), bf_lo(w.y), bf_hi(w.y), bf_lo(w.z), bf_hi(w.z), bf_lo(w.w), bf_hi(w.w)};
#pragma unroll
                    for (int j = 0; j < 8; ++j) ss += r[j] * r[j];
                }
                ss += __shfl_xor(ss, 16); ss += __shfl_xor(ss, 32);
                if (fq == 0) xstat[(size_t)row * 16 + 4 * u.pn + wc] = ss;
            }
    }
};

struct PCrossQ : PlainSched {
    static constexpr bool GATHER = false; static constexpr int ID = 3;
    const bf16_t* X; const bf16_t* W; const float* xstat; bf16_t* Q2; float* qstat; int lda, ldb, K;
    __device__ __forceinline__ const bf16_t* a_ptr(const U& u) const { return X + (size_t)u.pm * 256 * D; }
    __device__ __forceinline__ int a_row(const U&, int R) const { return R; }
    __device__ __forceinline__ const bf16_t* b_ptr(const U& u) const { return W + (size_t)u.pn * 256 * D; }
    static __device__ __forceinline__ int b_row(int bj, int S) { return brow_std(bj, S); }
    __device__ __forceinline__ void epi(Acc& acc, const U& u, int wr, int wc, int fr, int fq) const {
#pragma unroll
        for (int ai = 0; ai < 2; ++ai)
#pragma unroll
            for (int m = 0; m < 4; ++m) {
                const int row = u.pm * 256 + 128 * ai + 64 * wr + 16 * m + fr; float ss = 0.f;
                const float s = rsqrtf(sum16(xstat + (size_t)row * 16) * (1.f / D) + EPS);
#pragma unroll
                for (int bj = 0; bj < 2; ++bj) {
                    float v[8];
#pragma unroll
                    for (int n = 0; n < 2; ++n)
#pragma unroll
                        for (int e = 0; e < 4; ++e) v[n * 4 + e] = acc[ai][bj][m][n][e] * s;
                    u32x4 w; w.x = pk2(v[0], v[1]); w.y = pk2(v[2], v[3]); w.z = pk2(v[4], v[5]); w.w = pk2(v[6], v[7]);
                    *(u32x4*)(Q2 + (size_t)row * D + 256 * u.pn + 64 * wc + 32 * bj + 8 * fq) = w;
                    const float r[8] = {bf_lo(w.x), bf_hi(w.x), bf_lo(w.y), bf_hi(w.y), bf_lo(w.z), bf_hi(w.z), bf_lo(w.w), bf_hi(w.w)};
#pragma unroll
                    for (int j = 0; j < 8; ++j) ss += r[j] * r[j];
                }
                ss += __shfl_xor(ss, 16); ss += __shfl_xor(ss, 32);
                if (fq == 0) qstat[(size_t)row * 16 + 4 * u.pn + wc] = ss;
            }
    }
};

struct PCrossS : PlainSched {
    static constexpr bool GATHER = false; static constexpr int ID = 4;
    const bf16_t* Q2; const bf16_t* K2; const float* qstat; bf16_t* P; float* psum; int lda, ldb, K;
    __device__ __forceinline__ const bf16_t* a_ptr(const U& u) const { return Q2 + (size_t)u.pm * 256 * D + 256 * u.pn; }
    __device__ __forceinline__ int a_row(const U&, int R) const { return R; }
    __device__ __forceinline__ const bf16_t* b_ptr(const U& u) const { return K2 + (size_t)((u.pm >> 4) * 4 + u.pn) * 65536; }
    static __device__ __forceinline__ int b_row(int bj, int S) { return brow_std(bj, S); }
    __device__ __forceinline__ void epi(Acc& acc, const U& u, int wr, int wc, int fr, int fq) const {
#pragma unroll
        for (int ai = 0; ai < 2; ++ai)
#pragma unroll
            for (int m = 0; m < 4; ++m) {
                const int row = u.pm * 256 + 128 * ai + 64 * wr + 16 * m + fr; float ss = 0.f;
                const f32x4 qs = *(const f32x4*)(qstat + (size_t)row * 16 + 4 * u.pn);
                const float rn = rsqrtf(((qs.x + qs.y) + (qs.z + qs.w)) * (1.f / XHD) + EPS) * C3;
#pragma unroll
                for (int bj = 0; bj < 2; ++bj) {
                    float v[8];
#pragma unroll
                    for (int n = 0; n < 2; ++n)
#pragma unroll
                        for (int e = 0; e < 4; ++e) v[n * 4 + e] = exp2f(acc[ai][bj][m][n][e] * rn);
                    u32x4 w; w.x = pk2(v[0], v[1]); w.y = pk2(v[2], v[3]); w.z = pk2(v[4], v[5]); w.w = pk2(v[6], v[7]);
                    *(u32x4*)(P + (size_t)row * D + 256 * u.pn + 64 * wc + 32 * bj + 8 * fq) = w;
                    const float r[8] = {bf_lo(w.x), bf_hi(w.x), bf_lo(w.y), bf_hi(w.y), bf_lo(w.z), bf_hi(w.z), bf_lo(w.w), bf_hi(w.w)};
#pragma unroll
                    for (int j = 0; j < 8; ++j) ss += r[j];
                }
                ss += __shfl_xor(ss, 16); ss += __shfl_xor(ss, 32);
                if (fq == 0) psum[(size_t)row * 16 + 4 * u.pn + wc] = ss;
            }
    }
};

struct PCrossPV : PlainSched {
    static constexpr bool GATHER = false; static constexpr int ID = 5;
    const bf16_t* P; const bf16_t* V2T; const float* psum; bf16_t* O; int lda, ldb, K;
    __device__ __forceinline__ const bf16_t* a_ptr(const U& u) const { return P + (size_t)u.pm * 256 * D + 256 * u.pn; }
    __device__ __forceinline__ int a_row(const U&, int R) const { return R; }
    __device__ __forceinline__ const bf16_t* b_ptr(const U& u) const { return V2T + (size_t)((u.pm >> 4) * 4 + u.pn) * 65536; }
    static __device__ __forceinline__ int b_row(int bj, int S) { return brow_std(bj, S); }
    __device__ __forceinline__ void epi(Acc& acc, const U& u, int wr, int wc, int fr, int fq) const {
#pragma unroll
        for (int ai = 0; ai < 2; ++ai)
#pragma unroll
            for (int m = 0; m < 4; ++m) {
                const int row = u.pm * 256 + 128 * ai + 64 * wr + 16 * m + fr;
                const f32x4 ps = *(const f32x4*)(psum + (size_t)row * 16 + 4 * u.pn);
                const float inv = 1.f / ((ps.x + ps.y) + (ps.z + ps.w));
#pragma unroll
                for (int bj = 0; bj < 2; ++bj) {
                    float v[8];
#pragma unroll
                    for (int n = 0; n < 2; ++n)
#pragma unroll
                        for (int e = 0; e < 4; ++e) v[n * 4 + e] = acc[ai][bj][m][n][e] * inv;
                    u32x4 w; w.x = pk2(v[0], v[1]); w.y = pk2(v[2], v[3]); w.z = pk2(v[4], v[5]); w.w = pk2(v[6], v[7]);
                    *(u32x4*)(O + (size_t)row * D + 256 * u.pn + 64 * wc + 32 * bj + 8 * fq) = w;
                }
            }
    }
};

struct PRouter : PlainSched {
    static constexpr bool GATHER = false; static constexpr int ID = 6;
    const bf16_t* X; const bf16_t* W; const float* xstat; const float* bg; const float* be; float* rlog; int lda, ldb, K;
    __device__ __forceinline__ const bf16_t* a_ptr(const U& u) const { return X + (size_t)u.pm * 256 * D; }
    __device__ __forceinline__ int a_row(const U&, int R) const { return R; }
    __device__ __forceinline__ const bf16_t* b_ptr(const U&) const { return W; }
    static __device__ __forceinline__ int b_row(int bj, int S) { return brow_std(bj, S); }
    __device__ __forceinline__ void epi(Acc& acc, const U& u, int wr, int wc, int fr, int fq) const {
        if (wc != 0) return;
#pragma unroll
        for (int ai = 0; ai < 2; ++ai)
#pragma unroll
            for (int m = 0; m < 4; ++m) {
                const int row = u.pm * 256 + 128 * ai + 64 * wr + 16 * m + fr;
                const float s = rsqrtf(sum16(xstat + (size_t)row * 16) * (1.f / D) + EPS);
#pragma unroll
                for (int n = 0; n < 2; ++n)
#pragma unroll
                    for (int e = 0; e < 4; ++e) { const int c = 8 * fq + 4 * n + e; rlog[(size_t)row * 40 + c] = acc[ai][0][m][n][e] * s + (c < 4 ? bg[c] : be[c - 4]); }
                if (fq == 0) {
#pragma unroll
                    for (int e = 0; e < 4; ++e) rlog[(size_t)row * 40 + 32 + e] = acc[ai][1][m][0][e] * s + be[28 + e];
                }
            }
    }
};

struct MoeSched {
    const int* cnt; const int* list; volatile LAS int* tpre;
    __device__ __forceinline__ bool unit(int L, U& u) const {
        const int mt = L >> 2; if (mt >= tpre[32]) return false;
        int e = 0;
        for (int j = 1; j < 32; ++j) e = (mt >= tpre[j]) ? j : e;
        u.e = e; u.pm = mt - tpre[e]; u.pn = L & 3; u.cnt = cnt[e]; return true;
    }
    __device__ __forceinline__ int pair_of(const U& u, int R) const { int s = u.pm * 256 + R; s = s < u.cnt ? s : u.cnt - 1; return list[(size_t)u.e * 65536 + s]; }
};
__device__ __forceinline__ void moe_sched_build(const int* cnt, volatile LAS int* tpre) {
    __syncthreads();
    if (threadIdx.x == 0) { int acc = 0; for (int e = 0; e < 32; ++e) { tpre[e] = acc; acc += (cnt[e] + 255) >> 8; } tpre[32] = acc; }
    __syncthreads();
}
struct PMoeUp : MoeSched {
    static constexpr bool GATHER = true; static constexpr int ID = 7;
    const bf16_t* X; const bf16_t* W; const float* xstat; bf16_t* H; int lda, ldb, K;
    __device__ __forceinline__ const bf16_t* a_ptr(const U&) const { return X; }
    __device__ __forceinline__ int a_row(const U& u, int R) const { return pair_of(u, R) >> 1; }
    __device__ __forceinline__ const bf16_t* b_ptr(const U& u) const { return W + (size_t)u.e * (1024 * 1024) + (size_t)u.pn * 128 * 1024; }
    static __device__ __forceinline__ int b_row(int bj, int S) { return 512 * bj + 32 * (S >> 5) + perm32(S & 31); }
    __device__ __forceinline__ void epi(Acc& acc, const U& u, int wr, int wc, int fr, int fq) const {
#pragma unroll
        for (int ai = 0; ai < 2; ++ai)
#pragma unroll
            for (int m = 0; m < 4; ++m) {
                const int pr = pair_of(u, 128 * ai + 64 * wr + 16 * m + fr), tok = pr >> 1;
                const float s = rsqrtf(sum16(xstat + (size_t)tok * 16) * (1.f / D) + EPS);
                float v[8];
#pragma unroll
                for (int n = 0; n < 2; ++n)
#pragma unroll
                    for (int e = 0; e < 4; ++e) { const float g = acc[ai][0][m][n][e] * s, up = acc[ai][1][m][n][e] * s; v[n * 4 + e] = g / (1.f + __expf(-g)) * up; }
                u32x4 w; w.x = pk2(v[0], v[1]); w.y = pk2(v[2], v[3]); w.z = pk2(v[4], v[5]); w.w = pk2(v[6], v[7]);
                *(u32x4*)(H + (size_t)pr * DEXP + 128 * u.pn + 32 * wc + 8 * fq) = w;
            }
    }
};
struct PMoeDown : MoeSched {
    static constexpr bool GATHER = true; static constexpr int ID = 8;
    const bf16_t* H; const bf16_t* W; const float* pairw; bf16_t* Y; int lda, ldb, K;
    __device__ __forceinline__ const bf16_t* a_ptr(const U&) const { return H; }
    __device__ __forceinline__ int a_row(const U& u, int R) const { return pair_of(u, R); }
    __device__ __forceinline__ const bf16_t* b_ptr(const U& u) const { return W + (size_t)u.e * (1024 * 512) + (size_t)u.pn * 256 * 512; }
    static __device__ __forceinline__ int b_row(int bj, int S) { return brow_std(bj, S); }
    __device__ __forceinline__ void epi(Acc& acc, const U& u, int wr, int wc, int fr, int fq) const {
#pragma unroll
        for (int ai = 0; ai < 2; ++ai)
#pragma unroll
            for (int m = 0; m < 4; ++m) {
                const int pr = pair_of(u, 128 * ai + 64 * wr + 16 * m + fr); const float wgt = pairw[pr];
#pragma unroll
                for (int bj = 0; bj < 2; ++bj) {
                    float v[8];
#pragma unroll
                    for (int n = 0; n < 2; ++n)
#pragma unroll
                        for (int e = 0; e < 4; ++e) v[n * 4 + e] = acc[ai][bj][m][n][e] * wgt;
                    u32x4 w; w.x = pk2(v[0], v[1]); w.y = pk2(v[2], v[3]); w.z = pk2(v[4], v[5]); w.w = pk2(v[6], v[7]);
                    *(u32x4*)(Y + (size_t)pr * D + 256 * u.pn + 64 * wc + 32 * bj + 8 * fq) = w;
                }
            }
    }
};
struct PInProj1 : PlainSched {
    static constexpr bool GATHER = false; static constexpr int ID = 9;
    const bf16_t* X; const bf16_t* W; const float* xstat; const float* bias; bf16_t* Ub; bf16_t* V3; float* vstat; int lda, ldb, K;
    __device__ __forceinline__ const bf16_t* a_ptr(const U& u) const { return X + (size_t)u.pm * 256 * D; }
    __device__ __forceinline__ int a_row(const U&, int R) const { return R; }
    __device__ __forceinline__ const bf16_t* b_ptr(const U& u) const { return W + (size_t)u.pn * 256 * D; }
    static __device__ __forceinline__ int b_row(int bj, int S) { return brow_std(bj, S); }
    __device__ __forceinline__ void epi(Acc& acc, const U& u, int wr, int wc, int fr, int fq) const {
        const bool isv = u.pn >= 8; const int pn8 = u.pn & 7; bf16_t* dst = isv ? V3 : Ub;
#pragma unroll
        for (int ai = 0; ai < 2; ++ai)
#pragma unroll
            for (int m = 0; m < 4; ++m) {
                const int row = u.pm * 256 + 128 * ai + 64 * wr + 16 * m + fr; float ss = 0.f;
                const float s = rsqrtf(sum16(xstat + (size_t)row * 16) * (1.f / D) + EPS);
#pragma unroll
                for (int bj = 0; bj < 2; ++bj) {
                    const int lc = 64 * wc + 32 * bj + 8 * fq;
                    const f32x4 b0 = *(const f32x4*)(bias + 256 * u.pn + lc), b1 = *(const f32x4*)(bias + 256 * u.pn + lc + 4);
                    float v[8];
#pragma unroll
                    for (int e = 0; e < 4; ++e) { v[e] = gelu_tanh(acc[ai][bj][m][0][e] * s + b0[e]); v[4 + e] = gelu_tanh(acc[ai][bj][m][1][e] * s + b1[e]); }
                    u32x4 w; w.x = pk2(v[0], v[1]); w.y = pk2(v[2], v[3]); w.z = pk2(v[4], v[5]); w.w = pk2(v[6], v[7]);
                    *(u32x4*)(dst + (size_t)row * CW + 256 * pn8 + lc) = w;
                    const float r[8] = {bf_lo(w.x), bf_hi(w.x), bf_lo(w.y), bf_hi(w.y), bf_lo(w.z), bf_hi(w.z), bf_lo(w.w), bf_hi(w.w)};
#pragma unroll
                    for (int j = 0; j < 8; ++j) ss += r[j] * r[j];
                }
                if (isv) { ss += __shfl_xor(ss, 16); ss += __shfl_xor(ss, 32); if (fq == 0) vstat[(size_t)row * 32 + 4 * pn8 + wc] = ss; }
            }
    }
};

__device__ __forceinline__ int lds_byte(int r, int c) { const int st = (r >> 4) * 2 + (c >> 5), rr = r & 15, cc = c & 31, ob = rr * 64 + cc * 2; return st * 1024 + (ob ^ (((ob >> 9) & 1) << 5)); }
__device__ __forceinline__ void stage_rc(int b, int& R, int& C) { const int st = b / 1024, sb = b % 1024, swz = sb ^ (((sb >> 9) & 1) << 5); R = (st >> 1) * 16 + swz / 64; C = (st & 1) * 32 + (swz % 64) / 2; }

template <class P> __device__ __forceinline__ void gemm_fast(LAS unsigned char* lds, const P& p) {
    constexpr int HTB = 16384;
    const int tid = threadIdx.x, wid = __builtin_amdgcn_readfirstlane(tid >> 6), lane = tid & 63, wr = wid >> 2, wc = wid & 3, fr = lane & 15, fq = lane >> 4;
    const int K = p.K, nt = K / 64, lda = p.lda, ldb = p.ldb;
    const int G = (int)gridDim.x, cu = (int)blockIdx.x;
    int Rs[2], Cs[2];
#pragma unroll
    for (int i = 0; i < 2; ++i) stage_rc(tid * 16 + i * 8192, Rs[i], Cs[i]);
    unsigned boffs[4];
#pragma unroll
    for (int bj = 0; bj < 2; ++bj)
#pragma unroll
        for (int i = 0; i < 2; ++i) boffs[bj * 2 + i] = (unsigned)(P::b_row(bj, Rs[i]) * ldb + Cs[i]) * 2u;
    const unsigned ldsw = (unsigned)wid * 1024u;
    const int aoff_l = lds_byte(wr * 64 + fr, fq * 8), boff_l = lds_byte(wc * 32 + fr, fq * 8);
#define GF_SA(b, h) (((b) * 2 + (h)) * HTB)
#define GF_SB(b, h) ((4 + (b) * 2 + (h)) * HTB)
#define GF_STAGE(bufoff, gbase, o0, o1) do { \
        __builtin_amdgcn_global_load_lds((const unsigned*)((const char*)(gbase) + (o0)), (LAS unsigned*)(lds + (bufoff) + ldsw), 16, 0, 0); \
        __builtin_amdgcn_global_load_lds((const unsigned*)((const char*)(gbase) + (o1)), (LAS unsigned*)(lds + (bufoff) + ldsw + 8192), 16, 0, 0); } while (0)
#define GF_LDA(dst, b, h) do { _Pragma("unroll") for (int m = 0; m < 4; ++m) _Pragma("unroll") for (int k = 0; k < 2; ++k) dst[m][k] = *(const LAS bf16x8*)(lds + GF_SA(b, h) + aoff_l + m * 2048 + k * 1024); } while (0)
#define GF_LDB(dst, b, h) do { _Pragma("unroll") for (int n = 0; n < 2; ++n) _Pragma("unroll") for (int k = 0; k < 2; ++k) dst[n][k] = *(const LAS bf16x8*)(lds + GF_SB(b, h) + boff_l + n * 2048 + k * 1024); } while (0)
#define GF_MMA(ai, bj, At, Bt) do { __builtin_amdgcn_s_setprio(1); _Pragma("unroll") for (int m = 0; m < 4; ++m) _Pragma("unroll") for (int n = 0; n < 2; ++n) _Pragma("unroll") for (int k = 0; k < 2; ++k) \
        acc[ai][bj][m][n] = __builtin_amdgcn_mfma_f32_16x16x32_bf16(Bt[n][k], At[m][k], acc[ai][bj][m][n], 0, 0, 0); __builtin_amdgcn_s_setprio(0); } while (0)
#define GF_WAIT_V(n) asm volatile("s_waitcnt vmcnt(" #n ")" ::: "memory")
#define GF_WAIT_L(n) asm volatile("s_waitcnt lgkmcnt(" #n ")" ::: "memory")
#define GF_BAR __builtin_amdgcn_s_barrier()
#define GF_SCHED __builtin_amdgcn_sched_barrier(0)
#define GF_AOFFS(dst, u) do { _Pragma("unroll") for (int h = 0; h < 2; ++h) _Pragma("unroll") for (int i = 0; i < 2; ++i) dst[h * 2 + i] = (unsigned)(p.a_row(u, 128 * h + Rs[i]) * lda + Cs[i]) * 2u; } while (0)
    U cur, nxt; int ui = 0;
    if (!p.unit(cu, cur)) return;
    Acc acc;
#pragma unroll
    for (int a = 0; a < 2; ++a)
#pragma unroll
        for (int b = 0; b < 2; ++b)
#pragma unroll
            for (int m = 0; m < 4; ++m)
#pragma unroll
                for (int n = 0; n < 2; ++n) acc[a][b][m][n] = (f32x4){0.f, 0.f, 0.f, 0.f};
    bf16x8 At[4][2], B0[2][2], B1[2][2];
    unsigned aoffs[4], naoffs[4];
    GF_AOFFS(aoffs, cur);
    const char* cA = (const char*)p.a_ptr(cur); const char* cB = (const char*)p.b_ptr(cur);
    GF_STAGE(GF_SB(0, 0), cB, boffs[0], boffs[1]); GF_STAGE(GF_SB(0, 1), cB, boffs[2], boffs[3]); GF_STAGE(GF_SA(0, 0), cA, aoffs[0], aoffs[1]); GF_STAGE(GF_SA(0, 1), cA, aoffs[2], aoffs[3]);
    if (wr == 1) GF_BAR;
    GF_WAIT_V(2); GF_BAR;
    GF_STAGE(GF_SB(1, 0), cB + 128, boffs[0], boffs[1]); GF_STAGE(GF_SA(1, 0), cA + 128, aoffs[0], aoffs[1]); GF_STAGE(GF_SB(1, 1), cB + 128, boffs[2], boffs[3]);
    GF_WAIT_V(6); GF_BAR;
    for (;;) {
        const bool has_next = p.unit((ui + 1) * G + cu, nxt);
        const char* nA = cA; const char* nB = cB;
#pragma unroll
        for (int j = 0; j < 4; ++j) naoffs[j] = aoffs[j];
        if (has_next) { nA = (const char*)p.a_ptr(nxt); nB = (const char*)p.b_ptr(nxt); if (P::GATHER) GF_AOFFS(naoffs, nxt); }
        for (int t = 0; t < nt; t += 2) {
            const bool last = (t == nt - 2);
            const char* a1 = cA + (size_t)(t + 1) * 128;
            const char* a2 = last ? nA : cA + (size_t)(t + 2) * 128; const char* b2 = last ? nB : cB + (size_t)(t + 2) * 128;
            const char* a3 = a2 + 128; const char* b3 = b2 + 128;
            unsigned o[4];
#pragma unroll
            for (int j = 0; j < 4; ++j) o[j] = (P::GATHER && last) ? naoffs[j] : aoffs[j];
            GF_LDB(B0, 0, 0); GF_LDB(B1, 0, 1); GF_SCHED; GF_LDA(At, 0, 0); GF_STAGE(GF_SA(1, 1), a1, aoffs[2], aoffs[3]);
            GF_WAIT_V(8); GF_WAIT_L(0); GF_BAR; GF_MMA(0, 0, At, B0); GF_MMA(0, 1, At, B1); GF_BAR; GF_SCHED;
            GF_LDA(At, 0, 1); GF_STAGE(GF_SB(0, 0), b2, boffs[0], boffs[1]); GF_STAGE(GF_SB(0, 1), b2, boffs[2], boffs[3]); GF_STAGE(GF_SA(0, 0), a2, o[0], o[1]);
            GF_WAIT_V(8); GF_WAIT_L(0); GF_BAR; GF_MMA(1, 0, At, B0); GF_MMA(1, 1, At, B1); GF_BAR; GF_SCHED;
            GF_LDB(B0, 1, 0); GF_LDB(B1, 1, 1); GF_SCHED; GF_LDA(At, 1, 0); GF_STAGE(GF_SA(0, 1), a2, o[2], o[3]);
            GF_WAIT_V(8); GF_WAIT_L(0); GF_BAR; GF_MMA(0, 0, At, B0); GF_MMA(0, 1, At, B1); GF_BAR; GF_SCHED;
            GF_LDA(At, 1, 1); GF_STAGE(GF_SB(1, 0), b3, boffs[0], boffs[1]); GF_STAGE(GF_SB(1, 1), b3, boffs[2], boffs[3]); GF_STAGE(GF_SA(1, 0), a3, o[0], o[1]);
            GF_WAIT_V(8); GF_WAIT_L(0); GF_BAR; GF_MMA(1, 0, At, B0); GF_MMA(1, 1, At, B1); GF_BAR; GF_SCHED;
        }
        if (wr == 0) GF_BAR;
        p.epi(acc, cur, wr, wc, fr, fq);
        if (!has_next) break;
#pragma unroll
        for (int a = 0; a < 2; ++a)
#pragma unroll
            for (int b = 0; b < 2; ++b)
#pragma unroll
                for (int m = 0; m < 4; ++m)
#pragma unroll
                    for (int n = 0; n < 2; ++n) acc[a][b][m][n] = (f32x4){0.f, 0.f, 0.f, 0.f};
        cur = nxt; cA = nA; cB = nB; ++ui;
#pragma unroll
        for (int j = 0; j < 4; ++j) aoffs[j] = naoffs[j];
        if (wr == 1) GF_BAR;
    }
    GF_WAIT_V(0);
    GF_BAR;
#undef GF_SA
#undef GF_SB
#undef GF_STAGE
#undef GF_LDA
#undef GF_LDB
#undef GF_MMA
#undef GF_WAIT_V
#undef GF_WAIT_L
#undef GF_BAR
#undef GF_SCHED
#undef GF_AOFFS
}

#ifndef FAST_MASK
#define FAST_MASK 0xffffffffu
#endif
template <class P> __device__ __forceinline__ void run_gemm(LAS unsigned char* lds, const P& p) {
#if FAST_CORE
    if constexpr (((FAST_MASK >> P::ID) & 1u) != 0u) { gemm_fast<P>(lds, p); __syncthreads(); }
    else gemm_naive<P>(p);
#else
    (void)lds;
    gemm_naive<P>(p);
#endif
}

__device__ __forceinline__ void tconv_item(const float* W, int ldw, int n0, bf16_t* dst, int ldd, int drow0, const float* ksc, LAS float* scr, int kb, int nb, int lane) {
    const int k0 = 64 * kb, c0 = n0 + 32 * nb;
#pragma unroll 8
    for (int i = 0; i < 32; ++i) { const int kk = 2 * i + (lane >> 5); scr[kk * 33 + (lane & 31)] = W[(size_t)(k0 + kk) * ldw + c0 + (lane & 31)]; }
    asm volatile("s_waitcnt lgkmcnt(0)" ::: "memory");
    const int c = lane & 7;
    float sc[8];
#pragma unroll
    for (int j = 0; j < 8; ++j) sc[j] = ksc ? ksc[k0 + 8 * c + j] : 1.f;
#pragma unroll
    for (int j = 0; j < 4; ++j) { const int n = (lane >> 3) + 8 * j; const LAS float* s = scr + (8 * c) * 33 + n;
        u32x4 o; o.x = pk2(s[0 * 33] * sc[0], s[1 * 33] * sc[1]); o.y = pk2(s[2 * 33] * sc[2], s[3 * 33] * sc[3]); o.z = pk2(s[4 * 33] * sc[4], s[5 * 33] * sc[5]); o.w = pk2(s[6 * 33] * sc[6], s[7 * 33] * sc[7]);
        *(u32x4*)(dst + (size_t)(drow0 + 32 * nb + n) * ldd + k0 + 8 * c) = o; }
    asm volatile("s_waitcnt lgkmcnt(0)" ::: "memory");
}
__device__ __forceinline__ bool tconv_job(int& r, const float* W, int ldw, int n0, int Kd, int Nc, bf16_t* dst, int drow0, const float* ksc, LAS float* scr, int lane) {
    const int nkb = Kd / 64, nnb = Nc / 32, items = nkb * nnb;
    if (r >= items) { r -= items; return false; }
    const int kb = r / nnb, nb = r - kb * nnb;
    tconv_item(W, ldw, n0, dst, Kd, drow0, ksc, scr, kb, nb, lane);
    return true;
}
__device__ __forceinline__ void conv_moe_layer(const Args& a, int l, LAS unsigned char* lds) {
    const int lane = threadIdx.x & 63, wave = threadIdx.x >> 6;
    LAS float* scr = (LAS float*)(lds + wave * 8448);
    const int gw = blockIdx.x * NWAVES + wave, NGW = gridDim.x * NWAVES;
    bf16_t* WGU = (bf16_t*)(a.ws + WS_W_GU); bf16_t* WDN = (bf16_t*)(a.ws + WS_W_DN);
    const float* g = a.in[I_NFFN] + l * D;
    for (int it = gw; it < 3 * 32 * 256; it += NGW) {
        const int kind = it / 8192, r = it - kind * 8192, e = r >> 8, q = r & 255;
        if (kind == 0) { const float* W = a.in[I_MGATE] + ((size_t)l * 32 + e) * (D * DEXP); tconv_item(W, DEXP, 0, WGU + (size_t)e * 1024 * 1024, D, 0, g, scr, q >> 4, q & 15, lane); }
        else if (kind == 1) { const float* W = a.in[I_MUP] + ((size_t)l * 32 + e) * (D * DEXP); tconv_item(W, DEXP, 0, WGU + (size_t)e * 1024 * 1024, D, 512, g, scr, q >> 4, q & 15, lane); }
        else { const float* W = a.in[I_MDOWN] + ((size_t)l * 32 + e) * (DEXP * D); tconv_item(W, D, 0, WDN + (size_t)e * 1024 * 512, DEXP, 0, nullptr, scr, q >> 5, q & 31, lane); }
    }
}
__device__ __forceinline__ void phase_prologue(const Args& a, LAS unsigned char* lds) {
    const int tid = threadIdx.x, lane = tid & 63, wave = tid >> 6;
    LAS float* scr = (LAS float*)(lds + wave * 8448);
    const int gw = blockIdx.x * NWAVES + wave, NGW = gridDim.x * NWAVES;
    unsigned char* ws = a.ws;
    constexpr int NITEMS = 768 + 512 + 512 + 2048 + 1024 + 2 * 512 + 2 * 1024 + 2 * 512;
    for (int it = gw; it < NITEMS; it += NGW) {
        int r = it;
        if (tconv_job(r, a.in[I_ABWIN], INAB, 0, D, 1536, (bf16_t*)(ws + WS_W_IN0), 0, a.in[I_NMIX], scr, lane)) continue;
        if (tconv_job(r, a.in[I_ABWIN], INAB, 1544, D, 1024, (bf16_t*)(ws + WS_W_IN0), 1536, a.in[I_NMIX], scr, lane)) continue;
        if (tconv_job(r, a.in[I_ABWOUT], D, 0, D, D, (bf16_t*)(ws + WS_W_OUT0), 0, nullptr, scr, lane)) continue;
        if (tconv_job(r, a.in[I_CWIN], 2 * CW, 0, D, 2 * CW, (bf16_t*)(ws + WS_W_IN1), 0, a.in[I_NMIX] + D, scr, lane)) continue;
        if (tconv_job(r, a.in[I_CWOUT], D, 0, CW, D, (bf16_t*)(ws + WS_W_OUT1), 0, nullptr, scr, lane)) continue;
        if (tconv_job(r, a.in[I_XWQ], D, 0, D, D, (bf16_t*)(ws + WS_W_Q), 0, a.in[I_NCROSS], scr, lane)) continue;
        if (tconv_job(r, a.in[I_XWQ] + (size_t)D * D, D, 0, D, D, (bf16_t*)(ws + WS_W_Q) + (size_t)D * D, 0, a.in[I_NCROSS] + D, scr, lane)) continue;
        if (tconv_job(r, a.in[I_XWKV], 2 * D, 0, D, 2 * D, (bf16_t*)(ws + WS_W_KV), 0, a.in[I_NMEM], scr, lane)) continue;
        if (tconv_job(r, a.in[I_XWKV] + (size_t)D * 2 * D, 2 * D, 0, D, 2 * D, (bf16_t*)(ws + WS_W_KV) + (size_t)2 * D * D, 0, a.in[I_NMEM] + D, scr, lane)) continue;
        if (tconv_job(r, a.in[I_XWO], D, 0, D, D, (bf16_t*)(ws + WS_W_O), 0, nullptr, scr, lane)) continue;
        tconv_job(r, a.in[I_XWO] + (size_t)D * D, D, 0, D, D, (bf16_t*)(ws + WS_W_O) + (size_t)D * D, 0, nullptr, scr, lane);
    }
    conv_moe_layer(a, 0, lds);
    const int gt = blockIdx.x * NTHREADS + tid, NGT = gridDim.x * NTHREADS;
    for (int i = gt; i < 2 * 256 * D; i += NGT) {
        const int l = i / (256 * D), n = (i / D) & 255, k = i & (D - 1);
        float v = 0.f;
        if (n < 4) v = a.in[I_MWG][((size_t)l * D + k) * 4 + n] * a.in[I_NFFN][l * D + k];
        else if (n < 36) v = a.in[I_MWE][((size_t)l * D + k) * 32 + (n - 4)] * a.in[I_NFFN][l * D + k];
        ((bf16_t*)(ws + WS_W_R))[i] = f2bf(v);
    }
    for (int i = gt; i < CG * CCH * CCH; i += NGT) { const int t = (i >> 7) & 127, s = i & 127; ((bf16_t*)(ws + WS_TRIL))[i] = f2bf(s <= t ? a.in[I_CWS][i] : 0.f); }
    __syncthreads();
    LAS float* wf = (LAS float*)(lds + 73728);
    for (int i = tid; i < D * 8; i += NTHREADS) { const int k = i >> 3, h = i & 7; wf[i] = a.in[I_ABWIN][(size_t)k * INAB + 1536 + h] * a.in[I_NMIX][k]; }
    __syncthreads();
    bf16_t* X = (bf16_t*)(ws + WS_X); float* xstat = (float*)(ws + WS_XSTAT); float* flog = (float*)(ws + WS_FLOG);
    for (int row = gw; row < T; row += NGW) {
        const f32x4* xr = (const f32x4*)(a.in[I_X] + (size_t)row * D) + lane;
        f32x4 v[4]; float ss = 0.f; float fl[8];
#pragma unroll
        for (int h = 0; h < 8; ++h) fl[h] = 0.f;
#pragma unroll
        for (int j = 0; j < 4; ++j) { v[j] = xr[64 * j]; ss += (v[j].x * v[j].x + v[j].y * v[j].y) + (v[j].z * v[j].z + v[j].w * v[j].w); }
#pragma unroll
        for (int j = 0; j < 4; ++j)
#pragma unroll
            for (int e = 0; e < 4; ++e) { const int k = 4 * lane + 256 * j + e; const f32x4 w0 = *(const LAS f32x4*)(wf + k * 8), w1 = *(const LAS f32x4*)(wf + k * 8 + 4);
#pragma unroll
                for (int h = 0; h < 4; ++h) { fl[h] += v[j][e] * w0[h]; fl[4 + h] += v[j][e] * w1[h]; } }
        ss = wave_sum(ss);
#pragma unroll
        for (int h = 0; h < 8; ++h) fl[h] = wave_sum(fl[h]);
        u32x2* o8 = (u32x2*)(X + (size_t)row * D) + lane;
#pragma unroll
        for (int j = 0; j < 4; ++j) { u32x2 o; o.x = pk2(v[j].x, v[j].y); o.y = pk2(v[j].z, v[j].w); o8[64 * j] = o; }
        if (lane < 16) xstat[(size_t)row * 16 + lane] = lane == 0 ? ss : 0.f;
        const float s = rsqrtf(ss * (1.f / D) + EPS);
        if (lane < 8) { float f = fl[0];
#pragma unroll
            for (int h = 1; h < 8; ++h) f = lane == h ? fl[h] : f;
            flog[(size_t)row * 8 + lane] = f * s; }
    }
    bf16_t* MB = (bf16_t*)(ws + WS_MEMB); float* memstat = (float*)(ws + WS_MISC + MISC_MEMSTAT);
    for (int row = gw; row < NB * MEML; row += NGW) {
        const f32x4* xr = (const f32x4*)(a.in[I_MEM] + (size_t)row * D) + lane; float ss = 0.f;
        u32x2* o8 = (u32x2*)(MB + (size_t)row * D) + lane;
#pragma unroll
        for (int j = 0; j < 4; ++j) { const f32x4 v = xr[64 * j]; ss += (v.x * v.x + v.y * v.y) + (v.z * v.z + v.w * v.w); u32x2 o; o.x = pk2(v.x, v.y); o.y = pk2(v.z, v.w); o8[64 * j] = o; }
        ss = wave_sum(ss);
        if (lane == 0) memstat[row] = ss;
    }
}

__device__ __forceinline__ void phase_cumsum(const Args& a, LAS unsigned char* lds) {
    const int tid = threadIdx.x, lane = tid & 63, wave = tid >> 6;
    const float* flog = (const float*)(a.ws + WS_FLOG); float* csum = (float*)(a.ws + WS_CSUM);
    LAS float* wsum = (LAS float*)lds;
    for (int u = blockIdx.x; u < NB * AH; u += gridDim.x) {
        const int b = u >> 3, h = u & 7; const float fb = a.in[I_FBIAS][h];
        float v[8]; float run = 0.f;
#pragma unroll
        for (int j = 0; j < 8; ++j) { const float x = flog[((size_t)b * SEQ + 8 * tid + j) * 8 + h] + fb; const float lf = fminf(x, 0.f) - log1pf(__expf(-fabsf(x))); run += lf; v[j] = run; }
        float inc = run;
#pragma unroll
        for (int o = 1; o < 64; o <<= 1) { const float t = __shfl_up(inc, o); if (lane >= o) inc += t; }
        __syncthreads();
        if (lane == 63) wsum[wave] = inc;
        __syncthreads();
        float base = inc - run;
        for (int w = 0; w < wave; ++w) base += wsum[w];
#pragma unroll
        for (int j = 0; j < 8; ++j) csum[(size_t)u * SEQ + 8 * tid + j] = base + v[j];
    }
}

__device__ __forceinline__ void phase_k2fin(const Args& a) {
    const int lane = threadIdx.x & 63, wave = threadIdx.x >> 6;
    const int gw = blockIdx.x * NWAVES + wave, NGW = gridDim.x * NWAVES;
    bf16_t* K2 = (bf16_t*)(a.ws + WS_K2); const float* k2stat = (const float*)(a.ws + WS_MISC + MISC_K2STAT);
    for (int it = gw; it < 2 * NB * XH * MEML; it += NGW) {
        const int key = it & 255, h = (it >> 8) & 3, b = (it >> 10) & 7, l = it >> 13;
        const f32x4 st = *(const f32x4*)(k2stat + ((size_t)l * 2048 + b * 256 + key) * 16 + 4 * h);
        const float rn = rsqrtf(((st.x + st.y) + (st.z + st.w)) * (1.f / XHD) + EPS);
        u32x2* p = (u32x2*)(K2 + (size_t)it * 256) + lane; const u32x2 v = *p;
        const float* qg = a.in[I_XQG] + l * XHD + 4 * lane; const float* kg = a.in[I_XKG] + l * XHD + 4 * lane;
        u32x2 o; o.x = pk2(bf_lo(v.x) * rn * qg[0] * kg[0], bf_hi(v.x) * rn * qg[1] * kg[1]); o.y = pk2(bf_lo(v.y) * rn * qg[2] * kg[2], bf_hi(v.y) * rn * qg[3] * kg[3]);
        *p = o;
    }
    const bf16_t* V2 = (const bf16_t*)(a.ws + WS_ARENA + AR_V2TMP); bf16_t* V2T = (bf16_t*)(a.ws + WS_V2T);
    const int gt = blockIdx.x * NTHREADS + threadIdx.x, NGT = gridDim.x * NTHREADS;
    for (int it = gt; it < 64 * 256 * 32; it += NGT) {
        const int d = it & 255, k8 = (it >> 8) & 31, tile = it >> 13;
        const bf16_t* src = V2 + (size_t)tile * 65536 + (size_t)(8 * k8) * 256 + d;
        u32x4 w; w.x = (unsigned)src[0] | ((unsigned)src[256] << 16); w.y = (unsigned)src[512] | ((unsigned)src[768] << 16); w.z = (unsigned)src[1024] | ((unsigned)src[1280] << 16); w.w = (unsigned)src[1536] | ((unsigned)src[1792] << 16);
        *(u32x4*)(V2T + (size_t)tile * 65536 + (size_t)d * 256 + 8 * k8) = w;
    }
}

__device__ __forceinline__ void lru_unit(const Args& a, LAS unsigned char* lds, int b, int g, int ch, int pass) {
    const int tid = threadIdx.x, c = tid & 63, tq = tid >> 6;
    LAS float* xc = (LAS float*)lds;
    LAS float* wA = (LAS float*)(lds + 33792);
    LAS float* wX = (LAS float*)(lds + 33792 + 16384);
    LAS float* seg = (LAS float*)(lds + 33792 + 32768);
    const bf16_t* XB = (const bf16_t*)(a.ws + WS_ARENA + AR_XB); const bf16_t* GATE = (const bf16_t*)(a.ws + WS_ARENA + AR_GATE);
    bf16_t* AR = (bf16_t*)(a.ws + WS_ARENA + AR_AR); float* lsum = (float*)(a.ws + WS_LSUM);
    const int ch0 = 64 * g + c; const size_t row0 = (size_t)b * SEQ + 128 * ch;
    __syncthreads();
    for (int i = tid; i < 4096; i += NTHREADS) { wA[i] = a.in[I_WA][g * 4096 + i]; wX[i] = a.in[I_WX][g * 4096 + i]; }
    {
        const float w0 = a.in[I_CONVW][0 * BW + ch0], w1 = a.in[I_CONVW][1 * BW + ch0], w2 = a.in[I_CONVW][2 * BW + ch0], w3 = a.in[I_CONVW][3 * BW + ch0], cb = a.in[I_CONVB][ch0];
        float xm3, xm2, xm1; const int tl0 = 16 * tq, s0 = 128 * ch + tl0;
        xm3 = s0 >= 3 ? bf2f(XB[(row0 + tl0 - 3) * BW + ch0]) : 0.f; xm2 = s0 >= 2 ? bf2f(XB[(row0 + tl0 - 2) * BW + ch0]) : 0.f; xm1 = s0 >= 1 ? bf2f(XB[(row0 + tl0 - 1) * BW + ch0]) : 0.f;
#pragma unroll 4
        for (int j = 0; j < 16; ++j) { const float x0 = bf2f(XB[(row0 + tl0 + j) * BW + ch0]); xc[(tl0 + j) * 65 + c] = w0 * xm3 + w1 * xm2 + w2 * xm1 + w3 * x0 + cb; xm3 = xm2; xm2 = xm1; xm1 = x0; }
    }
    __syncthreads();
    float ra[16], rx[16];
#pragma unroll
    for (int j = 0; j < 16; ++j) { ra[j] = 0.f; rx[j] = 0.f; }
    for (int k = 0; k < 64; ++k) { const float wa = wA[k * 64 + c], wx = wX[k * 64 + c];
#pragma unroll
        for (int j = 0; j < 16; ++j) { const float x = xc[(16 * tq + j) * 65 + k]; ra[j] += x * wa; rx[j] += x * wx; } }
    const float ba = a.in[I_BA][ch0], bx = a.in[I_BX][ch0], lam = a.in[I_LAM][ch0];
    const float sp = (lam > 0.f ? 0.f : -lam) + log1pf(__expf(-fabsf(lam)));
    float av[16], bv[16]; float Pp = 1.f, hh = 0.f;
#pragma unroll
    for (int j = 0; j < 16; ++j) { const float r = sigmoidf(ra[j] + ba), ig = sigmoidf(rx[j] + bx); const float la = -8.f * r * sp; const float aa = __expf(la);
        const float beta = sqrtf(fmaxf(-expm1f(2.f * la), 0.f)); av[j] = aa; bv[j] = beta * (ig * xc[(16 * tq + j) * 65 + c]); Pp *= aa; hh = aa * hh + bv[j]; }
    seg[(tq * 64 + c) * 2] = Pp; seg[(tq * 64 + c) * 2 + 1] = hh;
    __syncthreads();
    if (pass == 0) {
        if (tq == 0) { float PA = 1.f, H = 0.f;
            for (int q = 0; q < 8; ++q) { const float pq = seg[(q * 64 + c) * 2], hq = seg[(q * 64 + c) * 2 + 1]; H = pq * H + hq; PA *= pq; }
            float* o = lsum + (((size_t)b * 32 + ch) * BW + ch0) * 2; o[0] = PA; o[1] = H; }
    } else {
        float H = 0.f;
        for (int q = 0; q < ch; ++q) { const float* o = lsum + (((size_t)b * 32 + q) * BW + ch0) * 2; H = o[0] * H + o[1]; }
        for (int q = 0; q < tq; ++q) H = seg[(q * 64 + c) * 2] * H + seg[(q * 64 + c) * 2 + 1];
#pragma unroll
        for (int j = 0; j < 16; ++j) { H = av[j] * H + bv[j]; const size_t row = row0 + 16 * tq + j; AR[row * D + 512 + ch0] = f2bf(bf2f(GATE[row * BW + ch0]) * H); }
    }
}
__device__ __forceinline__ void phase_lru(const Args& a, LAS unsigned char* lds, int pass) {
    for (int u = blockIdx.x; u < NB * 8 * 32; u += gridDim.x) { const int ch = u & 31, g = (u >> 5) & 7, b = u >> 8; lru_unit(a, lds, b, g, ch, pass); }
    __syncthreads();
}

__device__ __forceinline__ void phase_attn_naive(const Args& a) {
    const int tid = threadIdx.x;
    const bf16_t* Q = (const bf16_t*)(a.ws + WS_ARENA + AR_Q); const bf16_t* Kb = (const bf16_t*)(a.ws + WS_ARENA + AR_K); const bf16_t* Vb = (const bf16_t*)(a.ws + WS_ARENA + AR_V);
    bf16_t* AR = (bf16_t*)(a.ws + WS_ARENA + AR_AR); const float* csum = (const float*)(a.ws + WS_CSUM);
    const int NU = NB * AH * (SEQ / NTHREADS);
    for (int i = blockIdx.x; i < NU; i += gridDim.x) {
        const int uu = NU - 1 - i;
        const int qb = uu / (NB * AH), bh = uu % (NB * AH), b = bh >> 3, h = bh & 7;
        const int t = qb * NTHREADS + tid; const size_t row = (size_t)b * SEQ + t;
        u32x4 qp[8]; float o[64];
#pragma unroll
        for (int d8 = 0; d8 < 8; ++d8) qp[d8] = *(const u32x4*)(Q + row * AW + h * HD + 8 * d8);
#pragma unroll
        for (int d = 0; d < 64; ++d) o[d] = 0.f;
        const float* cs = csum + (size_t)bh * SEQ; const float ci = cs[t] * LOG2E;
        float mx = -INFINITY, l = 0.f;
        const int jmax = qb * NTHREADS + (tid | 63);
        for (int j = 0; j <= jmax; ++j) {
            const size_t kr = ((size_t)b * SEQ + j) * AW + h * HD;
            float s = 0.f;
#pragma unroll
            for (int d8 = 0; d8 < 8; ++d8) { const u32x4 v = *(const u32x4*)(Kb + kr + 8 * d8); const u32x4 q = qp[d8];
                s += bf_lo(q.x) * bf_lo(v.x) + bf_hi(q.x) * bf_hi(v.x) + bf_lo(q.y) * bf_lo(v.y) + bf_hi(q.y) * bf_hi(v.y) + bf_lo(q.z) * bf_lo(v.z) + bf_hi(q.z) * bf_hi(v.z) + bf_lo(q.w) * bf_lo(v.w) + bf_hi(q.w) * bf_hi(v.w); }
            s += ci - cs[j] * LOG2E;
            if (j > t) s = -INFINITY;
            const float mn = fmaxf(mx, s); const float sc = exp2f(mx - mn), p = exp2f(s - mn);
            l = l * sc + p; mx = mn;
#pragma unroll
            for (int d8 = 0; d8 < 8; ++d8) { const u32x4 v = *(const u32x4*)(Vb + kr + 8 * d8);
                o[8 * d8] = o[8 * d8] * sc + p * bf_lo(v.x); o[8 * d8 + 1] = o[8 * d8 + 1] * sc + p * bf_hi(v.x); o[8 * d8 + 2] = o[8 * d8 + 2] * sc + p * bf_lo(v.y); o[8 * d8 + 3] = o[8 * d8 + 3] * sc + p * bf_hi(v.y);
                o[8 * d8 + 4] = o[8 * d8 + 4] * sc + p * bf_lo(v.z); o[8 * d8 + 5] = o[8 * d8 + 5] * sc + p * bf_hi(v.z); o[8 * d8 + 6] = o[8 * d8 + 6] * sc + p * bf_lo(v.w); o[8 * d8 + 7] = o[8 * d8 + 7] * sc + p * bf_hi(v.w); }
        }
        const float inv = 1.f / l;
#pragma unroll
        for (int d8 = 0; d8 < 8; ++d8) { u32x4 w; w.x = pk2(o[8 * d8] * inv, o[8 * d8 + 1] * inv); w.y = pk2(o[8 * d8 + 2] * inv, o[8 * d8 + 3] * inv); w.z = pk2(o[8 * d8 + 4] * inv, o[8 * d8 + 5] * inv); w.w = pk2(o[8 * d8 + 6] * inv, o[8 * d8 + 7] * inv);
            *(u32x4*)(AR + row * D + h * HD + 8 * d8) = w; }
    }
}

#include <hip/hip_bf16.h>
#include <cmath>
namespace attn_body {
using bf16=__hip_bfloat16;
using bf16x8=__attribute__((ext_vector_type(8)))short;
using s16x4=__attribute__((ext_vector_type(4)))short;
using f32x16=__attribute__((ext_vector_type(16)))float;
using u32x4=__attribute__((ext_vector_type(4)))unsigned;
using f32x4_t=__attribute__((ext_vector_type(4)))float;
constexpr int BATCH=8,NHEAD=8,SEQ=4096,D=64,DM=NHEAD*D,DMO=1024;
constexpr int NW=8,QBLK=32,QB=QBLK*NW,KVBLK=64,NQB=SEQ/QB;
constexpr int ATTN_PITCH=DM, ATTN_UNIT_ROWS=QB;
__device__ __forceinline__ int crow(int r,int hi){return (r&3)+8*(r>>2)+4*hi;}
#define SBAR() __builtin_amdgcn_sched_barrier(0)
__device__ __forceinline__ void cmask(f32x16&p0,f32x16&p1,int jb,int qrel,int hi){
  const float NEG=-INFINITY; int kb=64*jb+4*hi;
  #pragma unroll
  for(int r=0;r<16;++r){int kv=kb+(r&3)+8*(r>>2); if(kv>qrel)p0[r]=NEG; if(kv+32>qrel)p1[r]=NEG;}
}

constexpr int NSLOT=3, SLOTB=8192;
constexpr int LDS_K=0, LDS_V=NSLOT*SLOTB, LDS_WS=2*NSLOT*SLOTB, LDS_OST=LDS_WS+NW*64*4, LDS_CB=LDS_OST+NW*4096, LDS_BYTES=LDS_CB+SEQ*4;
constexpr float C2=0.125f*1.4426950408889634f;
__device__ __forceinline__ void glds16(const void*gsrc,unsigned lds_dst){unsigned keep;
  asm volatile("s_mov_b32 %0, m0\n\ts_mov_b32 m0, %2\n\ts_nop 0\n\tglobal_load_lds_dwordx4 %1, off\n\ts_mov_b32 m0, %0":"=&s"(keep):"v"(gsrc),"s"(lds_dst):"memory");}
__device__ __forceinline__ float max3f(float a,float b,float c){float r;asm("v_max3_f32 %0, %1, %2, %3":"=v"(r):"v"(a),"v"(b),"v"(c));return r;}
__device__ __forceinline__ float max2f(float a,float b){float r;asm("v_max_f32_e32 %0, %1, %2":"=v"(r):"v"(a),"v"(b));return r;}
__device__ __forceinline__ float fadd_s(float a,float b){float r;asm("v_add_f32_e32 %0, %1, %2":"=v"(r):"v"(a),"v"(b));return r;}
__device__ __forceinline__ float fsub_s(float a,float b){float r;asm("v_sub_f32_e32 %0, %1, %2":"=v"(r):"v"(a),"v"(b));return r;}
typedef float f32x2_t __attribute__((ext_vector_type(2))); typedef __bf16 bf16x2_t __attribute__((ext_vector_type(2)));
__device__ __forceinline__ unsigned cvtpk_s(float lo,float hi){f32x2_t v={lo,hi};bf16x2_t b=__builtin_convertvector(v,bf16x2_t);return __builtin_bit_cast(unsigned,b);}
#define WAIT_BAR(N) asm volatile("s_waitcnt vmcnt(" #N ") lgkmcnt(0)\n\ts_barrier":::"memory")

__device__ __forceinline__ void qkt(f32x16&p0,f32x16&p1,const char*Kslot,const bf16x8*qr,int r32,int hi){
  const char*kb=Kslot+hi*1024+r32*16;
  #pragma unroll
  for(int d0=0;d0<4;++d0){
    const bf16x8 b0=*reinterpret_cast<const bf16x8*>(kb+d0*2048);
    const bf16x8 b1=*reinterpret_cast<const bf16x8*>(kb+d0*2048+512);
    {p0=__builtin_amdgcn_mfma_f32_32x32x16_bf16(b0,qr[d0],p0,0,0,0);p1=__builtin_amdgcn_mfma_f32_32x32x16_bf16(b1,qr[d0],p1,0,0,0);}}
}
typedef __attribute__((address_space(3))) const char* lds_cptr;
typedef short v4i16_t __attribute__((ext_vector_type(4)));
__device__ __forceinline__ void kload8(bf16x8*kf,lds_cptr kp){
  kf[0]=*(const __attribute__((address_space(3))) bf16x8*)(kp);      kf[1]=*(const __attribute__((address_space(3))) bf16x8*)(kp+512);
  kf[2]=*(const __attribute__((address_space(3))) bf16x8*)(kp+2048); kf[3]=*(const __attribute__((address_space(3))) bf16x8*)(kp+2560);
  kf[4]=*(const __attribute__((address_space(3))) bf16x8*)(kp+4096); kf[5]=*(const __attribute__((address_space(3))) bf16x8*)(kp+4608);
  kf[6]=*(const __attribute__((address_space(3))) bf16x8*)(kp+6144); kf[7]=*(const __attribute__((address_space(3))) bf16x8*)(kp+6656);
}
__device__ __forceinline__ void kload2(bf16x8*kf,lds_cptr kp,int j){ kf[2*j]=*(const __attribute__((address_space(3))) bf16x8*)(kp+j*2048); kf[2*j+1]=*(const __attribute__((address_space(3))) bf16x8*)(kp+j*2048+512); }
__device__ __forceinline__ s16x4 vtr(lds_cptr p){ return __builtin_bit_cast(s16x4,__builtin_amdgcn_ds_read_tr16_b64_v4i16((__attribute__((address_space(3))) v4i16_t*)p)); }
__device__ __forceinline__ float rowmax(const f32x16&p0,const f32x16&p1){
  float a=max3f(p0[0],p0[1],p1[0]),b=max3f(p0[2],p0[3],p1[1]);a=max3f(a,p1[2],p1[3]);
  #pragma unroll
  for(int r=4;r<16;r+=4){a=max3f(a,p0[r],p0[r+1]);b=max3f(b,p0[r+2],p0[r+3]);a=max3f(a,p1[r],p1[r+1]);b=max3f(b,p1[r+2],p1[r+3]);}
  const float m=max2f(a,b);
  auto rr=__builtin_amdgcn_permlane32_swap(__float_as_uint(m),__float_as_uint(m),false,false);
  return max2f(__uint_as_float(rr[0]),__uint_as_float(rr[1]));
}
__device__ __forceinline__ void pv(f32x16*o,int vb,bf16x8 pa0,bf16x8 pa1,bf16x8 pa2,bf16x8 pa3){
  #pragma unroll
  for(int d0=0;d0<2;++d0){s16x4 lo[4],hi[4];
    #pragma unroll
    for(int ks=0;ks<4;++ks){
      asm volatile("ds_read_b64_tr_b16 %0,%1 offset:%c2":"=&v"(lo[ks]):"v"(vb),"i"(d0*4096+ks*1024):"memory");
      asm volatile("ds_read_b64_tr_b16 %0,%1 offset:%c2":"=&v"(hi[ks]):"v"(vb),"i"(d0*4096+ks*1024+512):"memory");}
    asm volatile("s_waitcnt lgkmcnt(0)":::"memory");SBAR();
    #define PK(k) (bf16x8){lo[k][0],lo[k][1],lo[k][2],lo[k][3],hi[k][0],hi[k][1],hi[k][2],hi[k][3]}
    o[d0]=__builtin_amdgcn_mfma_f32_32x32x16_bf16(pa0,PK(0),o[d0],0,0,0);
    o[d0]=__builtin_amdgcn_mfma_f32_32x32x16_bf16(pa1,PK(1),o[d0],0,0,0);
    o[d0]=__builtin_amdgcn_mfma_f32_32x32x16_bf16(pa2,PK(2),o[d0],0,0,0);
    o[d0]=__builtin_amdgcn_mfma_f32_32x32x16_bf16(pa3,PK(3),o[d0],0,0,0);
    #undef PK
  }
}

#ifndef ATTN_STORE16
#define ATTN_STORE16(p,v) (*(u32x4*)(p)=(v))
#endif
template<int THRL> __device__ __forceinline__ void attn_unit(int b,int h,int qb,const bf16*Q,const bf16*__restrict__ K,const bf16*__restrict__ V,bf16*O,const float*__restrict__ csum,char*shm){
  int tid_=threadIdx.x; asm volatile("":"+v"(tid_));
  const int tid=tid_,lane=tid&63,r32=lane&31,hi=lane>>5; const int wid=__builtin_amdgcn_readfirstlane(tid>>6);
  const lds_cptr shm3=(lds_cptr)shm;
  const long rowbase=(long)b*SEQ; const int q0=qb*QB;
  const bf16*Qw=Q+(rowbase+q0+wid*QBLK)*DM+h*D;
  const bf16*Kh=K+rowbase*DM+h*D,*Vh=V+rowbase*DM+h*D;
  const unsigned lds0=(unsigned)(uintptr_t)shm;
  float*wsf=(float*)(shm+LDS_WS)+wid*64;
  const bf16*ksrc=Kh+(long)lane*DM+wid*8;
  const bf16*vsrc=Vh+(long)(16*(wid&3)+(lane>>2))*DM+(wid>>2)*32+(lane&3)*8;
  const unsigned kdst=lds0+LDS_K+wid*1024, vdst=lds0+LDS_V+wid*1024;
  #define DMA_K(t,slot) glds16(ksrc+(long)(t)*KVBLK*DM,(unsigned)__builtin_amdgcn_readfirstlane(kdst+(slot)))
  #define DMA_V(t,slot) glds16(vsrc+(long)(t)*KVBLK*DM,(unsigned)__builtin_amdgcn_readfirstlane(vdst+(slot)))
  const int vb0=(int)(lds0+LDS_V)+((lane>>4)&1)*32+(lane&3)*8+(4*hi+((lane&15)>>2))*64;
  const char*Kbase=shm+LDS_K; bf16x8 kf[8];
  const lds_cptr kp0=shm3+LDS_K+hi*1024+r32*16; const lds_cptr vp0=shm3+LDS_V+((lane>>4)&1)*32+(lane&3)*8+(4*hi+((lane&15)>>2))*64;
  const int NT=(q0+QB)/KVBLK;
  { const float*cs=csum+(long)(b*NHEAD+h)*SEQ; const float cref=cs[q0]; float*cbw=(float*)(shm+LDS_CB);
    for(int j=tid;j<q0+QB;j+=NW*64)cbw[j]=(cref-cs[j])*1.4426950408889634f; }
  const __attribute__((address_space(3))) f32x4_t* cbp=(const __attribute__((address_space(3))) f32x4_t*)(shm3+LDS_CB+16*hi);
  #define LOADB(X0,X1,t) do{ _Pragma("unroll") for(int g_=0;g_<4;++g_){ const f32x4_t b0_=cbp[16*(t)+2*g_], b1_=cbp[16*(t)+2*g_+8]; \
      X0[4*g_]=b0_[0];X0[4*g_+1]=b0_[1];X0[4*g_+2]=b0_[2];X0[4*g_+3]=b0_[3]; X1[4*g_]=b1_[0];X1[4*g_+1]=b1_[1];X1[4*g_+2]=b1_[2];X1[4*g_+3]=b1_[3]; } }while(0)
  DMA_K(0,0);DMA_V(0,0);DMA_K(1,SLOTB);
  bf16x8 qr[4];
  #pragma unroll
  for(int d0=0;d0<4;++d0)qr[d0]=*reinterpret_cast<const bf16x8*>(&Qw[(long)r32*DM+d0*16+hi*8]);
  float mhat=0.f,l_reg=0.f;f32x16 o[2];o[0]=f32x16{};o[1]=f32x16{};
  const int qrel=wid*QBLK+r32;
  #define CMASK(P0,P1,t) do{int jb_=(t)-(NT-4); if(jb_>=0)cmask(P0,P1,jb_,qrel,hi);}while(0)
  bool resc=false;
  #define START(P0,P1) do{ const float rm=rowmax(P0,P1); resc=false; \
    { const float dl=rm; mhat=fadd_s(mhat,dl); \
      _Pragma("unroll") for(int r=0;r<16;++r){P0[r]=fsub_s(P0[r],dl);P1[r]=fsub_s(P1[r],dl);} } \
    _Pragma("unroll") for(int r=0;r<16;++r)P0[r]=__builtin_amdgcn_exp2f(P0[r]); }while(0)
  #define RESC() do{ if(resc){ asm volatile("s_waitcnt lgkmcnt(0)":::"memory"); \
      _Pragma("unroll") for(int d_=0;d_<2;++d_) _Pragma("unroll") for(int r=0;r<16;++r)o[d_][r]*=wsf[crow(r,hi)]; } }while(0)
  f32x16 pA0,pA1,pB0,pB1;
  int sl_prev=0,sl_cur=0,sl_next=SLOTB;
  #define ROT() do{sl_prev=sl_cur;sl_cur=sl_next;sl_next=(sl_next==(NSLOT-1)*SLOTB)?0:sl_next+SLOTB;}while(0)
  DMA_K(2,2*SLOTB);
  WAIT_BAR(3);
  LOADB(pA0,pA1,0);qkt(pA0,pA1,Kbase,qr,r32,hi);asm volatile("s_nop 15\n\ts_nop 7":"+v"(pA0),"+v"(pA1));CMASK(pA0,pA1,0);
  START(pA0,pA1);
  LOADB(pB0,pB1,1);
  _Pragma("unroll") for(int r=0;r<16;++r)pA1[r]=__builtin_amdgcn_exp2f(pA1[r]);
  WAIT_BAR(0);
  DMA_K(3,0);DMA_V(1,SLOTB);
  ROT();
  kload8(kf,kp0+sl_cur);
  WAIT_BAR(2);
  s16x4 vlo[8],vhi[8]; u32x4 pw0,pw1,pw2,pw3;
  #define PKW(P,B) cvtpk_s(P[B],P[B+1])
  #define PAF(k) __builtin_bit_cast(bf16x8,pw##k)
  #define VFR(i) (bf16x8){vlo[i][0],vlo[i][1],vlo[i][2],vlo[i][3],vhi[i][0],vhi[i][1],vhi[i][2],vhi[i][3]}
  #define PIN(x) asm volatile("":"+v"(x))
  #define MX3(a,b,c) __builtin_fmaxf(__builtin_fmaxf((a),(b)),(c))
  #define GAPA(MF,A0,A1,A2,A3,W0,W1,PW) do{ MF; sacc+=A0; sacc+=A1; sacc+=A2; sacc+=A3; PIN(sacc); W0; W1; PIN(PW); SBAR(); }while(0)
  #define EX(v) __builtin_amdgcn_exp2f(v)
  #define GAPB(MF,X,B) do{ MF; X[B]=EX(X[B]); X[B+1]=EX(X[B+1]); X[B+2]=EX(X[B+2]); X[B+3]=EX(X[B+3]); PIN(X); SBAR(); }while(0)
  #define VRD(i) do{ vlo[i]=vtr(vp_+(((i)>>2)*4096+((i)&3)*1024)); vhi[i]=vtr(vp_+(((i)>>2)*4096+((i)&3)*1024+512)); }while(0)
  #define KRD(G,j) do{ if(G){ kload2(kf,kp0+sl_next,j); SBAR(); } }while(0)
  #define STEP(C0,C1,P0,P1,t,GK,GV,GL) do{ SBAR(); \
    _Pragma("unroll") for(int r=0;r<16;++r){C0[r]-=mhat;C1[r]-=mhat;} \
    const lds_cptr vp_=vp0+sl_prev; \
    VRD(0); SBAR(); float sacc=(P0[0]+P0[1]); \
    GAPA(C0=__builtin_amdgcn_mfma_f32_32x32x16_bf16(kf[0],qr[0],C0,0,0,0), P0[2],P0[3],P0[4],P0[5],     pw0[0]=PKW(P0,0), pw0[1]=PKW(P0,2), pw0); \
    VRD(4); SBAR(); GAPA(C1=__builtin_amdgcn_mfma_f32_32x32x16_bf16(kf[1],qr[0],C1,0,0,0), P0[6],P0[7],P0[8],P0[9],     pw0[2]=PKW(P0,4), pw0[3]=PKW(P0,6), pw0); \
    VRD(1); SBAR(); GAPA(C0=__builtin_amdgcn_mfma_f32_32x32x16_bf16(kf[2],qr[1],C0,0,0,0),   P0[10],P0[11],P0[12],P0[13], pw1[0]=PKW(P0,8), pw1[1]=PKW(P0,10), pw1); \
    VRD(5); SBAR(); GAPA(C1=__builtin_amdgcn_mfma_f32_32x32x16_bf16(kf[3],qr[1],C1,0,0,0),   P0[14],P0[15],P1[0],P1[1],   pw1[2]=PKW(P0,12),pw1[3]=PKW(P0,14), pw1); \
    VRD(2); SBAR(); GAPA(C0=__builtin_amdgcn_mfma_f32_32x32x16_bf16(kf[4],qr[2],C0,0,0,0),   P1[2],P1[3],P1[4],P1[5],     pw2[0]=PKW(P1,0), pw2[1]=PKW(P1,2), pw2); \
    VRD(6); SBAR(); GAPA(C1=__builtin_amdgcn_mfma_f32_32x32x16_bf16(kf[5],qr[2],C1,0,0,0),   P1[6],P1[7],P1[8],P1[9],     pw2[2]=PKW(P1,4), pw2[3]=PKW(P1,6), pw2); \
    VRD(3); SBAR(); GAPA(C0=__builtin_amdgcn_mfma_f32_32x32x16_bf16(kf[6],qr[3],C0,0,0,0),   P1[10],P1[11],P1[12],P1[13], pw3[0]=PKW(P1,8), pw3[1]=PKW(P1,10), pw3); \
    VRD(7); SBAR(); GAPA(C1=__builtin_amdgcn_mfma_f32_32x32x16_bf16(kf[7],qr[3],C1,0,0,0),   P1[14],P1[15],0.f,0.f,       pw3[2]=PKW(P1,12),pw3[3]=PKW(P1,14), pw3); \
    l_reg+=sacc; LOADB(P0,P1,(t)+1); \
    if(GK){DMA_K((t)+3,sl_cur);} if(GV){DMA_V((t)+1,sl_next);} \
    CMASK(C0,C1,t); \
    { float a=MX3(C0[0],C0[1],C1[0]),b=MX3(C0[2],C0[3],C1[1]); a=MX3(a,C1[2],C1[3]); \
      _Pragma("unroll") for(int r=4;r<16;r+=4){a=MX3(a,C0[r],C0[r+1]);b=MX3(b,C0[r+2],C0[r+3]);a=MX3(a,C1[r],C1[r+1]);b=MX3(b,C1[r+2],C1[r+3]);} \
      float rm=__builtin_fmaxf(a,b); { auto rr=__builtin_amdgcn_permlane32_swap(__float_as_uint(rm),__float_as_uint(rm),false,false); rm=__builtin_fmaxf(__uint_as_float(rr[0]),__uint_as_float(rr[1])); } \
      resc=false; \
      if(__builtin_expect(__any(rm>(float)THRL),0)){ const float dl=__builtin_fmaxf(rm,0.f); mhat+=dl; \
        _Pragma("unroll") for(int r=0;r<16;++r){C0[r]-=dl;C1[r]-=dl;} \
        const float f=__builtin_amdgcn_exp2f(-dl); l_reg*=f; if(hi==0)wsf[r32]=f; resc=true; } } \
    SBAR(); \
    GAPB(o[0]=__builtin_amdgcn_mfma_f32_32x32x16_bf16(PAF(0),VFR(0),o[0],0,0,0), C0,0); \
    GAPB(o[1]=__builtin_amdgcn_mfma_f32_32x32x16_bf16(PAF(0),VFR(4),o[1],0,0,0), C0,4); \
    KRD(GL,0); GAPB(o[0]=__builtin_amdgcn_mfma_f32_32x32x16_bf16(PAF(1),VFR(1),o[0],0,0,0), C0,8); \
    KRD(GL,1); GAPB(o[1]=__builtin_amdgcn_mfma_f32_32x32x16_bf16(PAF(1),VFR(5),o[1],0,0,0), C0,12); \
    KRD(GL,2); GAPB(o[0]=__builtin_amdgcn_mfma_f32_32x32x16_bf16(PAF(2),VFR(2),o[0],0,0,0), C1,0); \
    KRD(GL,3); GAPB(o[1]=__builtin_amdgcn_mfma_f32_32x32x16_bf16(PAF(2),VFR(6),o[1],0,0,0), C1,4); \
    GAPB(o[0]=__builtin_amdgcn_mfma_f32_32x32x16_bf16(PAF(3),VFR(3),o[0],0,0,0), C1,8); \
    GAPB(o[1]=__builtin_amdgcn_mfma_f32_32x32x16_bf16(PAF(3),VFR(7),o[1],0,0,0), C1,12); \
    }while(0)
  int t=1;
  #undef CMASK
  #define CMASK(P0,P1,t) do{}while(0)
  for(;t+5<NT;t+=2){
    STEP(pB0,pB1,pA0,pA1,t,true,true,true);     WAIT_BAR(2); RESC(); ROT();
    STEP(pA0,pA1,pB0,pB1,t+1,true,true,true);   WAIT_BAR(2); RESC(); ROT();
  }
  #undef CMASK
  #define CMASK(P0,P1,t) do{int jb_=(t)-(NT-4); if(jb_>=0)cmask(P0,P1,jb_,qrel,hi);}while(0)
  #define ENDW(tt) do{ if((tt)+3<NT){WAIT_BAR(2);} else if((tt)+2<NT){WAIT_BAR(1);} else {WAIT_BAR(0);} }while(0)
  for(;t+1<NT;t+=2){
    STEP(pB0,pB1,pA0,pA1,t,(t+3<NT),(t+1<NT),(t+1<NT));       ENDW(t);   RESC(); ROT();
    STEP(pA0,pA1,pB0,pB1,t+1,(t+4<NT),(t+2<NT),(t+2<NT));     ENDW(t+1); RESC(); ROT();
  }
  STEP(pB0,pB1,pA0,pA1,NT-1,false,false,false); RESC();
  { float sacc=pB0[0]+pB0[1]; _Pragma("unroll") for(int r=2;r<16;++r)sacc+=pB0[r]; _Pragma("unroll") for(int r=0;r<16;++r)sacc+=pB1[r]; l_reg+=sacc;
    pw0=(u32x4){PKW(pB0,0),PKW(pB0,2),PKW(pB0,4),PKW(pB0,6)};pw1=(u32x4){PKW(pB0,8),PKW(pB0,10),PKW(pB0,12),PKW(pB0,14)};pw2=(u32x4){PKW(pB1,0),PKW(pB1,2),PKW(pB1,4),PKW(pB1,6)};pw3=(u32x4){PKW(pB1,8),PKW(pB1,10),PKW(pB1,12),PKW(pB1,14)};
    SBAR(); pv(o,vb0+sl_cur,PAF(0),PAF(1),PAF(2),PAF(3)); }
  #undef PKW
  #undef PAF
  #undef VFR
  #undef PIN
  #undef MX3
  #undef GAPA
  #undef GAPB
  #undef EX
  #undef VRD
  #undef KRD
  #undef STEP
  #undef ENDW
  {auto rr=__builtin_amdgcn_permlane32_swap(__float_as_uint(l_reg),__float_as_uint(l_reg),false,false);l_reg=__uint_as_float(rr[0])+__uint_as_float(rr[1]);}
  if(hi==0)wsf[32+r32]=l_reg;asm volatile("s_waitcnt lgkmcnt(0)":::"memory");
  float rli[16];
  #pragma unroll
  for(int r=0;r<16;++r)rli[r]=__builtin_amdgcn_rcpf(wsf[32+crow(r,hi)]);
  bf16*Ow=O+(rowbase+q0+wid*QBLK)*DMO+h*D;
  { bf16*stg=(bf16*)(shm+LDS_OST)+wid*2048;
    #pragma unroll
    for(int r=0;r<16;++r){const int orow=crow(r,hi);
      #pragma unroll
      for(int d0=0;d0<2;++d0)stg[orow*64+d0*32+r32]=__float2bfloat16(o[d0][r]*rli[r]);}
    asm volatile("s_waitcnt lgkmcnt(0)":::"memory");
    #pragma unroll
    for(int i=0;i<4;++i){const int row=i*8+(lane>>3),ch=lane&7; const u32x4 v=*(const u32x4*)(stg+row*64+ch*8); ATTN_STORE16(Ow+(long)row*DMO+ch*8,v);} }
  asm volatile("s_waitcnt lgkmcnt(0)\n\ts_barrier":::"memory");
  #undef LOADB
  #undef DMA_K
  #undef DMA_V
  #undef CMASK
  #undef START
  #undef RESC
  #undef ROT
}
constexpr int ATTN_LDS_BYTES=LDS_BYTES;
struct AttnTensors { const bf16* Q; const bf16* K; const bf16* V; bf16* O; const float* csum; };
struct AttnUnit { int bh; int qb; };
template<int THRL> __device__ __forceinline__ void attn_phase(char*lds,const AttnTensors&T){
  const int G=gridDim.x,bx=blockIdx.x; const int vcu=(G%8==0)?(bx%8)*(G/8)+bx/8:bx;
  for(int v=vcu;v<256;v+=G){ const int s=v&3,bh=v>>2;
    for(int i=0;i<4;++i){ const int qb=(i==0)?15-s:(i==1)?8+s:(i==2)?7-s:s; attn_unit<THRL>(bh/NHEAD,bh%NHEAD,qb,T.Q,T.K,T.V,T.O,T.csum,lds); } }
}
#undef SBAR
#undef WAIT_BAR
}

__device__ __forceinline__ void phase_mix_naive(const Args& a, LAS unsigned char* lds) {
    const int tid = threadIdx.x, lane = tid & 63, wave = tid >> 6;
    LAS float* vt = (LAS float*)lds;
    bf16_t* Ub = (bf16_t*)(a.ws + WS_ARENA + AR_U); const bf16_t* V3 = (const bf16_t*)(a.ws + WS_ARENA + AR_V3); const float* vstat = (const float*)(a.ws + WS_VSTAT);
    const bf16_t* tril = (const bf16_t*)(a.ws + WS_TRIL);
    for (int u = blockIdx.x; u < (T / CCH) * CG; u += gridDim.x) {
        const int g = u & 7, n = u >> 3; const size_t row0 = (size_t)n * CCH;
        __syncthreads();
        for (int i = tid; i < 128 * 64; i += NTHREADS) {
            const int s = i >> 6, c4 = (i & 63) * 4; const size_t row = row0 + s;
            const float* st = vstat + row * 32; float tot = 0.f;
#pragma unroll
            for (int j = 0; j < 32; ++j) tot += st[j];
            const float rs = rsqrtf(tot * (1.f / CW) + EPS);
            const u32x2 v = *(const u32x2*)(V3 + row * CW + 256 * g + c4); const float* gn = a.in[I_CVG] + 256 * g + c4;
            *(LAS f32x4*)(vt + s * 256 + c4) = (f32x4){bf_lo(v.x) * rs * gn[0], bf_hi(v.x) * rs * gn[1], bf_lo(v.y) * rs * gn[2], bf_hi(v.y) * rs * gn[3]};
        }
        __syncthreads();
        for (int tt = 0; tt < 16; ++tt) {
            const int t = wave * 16 + tt; const bf16_t* wrow = tril + ((size_t)g * 128 + t) * 128;
            f32x4 acc = (f32x4){0.f, 0.f, 0.f, 0.f};
            for (int s = 0; s <= t; ++s) { const float w = bf2f(wrow[s]); const f32x4 v = *(const LAS f32x4*)(vt + s * 256 + 4 * lane); acc += v * w; }
            const float bs = a.in[I_CBS][g * 128 + t];
            u32x2* up = (u32x2*)(Ub + (row0 + t) * CW + 256 * g + 4 * lane); const u32x2 uv = *up;
            u32x2 o; o.x = pk2(bf_lo(uv.x) * (acc.x + bs), bf_hi(uv.x) * (acc.y + bs)); o.y = pk2(bf_lo(uv.y) * (acc.z + bs), bf_hi(uv.y) * (acc.w + bs));
            *up = o;
        }
    }
    __syncthreads();
}

__device__ __forceinline__ void phase_mix_fast(const Args& a, LAS unsigned char* lds) {
    typedef short v4i16_t __attribute__((ext_vector_type(4)));
    typedef float f32x16 __attribute__((ext_vector_type(16)));
    const int tid = threadIdx.x, lane = tid & 63, wave = __builtin_amdgcn_readfirstlane(tid >> 6), r32 = lane & 31, hi = lane >> 5;
    constexpr int RS = 576;
    LAS unsigned char* tile = lds; LAS float* rsl = (LAS float*)(lds + 128 * RS);
    bf16_t* Ub = (bf16_t*)(a.ws + WS_ARENA + AR_U); const bf16_t* V3 = (const bf16_t*)(a.ws + WS_ARENA + AR_V3); const float* vstat = (const float*)(a.ws + WS_VSTAT);
    const bf16_t* tril = (const bf16_t*)(a.ws + WS_TRIL);
    const int q = (lane & 15) >> 2, p = lane & 3, cblk = (lane >> 4) & 1;
    for (int u = blockIdx.x; u < (T / CCH) * CG; u += gridDim.x) {
        const int g = u & 7, n = u >> 3; const size_t row0 = (size_t)n * CCH;
        __syncthreads();
        if (tid < 128) { const f32x4* st = (const f32x4*)(vstat + (row0 + tid) * 32); float tot = 0.f;
#pragma unroll
            for (int j = 0; j < 8; ++j) { const f32x4 v = st[j]; tot += (v.x + v.y) + (v.z + v.w); }
            rsl[tid] = rsqrtf(tot * (1.f / CW) + EPS); }
        __syncthreads();
#pragma unroll
        for (int j = 0; j < 8; ++j) {
            const int i = tid + 512 * j, s = i >> 5, c8 = (i & 31) * 8;
            const u32x4 v = *(const u32x4*)(V3 + (row0 + s) * CW + 256 * g + c8);
            const float* gn = a.in[I_CVG] + 256 * g + c8; const f32x4 g0 = *(const f32x4*)gn, g1 = *(const f32x4*)(gn + 4); const float rs = rsl[s];
            u32x4 w; w.x = pk2(bf_lo(v.x) * rs * g0.x, bf_hi(v.x) * rs * g0.y); w.y = pk2(bf_lo(v.y) * rs * g0.z, bf_hi(v.y) * rs * g0.w);
            w.z = pk2(bf_lo(v.z) * rs * g1.x, bf_hi(v.z) * rs * g1.y); w.w = pk2(bf_lo(v.w) * rs * g1.z, bf_hi(v.w) * rs * g1.w);
            *(LAS u32x4*)(tile + s * RS + c8 * 2) = w;
        }
        __syncthreads();
        f32x16 acc[4];
#pragma unroll
        for (int tb = 0; tb < 4; ++tb) acc[tb] = f32x16{};
        const LAS unsigned char* abase = tile + (8 * hi + q) * RS + (32 * wave + 16 * cblk + 4 * p) * 2;
        const bf16_t* wbase = tril + ((size_t)g * 128 + r32) * 128 + 8 * hi;
#pragma unroll
        for (int ks = 0; ks < 8; ++ks) {
            const v4i16_t lo = __builtin_amdgcn_ds_read_tr16_b64_v4i16((LAS v4i16_t*)(abase + (16 * ks) * RS));
            const v4i16_t h2 = __builtin_amdgcn_ds_read_tr16_b64_v4i16((LAS v4i16_t*)(abase + (16 * ks + 4) * RS));
            const bf16x8 af = (bf16x8){lo[0], lo[1], lo[2], lo[3], h2[0], h2[1], h2[2], h2[3]};
#pragma unroll
            for (int tb = 0; tb < 4; ++tb) if (ks <= 2 * tb + 1) {
                const bf16x8 bfr = *(const bf16x8*)(wbase + (size_t)(32 * tb) * 128 + 16 * ks);
                acc[tb] = __builtin_amdgcn_mfma_f32_32x32x16_bf16(af, bfr, acc[tb], 0, 0, 0);
            }
        }
#pragma unroll
        for (int tb = 0; tb < 4; ++tb) {
            const int t = 32 * tb + r32; const float bs = a.in[I_CBS][g * 128 + t];
            bf16_t* up = Ub + (row0 + t) * CW + 256 * g + 32 * wave + 4 * hi;
#pragma unroll
            for (int gr = 0; gr < 4; ++gr) {
                u32x2* pp = (u32x2*)(up + 8 * gr); const u32x2 uv = *pp;
                u32x2 o; o.x = pk2(bf_lo(uv.x) * (acc[tb][4 * gr] + bs), bf_hi(uv.x) * (acc[tb][4 * gr + 1] + bs)); o.y = pk2(bf_lo(uv.y) * (acc[tb][4 * gr + 2] + bs), bf_hi(uv.y) * (acc[tb][4 * gr + 3] + bs));
                *pp = o;
            }
        }
    }
    __syncthreads();
}

__device__ __forceinline__ void phase_route(const Args& a, LAS unsigned char* lds, int l) {
    const int tid = threadIdx.x;
    LAS int* hist = (LAS int*)lds; LAS int* base = hist + 32;
    const float* rlog = (const float*)(a.ws + WS_RLOG); float* pairw = (float*)(a.ws + WS_PAIRW); int* list = (int*)(a.ws + WS_LIST); int* cnt = (int*)(a.ws + WS_CTL) + 64 * l;
    for (int cb = blockIdx.x; cb < T / 256; cb += gridDim.x) {
        __syncthreads();
        if (tid < 32) hist[tid] = 0;
        __syncthreads();
        int e0 = 0, e1 = 0, r0 = 0, r1 = 0; const int tok = cb * 256 + (tid & 255);
        if (tid < 256) {
            const float* lg = rlog + (size_t)tok * 40;
            int gi = 0; float gm = lg[0];
#pragma unroll
            for (int j = 1; j < 4; ++j) if (lg[j] > gm) { gm = lg[j]; gi = j; }
            float gs = 0.f;
#pragma unroll
            for (int j = 0; j < 4; ++j) gs += __expf(lg[j] - gm);
            const float gw = 1.f / gs;
            const float* el = lg + 4 + 8 * gi;
            int i0 = 0; float v0 = el[0];
#pragma unroll
            for (int j = 1; j < 8; ++j) if (el[j] > v0) { v0 = el[j]; i0 = j; }
            int i1 = -1; float v1 = -INFINITY;
#pragma unroll
            for (int j = 0; j < 8; ++j) if (j != i0 && el[j] > v1) { v1 = el[j]; i1 = j; }
            const float ex = __expf(v1 - v0), den = 1.f / (1.f + ex);
            pairw[2 * tok] = gw * den; pairw[2 * tok + 1] = gw * ex * den;
            e0 = gi * 8 + i0; e1 = gi * 8 + i1;
            r0 = atomicAdd((int*)&hist[e0], 1); r1 = atomicAdd((int*)&hist[e1], 1);
        }
        __syncthreads();
        if (tid < 32) base[tid] = hist[tid] ? atomicAdd(&cnt[tid], hist[tid]) : 0;
        __syncthreads();
        if (tid < 256) { list[(size_t)e0 * 65536 + base[e0] + r0] = 2 * tok; list[(size_t)e1 * 65536 + base[e1] + r1] = 2 * tok + 1; }
    }
    __syncthreads();
}

__device__ __forceinline__ void phase_combine(const Args& a, bool last) {
    const int lane = threadIdx.x & 63, wave = threadIdx.x >> 6;
    const int gw = blockIdx.x * NWAVES + wave, NGW = gridDim.x * NWAVES;
    bf16_t* X = (bf16_t*)(a.ws + WS_X); const bf16_t* Y = (const bf16_t*)(a.ws + WS_ARENA + AR_Y); float* xstat = (float*)(a.ws + WS_XSTAT);
    for (int row = gw; row < T; row += NGW) {
        float ss = 0.f;
#pragma unroll
        for (int hlf = 0; hlf < 2; ++hlf) {
            const int c0 = 512 * hlf + 8 * lane;
            const u32x4 xv = *(const u32x4*)(X + (size_t)row * D + c0), y0 = *(const u32x4*)(Y + (size_t)(2 * row) * D + c0), y1 = *(const u32x4*)(Y + (size_t)(2 * row + 1) * D + c0);
            float v[8] = {bf_lo(xv.x), bf_hi(xv.x), bf_lo(xv.y), bf_hi(xv.y), bf_lo(xv.z), bf_hi(xv.z), bf_lo(xv.w), bf_hi(xv.w)};
            const float p[8] = {bf_lo(y0.x), bf_hi(y0.x), bf_lo(y0.y), bf_hi(y0.y), bf_lo(y0.z), bf_hi(y0.z), bf_lo(y0.w), bf_hi(y0.w)};
            const float q[8] = {bf_lo(y1.x), bf_hi(y1.x), bf_lo(y1.y), bf_hi(y1.y), bf_lo(y1.z), bf_hi(y1.z), bf_lo(y1.w), bf_hi(y1.w)};
#pragma unroll
            for (int j = 0; j < 8; ++j) v[j] = (v[j] + p[j]) + q[j];
            if (last) { float* o = a.out + (size_t)row * D + c0; *(f32x4*)o = (f32x4){v[0], v[1], v[2], v[3]}; *(f32x4*)(o + 4) = (f32x4){v[4], v[5], v[6], v[7]}; }
            else { u32x4 w; w.x = pk2(v[0], v[1]); w.y = pk2(v[2], v[3]); w.z = pk2(v[4], v[5]); w.w = pk2(v[6], v[7]); *(u32x4*)(X + (size_t)row * D + c0) = w;
                const float r[8] = {bf_lo(w.x), bf_hi(w.x), bf_lo(w.y), bf_hi(w.y), bf_lo(w.z), bf_hi(w.z), bf_lo(w.w), bf_hi(w.w)};
#pragma unroll
                for (int j = 0; j < 8; ++j) ss += r[j] * r[j]; }
        }
        if (!last) { ss = wave_sum(ss); if (lane < 16) xstat[(size_t)row * 16 + lane] = lane == 0 ? ss : 0.f; }
    }
}

#define XB_TMO      128
#define XB_XCNT(j)  (256  + 64 * (j))
#define XB_XSUB(j)  (1280 + 64 * (j))
#define XB_XGEN(j)  (2304 + 64 * (j))
#define XB_TOP      3328
#define XB_TOPGEN   3392
#define XCD_BAR_WORDS 3456
#define XB_SPIN_CAP (1u << 22)

__device__ __forceinline__ unsigned xb_ld(unsigned* p)              { return __hip_atomic_load(p, __ATOMIC_RELAXED, __HIP_MEMORY_SCOPE_AGENT); }
__device__ __forceinline__ unsigned xb_add(unsigned* p, unsigned v) { return __hip_atomic_fetch_add(p, v, __ATOMIC_RELAXED, __HIP_MEMORY_SCOPE_AGENT); }
__device__ __forceinline__ unsigned xb_xcc_id() { return (unsigned)__builtin_amdgcn_s_getreg((3 << 11) | 20) & 0xFu; }
#define XB_SPIN(cond, bar) do { unsigned _sp = 0; while (cond) { __builtin_amdgcn_s_sleep(1); \
    if ((++_sp & 255u) == 0u) { if (xb_ld(&(bar)[XB_TMO])) break; if (_sp > XB_SPIN_CAP) { atomicAdd(&(bar)[XB_TMO], 1u); break; } } } } while (0)

struct XcdBarrier {
    unsigned* bar; unsigned x;
    volatile LAS unsigned* st;
};

__device__ __forceinline__ XcdBarrier xcd_barrier_post(unsigned* bar, volatile LAS unsigned* st) {
    XcdBarrier b; b.bar = bar; b.x = xb_xcc_id(); b.st = st;
    if (threadIdx.x == 0) (void)xb_add(&bar[XB_XCNT(b.x)], 1u);
    return b;
}
__device__ __forceinline__ void xcd_barrier_complete(unsigned* bar, unsigned x, unsigned& nloc, unsigned& nx) {
    const unsigned G = gridDim.x * gridDim.y * gridDim.z;
    unsigned sum, cnt, mine, sp = 0u;
    for (;;) {
        sum = 0u; cnt = 0u; mine = 0u;
#pragma unroll
        for (unsigned j = 0; j < 16; ++j) { const unsigned c = xb_ld(&bar[XB_XCNT(j)]); sum += c; cnt += (c > 0u) ? 1u : 0u; mine = (j == x) ? c : mine; }
        if (sum == G) break;
        __builtin_amdgcn_s_sleep(1);
        if ((++sp & 255u) == 0u) { if (xb_ld(&bar[XB_TMO])) break; if (sp > XB_SPIN_CAP) { atomicAdd(&bar[XB_TMO], 1u); break; } }
    }
    nloc = mine > 0u ? mine : 1u; nx = cnt > 0u ? cnt : 1u;
}

__device__ __forceinline__ void xcd_barrier(const XcdBarrier& b) {
    asm volatile("s_waitcnt vmcnt(0)" ::: "memory");
    __syncthreads();
    if (threadIdx.x == 0) {
        unsigned* bar = b.bar;
        __builtin_amdgcn_s_waitcnt(0);
        unsigned nloc = b.st[0], nx = b.st[1];
        if (nloc == 0u) { xcd_barrier_complete(bar, b.x, nloc, nx); b.st[0] = nloc; b.st[1] = nx; }
        const unsigned old = xb_add(&bar[XB_XSUB(b.x)], 1u);
        const unsigned gen = old / nloc;
        if (old + 1u == (gen + 1u) * nloc) {
            __builtin_amdgcn_fence(__ATOMIC_RELEASE, "agent");
            asm volatile("s_waitcnt vmcnt(0)" ::: "memory");
            const unsigned og = xb_add(&bar[XB_TOP], 1u);
            const unsigned tg = og / nx;
            if (og + 1u == (tg + 1u) * nx) xb_add(&bar[XB_TOPGEN], 1u);
            else XB_SPIN(xb_ld(&bar[XB_TOPGEN]) == tg, bar);
            __builtin_amdgcn_fence(__ATOMIC_ACQUIRE, "agent");
            xb_add(&bar[XB_XGEN(b.x)], 1u);
            asm volatile("s_waitcnt vmcnt(0)" ::: "memory");
        } else {
            XB_SPIN(xb_ld(&bar[XB_XGEN(b.x)]) == gen, bar);
            __builtin_amdgcn_fence(__ATOMIC_ACQUIRE, "agent");
            asm volatile("s_waitcnt vmcnt(0)" ::: "memory");
        }
    }
    __syncthreads();
}

constexpr int NPHASES = 26;
#ifdef ONLY_PHASE
#define PH(k) if (((k) == ONLY_PHASE || (k) == ONLY_PHASE2) && a.ph_lo <= (k) && (k) < a.ph_hi)
#else
#define PH(k) if (a.ph_lo <= (k) && (k) < a.ph_hi)
#endif
#if USE_CG_SYNC
#define SYNC(k) do { if ((k) + 1 < a.ph_hi) cg::this_grid().sync(); } while (0)
#else
#define SYNC(k) do { if ((k) + 1 < a.ph_hi) xcd_barrier(bar); } while (0)
#endif

template <int L> __device__ __forceinline__ void layer_tail(const Args& a, LAS unsigned char* lds, const int base, const XcdBarrier& bar) {
    unsigned char* ws = a.ws; unsigned char* ar = ws + WS_ARENA;
    bf16_t* X = (bf16_t*)(ws + WS_X); float* xstat = (float*)(ws + WS_XSTAT);
    volatile LAS int* tpre = (volatile LAS int*)(lds + 131072);
    PH(base + 0) { PCrossQ p; p.nM = T / 256; p.nN = 4; p.X = X; p.W = (const bf16_t*)(ws + WS_W_Q) + (size_t)L * D * D; p.xstat = xstat; p.Q2 = (bf16_t*)(ar + AR_Q2); p.qstat = (float*)(ws + WS_QSTAT); p.lda = D; p.ldb = D; p.K = D; run_gemm(lds, p); SYNC(base + 0); }
    PH(base + 1) { PCrossS p; p.nM = T / 256; p.nN = 4; p.Q2 = (const bf16_t*)(ar + AR_Q2); p.K2 = (const bf16_t*)(ws + WS_K2) + (size_t)L * 2048 * 1024; p.qstat = (const float*)(ws + WS_QSTAT); p.P = (bf16_t*)(ar + AR_P); p.psum = (float*)(ws + WS_PSUM); p.lda = D; p.ldb = 256; p.K = 256; run_gemm(lds, p); SYNC(base + 1); }
    PH(base + 2) { PCrossPV p; p.nM = T / 256; p.nN = 4; p.P = (const bf16_t*)(ar + AR_P); p.V2T = (const bf16_t*)(ws + WS_V2T) + (size_t)L * 2048 * 1024; p.psum = (const float*)(ws + WS_PSUM); p.O = (bf16_t*)(ar + AR_O); p.lda = D; p.ldb = 256; p.K = 256; run_gemm(lds, p); SYNC(base + 2); }
    PH(base + 3) { PResid p; p.nM = T / 256; p.nN = 4; p.A = (const bf16_t*)(ar + AR_O); p.W = (const bf16_t*)(ws + WS_W_O) + (size_t)L * D * D; p.X = X; p.xstat = xstat; p.lda = D; p.ldb = D; p.K = D; run_gemm(lds, p); SYNC(base + 3); }
    PH(base + 4) { PRouter p; p.nM = T / 256; p.nN = 1; p.X = X; p.W = (const bf16_t*)(ws + WS_W_R) + (size_t)L * 256 * D; p.xstat = xstat; p.bg = a.in[I_MBG] + L * 4; p.be = a.in[I_MBE] + L * 32; p.rlog = (float*)(ws + WS_RLOG); p.lda = D; p.ldb = D; p.K = D; run_gemm(lds, p); SYNC(base + 4); }
    PH(base + 5) { phase_route(a, lds, L); SYNC(base + 5); }
    PH(base + 6) { PMoeUp p; p.cnt = (const int*)(ws + WS_CTL) + 64 * L; p.list = (const int*)(ws + WS_LIST); p.tpre = tpre; p.X = X; p.W = (const bf16_t*)(ws + WS_W_GU); p.xstat = xstat; p.H = (bf16_t*)(ar + AR_H); p.lda = D; p.ldb = D; p.K = D;
        moe_sched_build(p.cnt, tpre); run_gemm(lds, p); SYNC(base + 6); }
    PH(base + 7) { PMoeDown p; p.cnt = (const int*)(ws + WS_CTL) + 64 * L; p.list = (const int*)(ws + WS_LIST); p.tpre = tpre; p.H = (const bf16_t*)(ar + AR_H); p.W = (const bf16_t*)(ws + WS_W_DN); p.pairw = (const float*)(ws + WS_PAIRW); p.Y = (bf16_t*)(ar + AR_Y); p.lda = DEXP; p.ldb = DEXP; p.K = DEXP;
        moe_sched_build(p.cnt, tpre); run_gemm(lds, p); SYNC(base + 7); }
    PH(base + 8) { phase_combine(a, L == 1); SYNC(base + 8); }
}

__global__ void __launch_bounds__(NTHREADS, 2) fwd_kernel(Args a) {
    extern __shared__ __attribute__((aligned(16))) unsigned char lds_raw[];
    LAS unsigned char* lds = (LAS unsigned char*)lds_raw;
    unsigned char* ws = a.ws;
    bf16_t* X = (bf16_t*)(ws + WS_X); float* xstat = (float*)(ws + WS_XSTAT);
    unsigned char* ar = ws + WS_ARENA;
    volatile LAS unsigned* bst = (volatile LAS unsigned*)(lds + 131072 + 256);
    if (threadIdx.x < 2) bst[threadIdx.x] = 0u;
    __syncthreads();
    XcdBarrier bar = xcd_barrier_post((unsigned*)(ws + WS_CTL + 4096), bst);
    PH(0) { phase_prologue(a, lds);
#if defined(REPEAT_PRO)
        __syncthreads(); phase_prologue(a, lds);
#endif
        SYNC(0); }
    PH(1) {
        phase_cumsum(a, lds);
        { PInProj0 p; p.nM = T / 256; p.nN = 10; p.X = X; p.W = (const bf16_t*)(ws + WS_W_IN0); p.xstat = xstat; p.qg = a.in[I_AQG]; p.kg = a.in[I_AKG];
          p.Q = (bf16_t*)(ar + AR_Q); p.Kq = (bf16_t*)(ar + AR_K); p.V = (bf16_t*)(ar + AR_V); p.XB = (bf16_t*)(ar + AR_XB); p.GATE = (bf16_t*)(ar + AR_GATE); p.lda = D; p.ldb = D; p.K = D;
          run_gemm(lds, p); }
        { PMemKV m; m.nM = 8; m.nN = 16; m.A = (const bf16_t*)(ws + WS_MEMB); m.W = (const bf16_t*)(ws + WS_W_KV); m.memstat = (const float*)(ws + WS_MISC + MISC_MEMSTAT);
          m.k2stat_ = (float*)(ws + WS_MISC + MISC_K2STAT); m.K2_ = (bf16_t*)(ws + WS_K2); m.V2T_ = (bf16_t*)(ws + WS_ARENA + AR_V2TMP); m.lda = D; m.ldb = D; m.K = D;
          run_gemm(lds, m); }
        SYNC(1);
    }
    PH(2) { phase_k2fin(a); phase_lru(a, lds, 0);
#if defined(REPEAT_LRU)
        phase_lru(a, lds, 0);
#endif
        SYNC(2); }
    PH(3) { phase_lru(a, lds, 1);
#if FAST_ATTN
        { const attn_body::AttnTensors AT{(const attn_body::bf16*)(ar + AR_Q), (const attn_body::bf16*)(ar + AR_K), (const attn_body::bf16*)(ar + AR_V), (attn_body::bf16*)(ar + AR_AR), (const float*)(ws + WS_CSUM)};
          __syncthreads(); attn_body::attn_phase<ATTN_THRL>((char*)lds_raw, AT); __syncthreads(); }
#else
        phase_attn_naive(a);
#endif
        SYNC(3); }
    PH(4) { PResid p; p.nM = T / 256; p.nN = 4; p.A = (const bf16_t*)(ar + AR_AR); p.W = (const bf16_t*)(ws + WS_W_OUT0); p.X = X; p.xstat = xstat; p.lda = D; p.ldb = D; p.K = D; run_gemm(lds, p); SYNC(4); }
    layer_tail<0>(a, lds, 5, bar);
    PH(14) { conv_moe_layer(a, 1, lds);
        PInProj1 p; p.nM = T / 256; p.nN = 16; p.X = X; p.W = (const bf16_t*)(ws + WS_W_IN1); p.xstat = xstat; p.bias = a.in[I_CBIN]; p.Ub = (bf16_t*)(ar + AR_U); p.V3 = (bf16_t*)(ar + AR_V3); p.vstat = (float*)(ws + WS_VSTAT); p.lda = D; p.ldb = D; p.K = D;
        __syncthreads(); run_gemm(lds, p); SYNC(14); }
#if FAST_MIX
    PH(15) { phase_mix_fast(a, lds); SYNC(15); }
#else
    PH(15) { phase_mix_naive(a, lds); SYNC(15); }
#endif
    PH(16) { PResid p; p.nM = T / 256; p.nN = 4; p.A = (const bf16_t*)(ar + AR_U); p.W = (const bf16_t*)(ws + WS_W_OUT1); p.X = X; p.xstat = xstat; p.lda = CW; p.ldb = CW; p.K = CW; run_gemm(lds, p); SYNC(16); }
    layer_tail<1>(a, lds, 17, bar);
}

extern "C" void kernel_launch(void* const* d_in, const int* in_sizes, int n_in, void* d_out, int out_size, void* d_ws, size_t ws_size, hipStream_t stream) {
    static int grid = 0;
    if (grid == 0) {
        if (n_in != 36 || out_size != T * D || ws_size < WS_END) { fprintf(stderr, "kernel_launch: unexpected sizes n_in %d out %d ws %zu\n", n_in, out_size, ws_size); grid = -1; return; }
        int dev = 0, cus = 0, per_cu = 0;
        hipGetDevice(&dev); hipDeviceGetAttribute(&cus, hipDeviceAttributeMultiprocessorCount, dev);
        hipFuncSetAttribute((const void*)fwd_kernel, hipFuncAttributeMaxDynamicSharedMemorySize, LDS_BYTES);
        hipOccupancyMaxActiveBlocksPerMultiprocessor(&per_cu, (const void*)fwd_kernel, NTHREADS, LDS_BYTES);
        if (per_cu < 1) { fprintf(stderr, "kernel_launch: occupancy query says %d blocks per CU\n", per_cu); per_cu = 1; }
        (void)hipGetLastError();
        grid = cus;
    }
    if (grid < 0) return;
    (void)hipMemsetAsync((char*)d_ws + WS_CTL, 0, 32768, stream);
    Args a{};
    for (int i = 0; i < 36; ++i) a.in[i] = (const float*)d_in[i];
    a.out = (float*)d_out; a.ws = (unsigned char*)d_ws;
#if ONE_LAUNCH
    a.ph_lo = 0; a.ph_hi = NPHASES;
#if USE_CG_SYNC
    void* args[] = {&a};
    hipError_t e = hipLaunchCooperativeKernel((const void*)fwd_kernel, dim3(grid), dim3(NTHREADS), args, LDS_BYTES, stream);
    if (e != hipSuccess) fprintf(stderr, "cooperative launch failed: %s (grid %d)\n", hipGetErrorString(e), grid);
#else
    hipLaunchKernelGGL(fwd_kernel, dim3(grid), dim3(NTHREADS), LDS_BYTES, stream, a);
#endif
#else
    for (int ph = 0; ph < NPHASES; ++ph) { a.ph_lo = ph; a.ph_hi = ph + 1; hipLaunchKernelGGL(fwd_kernel, dim3(grid), dim3(NTHREADS), LDS_BYTES, stream, a); }
#endif
}
```

```cpp
#include <hip/hip_runtime.h>
#include <hip/hip_cooperative_groups.h>
#include <cstdint>
#include <cstdio>
namespace cg = cooperative_groups;

#ifndef FAST_CORE
#define FAST_CORE 1
#endif
#ifndef FAST_MIX
#define FAST_MIX 1
#endif
#ifndef USE_CG_SYNC
#define USE_CG_SYNC 0
#endif
#ifndef FAST_ATTN
#define FAST_ATTN 1
#endif
#ifndef ATTN_THRL
#define ATTN_THRL 32
#endif
#ifndef ONLY_PHASE2
#define ONLY_PHASE2 -1
#endif
#ifndef ONE_LAUNCH
#define ONE_LAUNCH 1
#endif

#define LAS __attribute__((address_space(3)))
typedef unsigned short bf16_t;
typedef short bf16x8 __attribute__((ext_vector_type(8)));
typedef float f32x4 __attribute__((ext_vector_type(4)));
typedef float f32x2 __attribute__((ext_vector_type(2)));
typedef unsigned u32x4 __attribute__((ext_vector_type(4)));
typedef unsigned u32x2 __attribute__((ext_vector_type(2)));

constexpr int NB = 8, SEQ = 4096, T = NB * SEQ, D = 1024;
constexpr int AH = 8, HD = 64, AW = 512, BW = 512;
constexpr int INAB = 2568;
constexpr int CW = 2048, CG = 8, CCH = 128;
constexpr int MEML = 256, XH = 4, XHD = 256;
constexpr int NGRP = 4, EPG = 8, NEXP = 32, DEXP = 512;
constexpr float EPS = 1e-6f;
constexpr float LOG2E = 1.4426950408889634f;
constexpr float C2 = 0.125f * LOG2E;
constexpr float C3 = 0.0625f * LOG2E;
constexpr int NTHREADS = 512, NWAVES = 8;
constexpr int LDS_BYTES = 147456;

constexpr size_t MiB = 1ull << 20;
constexpr size_t WS_CTL = 0;
constexpr size_t WS_W_IN0 = 1 * MiB, WS_W_OUT0 = 6 * MiB, WS_W_IN1 = 8 * MiB, WS_W_OUT1 = 16 * MiB;
constexpr size_t WS_W_Q = 20 * MiB, WS_W_KV = 24 * MiB, WS_W_O = 32 * MiB, WS_W_R = 36 * MiB, WS_TRIL = 37 * MiB;
constexpr size_t WS_W_GU = 38 * MiB, WS_W_DN = 102 * MiB;
constexpr size_t WS_X = 134 * MiB, WS_MEMB = 198 * MiB, WS_K2 = 202 * MiB, WS_V2T = 210 * MiB;
constexpr size_t WS_XSTAT = 218 * MiB, WS_VSTAT = 220 * MiB, WS_QSTAT = 224 * MiB, WS_PSUM = 226 * MiB;
constexpr size_t WS_FLOG = 228 * MiB, WS_CSUM = 229 * MiB, WS_LSUM = 230 * MiB, WS_MISC = 231 * MiB;
constexpr size_t WS_RLOG = 232 * MiB, WS_PAIRW = 238 * MiB, WS_LIST = 239 * MiB, WS_ARENA = 248 * MiB, WS_END = 504 * MiB;
constexpr size_t AR_Q = 0, AR_K = 32 * MiB, AR_V = 64 * MiB, AR_XB = 96 * MiB, AR_GATE = 128 * MiB, AR_AR = 160 * MiB;
constexpr size_t AR_V2TMP = 224 * MiB;
constexpr size_t AR_Q2 = 0, AR_P = 64 * MiB, AR_O = 128 * MiB;
constexpr size_t AR_H = 0, AR_Y = 64 * MiB;
constexpr size_t AR_U = 0, AR_V3 = 128 * MiB;
constexpr size_t MISC_MEMSTAT = 0, MISC_K2STAT = 65536;

struct Args { const float* in[36]; float* out; unsigned char* ws; int ph_lo, ph_hi; };
enum { I_X = 0, I_MEM, I_NMIX, I_NCROSS, I_NMEM, I_NFFN, I_ABWIN, I_FBIAS, I_AQG, I_AKG, I_CONVW, I_CONVB, I_WA, I_BA, I_WX, I_BX, I_LAM, I_ABWOUT,
       I_CWIN, I_CBIN, I_CVG, I_CWS, I_CBS, I_CWOUT, I_XWQ, I_XWKV, I_XWO, I_XQG, I_XKG, I_MWG, I_MBG, I_MWE, I_MBE, I_MGATE, I_MUP, I_MDOWN };

__device__ __forceinline__ float bf_lo(unsigned u) { return __uint_as_float(u << 16); }
__device__ __forceinline__ float bf_hi(unsigned u) { return __uint_as_float(u & 0xffff0000u); }
__device__ __forceinline__ float bf2f(bf16_t v) { return __uint_as_float((unsigned)v << 16); }
__device__ __forceinline__ unsigned pk2(float lo, float hi) { typedef __bf16 bf2_t __attribute__((ext_vector_type(2))); f32x2 v = {lo, hi}; bf2_t b = __builtin_convertvector(v, bf2_t); return __builtin_bit_cast(unsigned, b); }
__device__ __forceinline__ bf16_t f2bf(float f) { return (bf16_t)(pk2(f, 0.f) & 0xffffu); }
__device__ __forceinline__ float wave_sum(float v) {
#pragma unroll
    for (int o = 1; o < 64; o <<= 1) v += __shfl_xor(v, o);
    return v;
}
__device__ __forceinline__ float frcp(float x) { return __builtin_amdgcn_rcpf(x); }
__device__ __forceinline__ float frsq(float x) { return __builtin_amdgcn_rsqf(x); }
__device__ __forceinline__ float fexp2(float x) { return __builtin_amdgcn_exp2f(x); }
__device__ __forceinline__ float gelu_tanh(float x) { const float t = x * x; const float y = x * (-0.10294324f * t + -2.3022082f); return x * frcp(1.f + fexp2(y)); }
__device__ __forceinline__ float sigmoidf(float x) { return frcp(1.f + fexp2(-LOG2E * x)); }
__device__ __forceinline__ float rowscale16(const float* stat, int row, int fq, float invn) { const f32x4 a = *(const f32x4*)(stat + (size_t)row * 16 + 4 * fq); float t = (a.x + a.y) + (a.z + a.w); t += __shfl_xor(t, 16); t += __shfl_xor(t, 32); return frsq(t * invn + EPS); }
__device__ __forceinline__ float sum16(const float* p) { const f32x4 a = *(const f32x4*)p, b = *(const f32x4*)(p + 4), c = *(const f32x4*)(p + 8), d = *(const f32x4*)(p + 12);
    return ((a.x + a.y) + (a.z + a.w)) + ((b.x + b.y) + (b.z + b.w)) + ((c.x + c.y) + (c.z + c.w)) + ((d.x + d.y) + (d.z + d.w)); }
__device__ __forceinline__ int perm32(int rho) { const int n = rho >> 4, i = rho & 15; return 8 * (i >> 2) + 4 * n + (i & 3); }

struct U { int pm, pn, e, cnt; };
__device__ __forceinline__ int brow_std(int bj, int S) { return 64 * (S >> 5) + 32 * bj + perm32(S & 31); }
typedef f32x4 Acc[2][2][4][2];

template <class P> __device__ __forceinline__ void gemm_naive(const P& p) {
    const int tid = threadIdx.x, wid = tid >> 6, lane = tid & 63, wr = wid >> 2, wc = wid & 3, fr = lane & 15, fq = lane >> 4;
    for (int i = 0;; ++i) {
        U u; if (!p.unit(i * (int)gridDim.x + (int)blockIdx.x, u)) break;
        Acc acc;
#pragma unroll
        for (int a = 0; a < 2; ++a)
#pragma unroll
            for (int b = 0; b < 2; ++b)
#pragma unroll
                for (int m = 0; m < 4; ++m)
#pragma unroll
                    for (int n = 0; n < 2; ++n) acc[a][b][m][n] = (f32x4){0.f, 0.f, 0.f, 0.f};
        const bf16_t* A = p.a_ptr(u); const bf16_t* B = p.b_ptr(u); const int lda = p.lda, ldb = p.ldb, K = p.K;
        unsigned aoff[8], boff[16];
#pragma unroll
        for (int ai = 0; ai < 2; ++ai)
#pragma unroll
            for (int m = 0; m < 4; ++m) aoff[ai * 4 + m] = (unsigned)p.a_row(u, 128 * ai + 64 * wr + 16 * m + fr) * (unsigned)lda;
#pragma unroll
        for (int bj = 0; bj < 2; ++bj)
#pragma unroll
            for (int n = 0; n < 2; ++n)
#pragma unroll
                for (int e = 0; e < 4; ++e) boff[bj * 8 + n * 4 + e] = (unsigned)P::b_row(bj, 32 * wc + 16 * n + 4 * fq + e) * (unsigned)ldb;
        for (int k0 = 0; k0 < K; k0 += 2) {
            float af[8][2];
#pragma unroll
            for (int r = 0; r < 8; ++r) { const unsigned v = *(const unsigned*)(A + aoff[r] + k0); af[r][0] = bf_lo(v); af[r][1] = bf_hi(v); }
#pragma unroll
            for (int bj = 0; bj < 2; ++bj)
#pragma unroll
                for (int n = 0; n < 2; ++n)
#pragma unroll
                    for (int e = 0; e < 4; ++e) {
                        const unsigned v = *(const unsigned*)(B + boff[bj * 8 + n * 4 + e] + k0);
                        const float b0 = bf_lo(v), b1 = bf_hi(v);
#pragma unroll
                        for (int ai = 0; ai < 2; ++ai)
#pragma unroll
                            for (int m = 0; m < 4; ++m) { const float* x = af[ai * 4 + m]; acc[ai][bj][m][n][e] += x[0] * b0 + x[1] * b1; }
                    }
        }
        p.epi(acc, u, wr, wc, fr, fq);
    }
}

__device__ __forceinline__ int xcd_remap(int L, int nwg) { const int q = nwg >> 3, r = nwg & 7, xcd = L & 7, off = L >> 3; return (xcd < r ? xcd * (q + 1) : r * (q + 1) + (xcd - r) * q) + off; }
struct PlainSched {
    int nM, nN;
    __device__ __forceinline__ bool unit(int L, U& u) const {
        const int nwg = nM * nN; if (L >= nwg) return false;
        const int wgid = xcd_remap(L, nwg);
        const int nig = 8 * nN, gid = wgid / nig, fm = gid * 8, gsz = (nM - fm) < 8 ? (nM - fm) : 8, w = wgid - gid * nig;
        u.pn = w / gsz; u.pm = fm + (w - u.pn * gsz); u.e = 0; u.cnt = 0; return true;
    }
};

struct PInProj0 : PlainSched {
    static constexpr bool GATHER = false; static constexpr int ID = 0;
    const bf16_t* X; const bf16_t* W; const float* xstat; const float* qg; const float* kg; bf16_t *Q, *Kq, *V, *XB, *GATE; int lda, ldb, K;
    __device__ __forceinline__ const bf16_t* a_ptr(const U& u) const { return X + (size_t)u.pm * 256 * D; }
    __device__ __forceinline__ int a_row(const U&, int R) const { return R; }
    __device__ __forceinline__ const bf16_t* b_ptr(const U& u) const { return W + (size_t)u.pn * 256 * D; }
    static __device__ __forceinline__ int b_row(int bj, int S) { return brow_std(bj, S); }
    __device__ __forceinline__ void epi(Acc& acc, const U& u, int wr, int wc, int fr, int fq) const {
        const int kind = u.pn >> 1, half = u.pn & 1;
        bf16_t* dst = kind == 0 ? Q : kind == 1 ? Kq : kind == 2 ? V : kind == 3 ? XB : GATE;
        const float* gain = kind == 0 ? qg : kg;
        float sc[8];
#pragma unroll
        for (int ai = 0; ai < 2; ++ai)
#pragma unroll
            for (int m = 0; m < 4; ++m) {
                const int row = u.pm * 256 + 128 * ai + 64 * wr + 16 * m + fr;
                const float s = rowscale16(xstat, row, fq, 1.f / D);
                float r = s;
                if (kind <= 1) {
                    float ss = 0.f;
#pragma unroll
                    for (int bj = 0; bj < 2; ++bj)
#pragma unroll
                        for (int n = 0; n < 2; ++n)
#pragma unroll
                            for (int e = 0; e < 4; ++e) { const float v = acc[ai][bj][m][n][e] * s; ss += v * v; }
                    ss += __shfl_xor(ss, 16); ss += __shfl_xor(ss, 32);
                    r = s * frsq(ss * (1.f / HD) + EPS) * (kind == 0 ? C2 : 1.f);
                }
                sc[ai * 4 + m] = r;
            }
#pragma unroll
        for (int bj = 0; bj < 2; ++bj) {
            float g[8];
#pragma unroll
            for (int j = 0; j < 8; ++j) g[j] = kind <= 1 ? gain[32 * bj + 8 * fq + j] : 1.f;
#pragma unroll
            for (int ai = 0; ai < 2; ++ai)
#pragma unroll
                for (int m = 0; m < 4; ++m) {
                    const int row = u.pm * 256 + 128 * ai + 64 * wr + 16 * m + fr;
                    float v[8];
#pragma unroll
                    for (int j = 0; j < 8; ++j) v[j] = acc[ai][bj][m][j >> 2][j & 3] * sc[ai * 4 + m] * g[j];
                    if (kind == 4) {
#pragma unroll
                        for (int j = 0; j < 8; ++j) v[j] = gelu_tanh(v[j]);
                    }
                    u32x4 w; w.x = pk2(v[0], v[1]); w.y = pk2(v[2], v[3]); w.z = pk2(v[4], v[5]); w.w = pk2(v[6], v[7]);
                    *(u32x4*)(dst + (size_t)row * 512 + 256 * half + 64 * wc + 32 * bj + 8 * fq) = w;
                }
        }
    }
};

struct PMemKV : PlainSched {
    static constexpr bool GATHER = false; static constexpr int ID = 1;
    const bf16_t* A; const bf16_t* W; const float* memstat; float* k2stat_; bf16_t* K2_; bf16_t* V2T_; int lda, ldb, K;
    __device__ __forceinline__ const bf16_t* a_ptr(const U& u) const { return A + (size_t)u.pm * 256 * D; }
    __device__ __forceinline__ int a_row(const U&, int R) const { return R; }
    __device__ __forceinline__ const bf16_t* b_ptr(const U& u) const { return W + (size_t)u.pn * 256 * D; }
    static __device__ __forceinline__ int b_row(int bj, int S) { return brow_std(bj, S); }
    __device__ __forceinline__ void epi(Acc& acc, const U& u, int wr, int wc, int fr, int fq) const {
        const int b = u.pm, h = u.pn & 3, ly = u.pn >> 3; const bool isv = (u.pn & 4) != 0;
        float* k2stat = k2stat_ + (size_t)ly * 2048 * 16; bf16_t* K2 = K2_ + (size_t)ly * 2048 * 1024; bf16_t* V2T = V2T_ + (size_t)ly * 2048 * 1024;
        bf16_t* dst = (isv ? V2T : K2) + (size_t)(b * 4 + h) * 65536;
        int lrow = 64 * wr + fr; asm volatile("" : "+v"(lrow));
#pragma unroll
        for (int ai = 0; ai < 2; ++ai)
#pragma unroll
            for (int m = 0; m < 4; ++m) {
                const int key = 128 * ai + 16 * m + lrow, row = b * 256 + key;
                const float s = frsq(memstat[row] * (1.f / D) + EPS);
                float ss = 0.f;
#pragma unroll
                for (int bj = 0; bj < 2; ++bj) {
                    float v[8];
#pragma unroll
                    for (int j = 0; j < 8; ++j) { v[j] = acc[ai][bj][m][j >> 2][j & 3] * s; ss += v[j] * v[j]; }
                    u32x4 w; w.x = pk2(v[0], v[1]); w.y = pk2(v[2], v[3]); w.z = pk2(v[4], v[5]); w.w = pk2(v[6], v[7]);
                    *(u32x4*)(dst + (size_t)key * 256 + 64 * wc + 32 * bj + 8 * fq) = w;
                }
                ss += __shfl_xor(ss, 16); ss += __shfl_xor(ss, 32);
                if (fq == 0 && !isv) k2stat[(size_t)row * 16 + 4 * h + wc] = ss;
            }
    }
};

struct PResid : PlainSched {
    static constexpr bool GATHER = false; static constexpr int ID = 2;
    const bf16_t* A; const bf16_t* W; bf16_t* X; float* xstat; int lda, ldb, K;
    __device__ __forceinline__ const bf16_t* a_ptr(const U& u) const { return A + (size_t)u.pm * 256 * lda; }
    __device__ __forceinline__ int a_row(const U&, int R) const { return R; }
    __device__ __forceinline__ const bf16_t* b_ptr(const U& u) const { return W + (size_t)u.pn * 256 * ldb; }
    static __device__ __forceinline__ int b_row(int bj, int S) { return brow_std(bj, S); }
    __device__ __forceinline__ void epi(Acc& acc, const U& u, int wr, int wc, int fr, int fq) const {
#pragma unroll
        for (int ai = 0; ai < 2; ++ai)
#pragma unroll
            for (int m = 0; m < 4; ++m) {
                const int row = u.pm * 256 + 128 * ai + 64 * wr + 16 * m + fr; float ss = 0.f;
#pragma unroll
                for (int bj = 0; bj < 2; ++bj) {
                    bf16_t* xp = X + (size_t)row * D + 256 * u.pn + 64 * wc + 32 * bj + 8 * fq;
                    const u32x4 o = *(const u32x4*)xp;
                    float v[8] = {bf_lo(o.x), bf_hi(o.x), bf_lo(o.y), bf_hi(o.y), bf_lo(o.z), bf_hi(o.z), bf_lo(o.w), bf_hi(o.w)};
#pragma unroll
                    for (int n = 0; n < 2; ++n)
#pragma unroll
                        for (int e = 0; e < 4; ++e) v[n * 4 + e] += acc[ai][bj][m][n][e];
                    u32x4 w; w.x = pk2(v[0], v[1]); w.y = pk2(v[2], v[3]); w.z = pk2(v[4], v[5]); w.w = pk2(v[6], v[7]);
                    *(u32x4*)xp = w;
                    const float r[8] = {bf_lo(w.x), bf_hi(w.x), bf_lo(w.y), bf_hi(w.y), bf_lo(w.z), bf_hi(w.z), bf_lo(w.w), bf_hi(w.w)};
#pragma unroll
                    for (int j = 0; j < 8; ++j) ss += r[j] * r[j];
                }
                ss += __shfl_xor(ss, 16); ss += __shfl_xor(ss, 32);
                if (fq == 0) xstat[(size_t)row * 16 + 4 * u.pn + wc] = ss;
            }
    }
};

struct PCrossQ : PlainSched {
    static constexpr bool GATHER = false; static constexpr int ID = 3;
    const bf16_t* X; const bf16_t* W; const float* xstat; bf16_t* Q2; float* qstat; int lda, ldb, K;
    __device__ __forceinline__ const bf16_t* a_ptr(const U& u) const { return X + (size_t)u.pm * 256 * D; }
    __device__ __forceinline__ int a_row(const U&, int R) const { return R; }
    __device__ __forceinline__ const bf16_t* b_ptr(const U& u) const { return W + (size_t)u.pn * 256 * D; }
    static __device__ __forceinline__ int b_row(int bj, int S) { return brow_std(bj, S); }
    __device__ __forceinline__ void epi(Acc& acc, const U& u, int wr, int wc, int fr, int fq) const {
#pragma unroll
        for (int ai = 0; ai < 2; ++ai)
#pragma unroll
            for (int m = 0; m < 4; ++m) {
                const int row = u.pm * 256 + 128 * ai + 64 * wr + 16 * m + fr; float ss = 0.f;
                const float s = rowscale16(xstat, row, fq, 1.f / D);
#pragma unroll
                for (int bj = 0; bj < 2; ++bj) {
                    float v[8];
#pragma unroll
                    for (int n = 0; n < 2; ++n)
#pragma unroll
                        for (int e = 0; e < 4; ++e) v[n * 4 + e] = acc[ai][bj][m][n][e] * s;
                    u32x4 w; w.x = pk2(v[0], v[1]); w.y = pk2(v[2], v[3]); w.z = pk2(v[4], v[5]); w.w = pk2(v[6], v[7]);
                    *(u32x4*)(Q2 + (size_t)row * D + 256 * u.pn + 64 * wc + 32 * bj + 8 * fq) = w;
                    const float r[8] = {bf_lo(w.x), bf_hi(w.x), bf_lo(w.y), bf_hi(w.y), bf_lo(w.z), bf_hi(w.z), bf_lo(w.w), bf_hi(w.w)};
#pragma unroll
                    for (int j = 0; j < 8; ++j) ss += r[j] * r[j];
                }
                ss += __shfl_xor(ss, 16); ss += __shfl_xor(ss, 32);
                if (fq == 0) qstat[(size_t)row * 16 + 4 * u.pn + wc] = ss;
            }
    }
};

struct PCrossS : PlainSched {
    static constexpr bool GATHER = false; static constexpr int ID = 4;
    const bf16_t* Q2; const bf16_t* K2; const float* qstat; bf16_t* P; float* psum; int lda, ldb, K;
    __device__ __forceinline__ const bf16_t* a_ptr(const U& u) const { return Q2 + (size_t)u.pm * 256 * D + 256 * u.pn; }
    __device__ __forceinline__ int a_row(const U&, int R) const { return R; }
    __device__ __forceinline__ const bf16_t* b_ptr(const U& u) const { return K2 + (size_t)((u.pm >> 4) * 4 + u.pn) * 65536; }
    static __device__ __forceinline__ int b_row(int bj, int S) { return brow_std(bj, S); }
    __device__ __forceinline__ void epi(Acc& acc, const U& u, int wr, int wc, int fr, int fq) const {
#pragma unroll
        for (int ai = 0; ai < 2; ++ai)
#pragma unroll
            for (int m = 0; m < 4; ++m) {
                const int row = u.pm * 256 + 128 * ai + 64 * wr + 16 * m + fr; float ss = 0.f;
                const f32x4 qs = *(const f32x4*)(qstat + (size_t)row * 16 + 4 * u.pn);
                const float rn = frsq(((qs.x + qs.y) + (qs.z + qs.w)) * (1.f / XHD) + EPS) * C3;
#pragma unroll
                for (int bj = 0; bj < 2; ++bj) {
                    float v[8];
#pragma unroll
                    for (int n = 0; n < 2; ++n)
#pragma unroll
                        for (int e = 0; e < 4; ++e) v[n * 4 + e] = fexp2(acc[ai][bj][m][n][e] * rn);
                    u32x4 w; w.x = pk2(v[0], v[1]); w.y = pk2(v[2], v[3]); w.z = pk2(v[4], v[5]); w.w = pk2(v[6], v[7]);
                    *(u32x4*)(P + (size_t)row * D + 256 * u.pn + 64 * wc + 32 * bj + 8 * fq) = w;
                    const float r[8] = {bf_lo(w.x), bf_hi(w.x), bf_lo(w.y), bf_hi(w.y), bf_lo(w.z), bf_hi(w.z), bf_lo(w.w), bf_hi(w.w)};
#pragma unroll
                    for (int j = 0; j < 8; ++j) ss += r[j];
                }
                ss += __shfl_xor(ss, 16); ss += __shfl_xor(ss, 32);
                if (fq == 0) psum[(size_t)row * 16 + 4 * u.pn + wc] = ss;
            }
    }
};

struct PCrossPV : PlainSched {
    static constexpr bool GATHER = false; static constexpr int ID = 5;
    const bf16_t* P; const bf16_t* V2T; const float* psum; bf16_t* O; int lda, ldb, K;
    __device__ __forceinline__ const bf16_t* a_ptr(const U& u) const { return P + (size_t)u.pm * 256 * D + 256 * u.pn; }
    __device__ __forceinline__ int a_row(const U&, int R) const { return R; }
    __device__ __forceinline__ const bf16_t* b_ptr(const U& u) const { return V2T + (size_t)((u.pm >> 4) * 4 + u.pn) * 65536; }
    static __device__ __forceinline__ int b_row(int bj, int S) { return brow_std(bj, S); }
    __device__ __forceinline__ void epi(Acc& acc, const U& u, int wr, int wc, int fr, int fq) const {
#pragma unroll
        for (int ai = 0; ai < 2; ++ai)
#pragma unroll
            for (int m = 0; m < 4; ++m) {
                const int row = u.pm * 256 + 128 * ai + 64 * wr + 16 * m + fr;
                const f32x4 ps = *(const f32x4*)(psum + (size_t)row * 16 + 4 * u.pn);
                const float inv = frcp((ps.x + ps.y) + (ps.z + ps.w));
#pragma unroll
                for (int bj = 0; bj < 2; ++bj) {
                    float v[8];
#pragma unroll
                    for (int n = 0; n < 2; ++n)
#pragma unroll
                        for (int e = 0; e < 4; ++e) v[n * 4 + e] = acc[ai][bj][m][n][e] * inv;
                    u32x4 w; w.x = pk2(v[0], v[1]); w.y = pk2(v[2], v[3]); w.z = pk2(v[4], v[5]); w.w = pk2(v[6], v[7]);
                    *(u32x4*)(O + (size_t)row * D + 256 * u.pn + 64 * wc + 32 * bj + 8 * fq) = w;
                }
            }
    }
};

struct PRouter : PlainSched {
    static constexpr bool GATHER = false; static constexpr int ID = 6;
    const bf16_t* X; const bf16_t* W; const float* xstat; const float* bg; const float* be; float* rlog; int lda, ldb, K;
    __device__ __forceinline__ const bf16_t* a_ptr(const U& u) const { return X + (size_t)u.pm * 256 * D; }
    __device__ __forceinline__ int a_row(const U&, int R) const { return R; }
    __device__ __forceinline__ const bf16_t* b_ptr(const U&) const { return W; }
    static __device__ __forceinline__ int b_row(int bj, int S) { return brow_std(bj, S); }
    __device__ __forceinline__ void epi(Acc& acc, const U& u, int wr, int wc, int fr, int fq) const {
        if (wc != 0) return;
#pragma unroll
        for (int ai = 0; ai < 2; ++ai)
#pragma unroll
            for (int m = 0; m < 4; ++m) {
                const int row = u.pm * 256 + 128 * ai + 64 * wr + 16 * m + fr;
                const float s = rowscale16(xstat, row, fq, 1.f / D);
#pragma unroll
                for (int n = 0; n < 2; ++n)
#pragma unroll
                    for (int e = 0; e < 4; ++e) { const int c = 8 * fq + 4 * n + e; rlog[(size_t)row * 40 + c] = acc[ai][0][m][n][e] * s + (c < 4 ? bg[c] : be[c - 4]); }
                if (fq == 0) {
#pragma unroll
                    for (int e = 0; e < 4; ++e) rlog[(size_t)row * 40 + 32 + e] = acc[ai][1][m][0][e] * s + be[28 + e];
                }
            }
    }
};

struct MoeSched {
    const int* cnt; const int* list; volatile LAS int* tpre;
    __device__ __forceinline__ bool unit(int L, U& u) const {
        const int nwg = tpre[32] * 4; if (L >= nwg) return false;
        L = xcd_remap(L, nwg);
        const int mt = L >> 2;
        int e = 0;
        for (int j = 1; j < 32; ++j) e = (mt >= tpre[j]) ? j : e;
        u.e = e; u.pm = mt - tpre[e]; u.pn = L & 3; u.cnt = cnt[e]; return true;
    }
    __device__ __forceinline__ int pair_of(const U& u, int R) const { int s = u.pm * 256 + R; s = s < u.cnt ? s : u.cnt - 1; return list[(size_t)u.e * 65536 + s]; }
};
__device__ __forceinline__ void moe_sched_build(const int* cnt, volatile LAS int* tpre) {
    __syncthreads();
    if (threadIdx.x == 0) { int acc = 0; for (int e = 0; e < 32; ++e) { tpre[e] = acc; acc += (cnt[e] + 255) >> 8; } tpre[32] = acc; }
    __syncthreads();
}
struct PMoeUp : MoeSched {
    static constexpr bool GATHER = true; static constexpr int ID = 7;
    const bf16_t* X; const bf16_t* W; const float* xstat; bf16_t* H; int lda, ldb, K;
    __device__ __forceinline__ const bf16_t* a_ptr(const U&) const { return X; }
    __device__ __forceinline__ int a_row(const U& u, int R) const { return pair_of(u, R) >> 1; }
    __device__ __forceinline__ const bf16_t* b_ptr(const U& u) const { return W + (size_t)u.e * (1024 * 1024) + (size_t)u.pn * 128 * 1024; }
    static __device__ __forceinline__ int b_row(int bj, int S) { return 512 * bj + 32 * (S >> 5) + perm32(S & 31); }
    __device__ __forceinline__ void epi(Acc& acc, const U& u, int wr, int wc, int fr, int fq) const {
#pragma unroll
        for (int ai = 0; ai < 2; ++ai)
#pragma unroll
            for (int m = 0; m < 4; ++m) {
                const int pr = pair_of(u, 128 * ai + 64 * wr + 16 * m + fr), tok = pr >> 1;
                const float s = frsq(sum16(xstat + (size_t)tok * 16) * (1.f / D) + EPS);
                float v[8];
#pragma unroll
                for (int n = 0; n < 2; ++n)
#pragma unroll
                    for (int e = 0; e < 4; ++e) { const float g = acc[ai][0][m][n][e] * s, up = acc[ai][1][m][n][e] * s; v[n * 4 + e] = g * frcp(1.f + fexp2(-LOG2E * g)) * up; }
                u32x4 w; w.x = pk2(v[0], v[1]); w.y = pk2(v[2], v[3]); w.z = pk2(v[4], v[5]); w.w = pk2(v[6], v[7]);
                *(u32x4*)(H + (size_t)pr * DEXP + 128 * u.pn + 32 * wc + 8 * fq) = w;
            }
    }
};
struct PMoeDown : MoeSched {
    static constexpr bool GATHER = true; static constexpr int ID = 8;
    const bf16_t* H; const bf16_t* W; const float* pairw; bf16_t* Y; int lda, ldb, K;
    __device__ __forceinline__ const bf16_t* a_ptr(const U&) const { return H; }
    __device__ __forceinline__ int a_row(const U& u, int R) const { return pair_of(u, R); }
    __device__ __forceinline__ const bf16_t* b_ptr(const U& u) const { return W + (size_t)u.e * (1024 * 512) + (size_t)u.pn * 256 * 512; }
    static __device__ __forceinline__ int b_row(int bj, int S) { return brow_std(bj, S); }
    __device__ __forceinline__ void epi(Acc& acc, const U& u, int wr, int wc, int fr, int fq) const {
#pragma unroll
        for (int ai = 0; ai < 2; ++ai)
#pragma unroll
            for (int m = 0; m < 4; ++m) {
                const int pr = pair_of(u, 128 * ai + 64 * wr + 16 * m + fr); const float wgt = pairw[pr];
#pragma unroll
                for (int bj = 0; bj < 2; ++bj) {
                    float v[8];
#pragma unroll
                    for (int n = 0; n < 2; ++n)
#pragma unroll
                        for (int e = 0; e < 4; ++e) v[n * 4 + e] = acc[ai][bj][m][n][e] * wgt;
                    u32x4 w; w.x = pk2(v[0], v[1]); w.y = pk2(v[2], v[3]); w.z = pk2(v[4], v[5]); w.w = pk2(v[6], v[7]);
                    *(u32x4*)(Y + (size_t)pr * D + 256 * u.pn + 64 * wc + 32 * bj + 8 * fq) = w;
                }
            }
    }
};
struct PInProj1 : PlainSched {
    static constexpr bool GATHER = false; static constexpr int ID = 9;
    const bf16_t* X; const bf16_t* W; const float* xstat; const float* bias; bf16_t* Ub; bf16_t* V3; float* vstat; int lda, ldb, K;
    __device__ __forceinline__ const bf16_t* a_ptr(const U& u) const { return X + (size_t)u.pm * 256 * D; }
    __device__ __forceinline__ int a_row(const U&, int R) const { return R; }
    __device__ __forceinline__ const bf16_t* b_ptr(const U& u) const { return W + (size_t)u.pn * 256 * D; }
    static __device__ __forceinline__ int b_row(int bj, int S) { return brow_std(bj, S); }
    __device__ __forceinline__ void epi(Acc& acc, const U& u, int wr, int wc, int fr, int fq) const {
        const bool isv = u.pn >= 8; const int pn8 = u.pn & 7; bf16_t* dst = isv ? V3 : Ub;
#pragma unroll
        for (int ai = 0; ai < 2; ++ai)
#pragma unroll
            for (int m = 0; m < 4; ++m) {
                const int row = u.pm * 256 + 128 * ai + 64 * wr + 16 * m + fr; float ss = 0.f;
                const float s = rowscale16(xstat, row, fq, 1.f / D);
#pragma unroll
                for (int bj = 0; bj < 2; ++bj) {
                    const int lc = 64 * wc + 32 * bj + 8 * fq;
                    const f32x4 b0 = *(const f32x4*)(bias + 256 * u.pn + lc), b1 = *(const f32x4*)(bias + 256 * u.pn + lc + 4);
                    float v[8];
#pragma unroll
                    for (int e = 0; e < 4; ++e) { v[e] = gelu_tanh(acc[ai][bj][m][0][e] * s + b0[e]); v[4 + e] = gelu_tanh(acc[ai][bj][m][1][e] * s + b1[e]); }
                    u32x4 w; w.x = pk2(v[0], v[1]); w.y = pk2(v[2], v[3]); w.z = pk2(v[4], v[5]); w.w = pk2(v[6], v[7]);
                    *(u32x4*)(dst + (size_t)row * CW + 256 * pn8 + lc) = w;
                    const float r[8] = {bf_lo(w.x), bf_hi(w.x), bf_lo(w.y), bf_hi(w.y), bf_lo(w.z), bf_hi(w.z), bf_lo(w.w), bf_hi(w.w)};
#pragma unroll
                    for (int j = 0; j < 8; ++j) ss += r[j] * r[j];
                }
                if (isv) { ss += __shfl_xor(ss, 16); ss += __shfl_xor(ss, 32); if (fq == 0) vstat[(size_t)row * 32 + 4 * pn8 + wc] = ss; }
            }
    }
};

__device__ __forceinline__ int lds_byte(int r, int c) { const int st = (r >> 4) * 2 + (c >> 5), rr = r & 15, cc = c & 31, ob = rr * 64 + cc * 2; return st * 1024 + (ob ^ (((ob >> 9) & 1) << 5)); }
__device__ __forceinline__ void stage_rc(int b, int& R, int& C) { const int st = b / 1024, sb = b % 1024, swz = sb ^ (((sb >> 9) & 1) << 5); R = (st >> 1) * 16 + swz / 64; C = (st & 1) * 32 + (swz % 64) / 2; }

template <class P> __device__ __forceinline__ void gemm_fast(LAS unsigned char* lds, const P& p) {
    constexpr int HTB = 16384;
    const int tid = threadIdx.x, wid = __builtin_amdgcn_readfirstlane(tid >> 6), lane = tid & 63, wr = wid >> 2, wc = wid & 3, fr = lane & 15, fq = lane >> 4;
    const int K = p.K, nt = K / 64, lda = p.lda, ldb = p.ldb;
    const int G = (int)gridDim.x, cu = (int)blockIdx.x;
    int Rs[2], Cs[2];
#pragma unroll
    for (int i = 0; i < 2; ++i) stage_rc(tid * 16 + i * 8192, Rs[i], Cs[i]);
    unsigned boffs[4];
#pragma unroll
    for (int bj = 0; bj < 2; ++bj)
#pragma unroll
        for (int i = 0; i < 2; ++i) boffs[bj * 2 + i] = (unsigned)(P::b_row(bj, Rs[i]) * ldb + Cs[i]) * 2u;
    const unsigned ldsw = (unsigned)wid * 1024u;
    const int aoff_l = lds_byte(wr * 64 + fr, fq * 8), boff_l = lds_byte(wc * 32 + fr, fq * 8);
#define GF_SA(b, h) (((b) * 2 + (h)) * HTB)
#define GF_SB(b, h) ((4 + (b) * 2 + (h)) * HTB)
#define GF_STAGE(bufoff, gbase, o0, o1) do { \
        __builtin_amdgcn_global_load_lds((const unsigned*)((const char*)(gbase) + (o0)), (LAS unsigned*)(lds + (bufoff) + ldsw), 16, 0, 0); \
        __builtin_amdgcn_global_load_lds((const unsigned*)((const char*)(gbase) + (o1)), (LAS unsigned*)(lds + (bufoff) + ldsw + 8192), 16, 0, 0); } while (0)
#define GF_LDA(dst, b, h) do { _Pragma("unroll") for (int m = 0; m < 4; ++m) _Pragma("unroll") for (int k = 0; k < 2; ++k) dst[m][k] = *(const LAS bf16x8*)(lds + GF_SA(b, h) + aoff_l + m * 2048 + k * 1024); } while (0)
#define GF_LDB(dst, b, h) do { _Pragma("unroll") for (int n = 0; n < 2; ++n) _Pragma("unroll") for (int k = 0; k < 2; ++k) dst[n][k] = *(const LAS bf16x8*)(lds + GF_SB(b, h) + boff_l + n * 2048 + k * 1024); } while (0)
#define GF_MMA(ai, bj, At, Bt) do { __builtin_amdgcn_s_setprio(1); _Pragma("unroll") for (int m = 0; m < 4; ++m) _Pragma("unroll") for (int n = 0; n < 2; ++n) _Pragma("unroll") for (int k = 0; k < 2; ++k) \
        acc[ai][bj][m][n] = __builtin_amdgcn_mfma_f32_16x16x32_bf16(Bt[n][k], At[m][k], acc[ai][bj][m][n], 0, 0, 0); __builtin_amdgcn_s_setprio(0); } while (0)
#define GF_WAIT_V(n) asm volatile("s_waitcnt vmcnt(" #n ")" ::: "memory")
#define GF_WAIT_L(n) asm volatile("s_waitcnt lgkmcnt(" #n ")" ::: "memory")
#define GF_BAR __builtin_amdgcn_s_barrier()
#define GF_SCHED __builtin_amdgcn_sched_barrier(0)
#define GF_AOFFS(dst, u) do { _Pragma("unroll") for (int h = 0; h < 2; ++h) _Pragma("unroll") for (int i = 0; i < 2; ++i) dst[h * 2 + i] = (unsigned)(p.a_row(u, 128 * h + Rs[i]) * lda + Cs[i]) * 2u; } while (0)
    U cur, nxt; int ui = 0;
    if (!p.unit(cu, cur)) return;
    Acc acc;
#pragma unroll
    for (int a = 0; a < 2; ++a)
#pragma unroll
        for (int b = 0; b < 2; ++b)
#pragma unroll
            for (int m = 0; m < 4; ++m)
#pragma unroll
                for (int n = 0; n < 2; ++n) acc[a][b][m][n] = (f32x4){0.f, 0.f, 0.f, 0.f};
    bf16x8 At[4][2], B0[2][2], B1[2][2];
    unsigned aoffs[4], naoffs[4];
    GF_AOFFS(aoffs, cur);
    const char* cA = (const char*)p.a_ptr(cur); const char* cB = (const char*)p.b_ptr(cur);
    GF_STAGE(GF_SB(0, 0), cB, boffs[0], boffs[1]); GF_STAGE(GF_SB(0, 1), cB, boffs[2], boffs[3]); GF_STAGE(GF_SA(0, 0), cA, aoffs[0], aoffs[1]); GF_STAGE(GF_SA(0, 1), cA, aoffs[2], aoffs[3]);
    if (wr == 1) GF_BAR;
    GF_WAIT_V(2); GF_BAR;
    GF_STAGE(GF_SB(1, 0), cB + 128, boffs[0], boffs[1]); GF_STAGE(GF_SA(1, 0), cA + 128, aoffs[0], aoffs[1]); GF_STAGE(GF_SB(1, 1), cB + 128, boffs[2], boffs[3]);
    GF_WAIT_V(6); GF_BAR;
    for (;;) {
        const bool has_next = p.unit((ui + 1) * G + cu, nxt);
        const char* nA = cA; const char* nB = cB;
#pragma unroll
        for (int j = 0; j < 4; ++j) naoffs[j] = aoffs[j];
        if (has_next) { nA = (const char*)p.a_ptr(nxt); nB = (const char*)p.b_ptr(nxt); if (P::GATHER) GF_AOFFS(naoffs, nxt); }
        for (int t = 0; t < nt; t += 2) {
            const bool last = (t == nt - 2);
            const char* a1 = cA + (size_t)(t + 1) * 128;
            const char* a2 = last ? nA : cA + (size_t)(t + 2) * 128; const char* b2 = last ? nB : cB + (size_t)(t + 2) * 128;
            const char* a3 = a2 + 128; const char* b3 = b2 + 128;
            unsigned o[4];
#pragma unroll
            for (int j = 0; j < 4; ++j) o[j] = (P::GATHER && last) ? naoffs[j] : aoffs[j];
            GF_LDB(B0, 0, 0); GF_LDB(B1, 0, 1); GF_SCHED; GF_LDA(At, 0, 0); GF_STAGE(GF_SA(1, 1), a1, aoffs[2], aoffs[3]);
            GF_WAIT_V(8); GF_WAIT_L(0); GF_BAR; GF_MMA(0, 0, At, B0); GF_MMA(0, 1, At, B1); GF_BAR; GF_SCHED;
            GF_LDA(At, 0, 1); GF_STAGE(GF_SB(0, 0), b2, boffs[0], boffs[1]); GF_STAGE(GF_SB(0, 1), b2, boffs[2], boffs[3]); GF_STAGE(GF_SA(0, 0), a2, o[0], o[1]);
            GF_WAIT_V(8); GF_WAIT_L(0); GF_BAR; GF_MMA(1, 0, At, B0); GF_MMA(1, 1, At, B1); GF_BAR; GF_SCHED;
            GF_LDB(B0, 1, 0); GF_LDB(B1, 1, 1); GF_SCHED; GF_LDA(At, 1, 0); GF_STAGE(GF_SA(0, 1), a2, o[2], o[3]);
            GF_WAIT_V(8); GF_WAIT_L(0); GF_BAR; GF_MMA(0, 0, At, B0); GF_MMA(0, 1, At, B1); GF_BAR; GF_SCHED;
            GF_LDA(At, 1, 1); GF_STAGE(GF_SB(1, 0), b3, boffs[0], boffs[1]); GF_STAGE(GF_SB(1, 1), b3, boffs[2], boffs[3]); GF_STAGE(GF_SA(1, 0), a3, o[0], o[1]);
            GF_WAIT_V(8); GF_WAIT_L(0); GF_BAR; GF_MMA(1, 0, At, B0); GF_MMA(1, 1, At, B1); GF_BAR; GF_SCHED;
        }
        if (wr == 0) GF_BAR;
        p.epi(acc, cur, wr, wc, fr, fq);
        if (!has_next) break;
#pragma unroll
        for (int a = 0; a < 2; ++a)
#pragma unroll
            for (int b = 0; b < 2; ++b)
#pragma unroll
                for (int m = 0; m < 4; ++m)
#pragma unroll
                    for (int n = 0; n < 2; ++n) acc[a][b][m][n] = (f32x4){0.f, 0.f, 0.f, 0.f};
        cur = nxt; cA = nA; cB = nB; ++ui;
#pragma unroll
        for (int j = 0; j < 4; ++j) aoffs[j] = naoffs[j];
        if (wr == 1) GF_BAR;
    }
    GF_WAIT_V(0);
    GF_BAR;
#undef GF_SA
#undef GF_SB
#undef GF_STAGE
#undef GF_LDA
#undef GF_LDB
#undef GF_MMA
#undef GF_WAIT_V
#undef GF_WAIT_L
#undef GF_BAR
#undef GF_SCHED
#undef GF_AOFFS
}

#ifndef FAST_MASK
#define FAST_MASK 0xffffffffu
#endif
template <class P> __device__ __forceinline__ void run_gemm(LAS unsigned char* lds, const P& p) {
#if FAST_CORE
    if constexpr (((FAST_MASK >> P::ID) & 1u) != 0u) { gemm_fast<P>(lds, p); __syncthreads();
#ifdef REPEAT_GEMM_ID
        if constexpr (P::ID == REPEAT_GEMM_ID) { gemm_fast<P>(lds, p); __syncthreads(); }
#endif
    }
    else gemm_naive<P>(p);
#else
    (void)lds;
    gemm_naive<P>(p);
#endif
}

__device__ __forceinline__ void tconv_task(const float* W, int ldw, int n0, bf16_t* dst, int ldd, int drow0, const float* ksc, int kb, int nb, int lane) {
    const int k0 = 32 * kb; const float* src = W + (size_t)k0 * ldw + n0 + 256 * nb + 4 * lane;
    f32x4 v[32];
#pragma unroll
    for (int j = 0; j < 32; ++j) v[j] = *(const f32x4*)(src + (size_t)j * ldw);
    if (ksc) {
#pragma unroll
        for (int j = 0; j < 32; ++j) v[j] *= ksc[k0 + j];
    }
#pragma unroll
    for (int e = 0; e < 4; ++e) {
        u32x4* o = (u32x4*)(dst + (size_t)(drow0 + 256 * nb + 4 * lane + e) * ldd + k0);
#pragma unroll
        for (int c = 0; c < 4; ++c) { u32x4 w; w.x = pk2(v[8 * c][e], v[8 * c + 1][e]); w.y = pk2(v[8 * c + 2][e], v[8 * c + 3][e]); w.z = pk2(v[8 * c + 4][e], v[8 * c + 5][e]); w.w = pk2(v[8 * c + 6][e], v[8 * c + 7][e]); o[c] = w; }
    }
}
__device__ __forceinline__ bool tconv_job(int& r, const float* W, int ldw, int n0, int Kd, int Nc, bf16_t* dst, int drow0, const float* ksc, int lane) {
    const int nkb = Kd / 32, nnb = Nc / 256, items = nkb * nnb;
    if (r >= items) { r -= items; return false; }
    const int kb = r / nnb, nb = r - kb * nnb;
    tconv_task(W, ldw, n0, dst, Kd, drow0, ksc, kb, nb, lane);
    return true;
}
__device__ __forceinline__ void conv_moe_layer(const Args& a, int l) {
    const int lane = threadIdx.x & 63, wave = threadIdx.x >> 6;
    const int gw = blockIdx.x * NWAVES + wave, NGW = gridDim.x * NWAVES;
    bf16_t* WGU = (bf16_t*)(a.ws + WS_W_GU); bf16_t* WDN = (bf16_t*)(a.ws + WS_W_DN);
    const float* g = a.in[I_NFFN] + l * D;
    for (int it = gw; it < 3 * 32 * 64; it += NGW) {
        const int kind = it / 2048, r = it - kind * 2048, e = r >> 6, q = r & 63;
        if (kind == 0) { const float* W = a.in[I_MGATE] + ((size_t)l * 32 + e) * (D * DEXP); tconv_task(W, DEXP, 0, WGU + (size_t)e * 1024 * 1024, D, 0, g, q >> 1, q & 1, lane); }
        else if (kind == 1) { const float* W = a.in[I_MUP] + ((size_t)l * 32 + e) * (D * DEXP); tconv_task(W, DEXP, 0, WGU + (size_t)e * 1024 * 1024, D, 512, g, q >> 1, q & 1, lane); }
        else { const float* W = a.in[I_MDOWN] + ((size_t)l * 32 + e) * (DEXP * D); tconv_task(W, D, 0, WDN + (size_t)e * 1024 * 512, DEXP, 0, nullptr, q >> 2, q & 3, lane); }
    }
}
__device__ __forceinline__ void phase_prologue(const Args& a, LAS unsigned char* lds) {
    const int tid = threadIdx.x, lane = tid & 63, wave = tid >> 6;
    const int gw = blockIdx.x * NWAVES + wave, NGW = gridDim.x * NWAVES;
    unsigned char* ws = a.ws;
    constexpr int NITEMS = 192 + 128 + 128 + 512 + 256 + 2 * 128 + 2 * 256 + 2 * 128;
    for (int it = gw; it < NITEMS; it += NGW) {
        int r = it;
        if (tconv_job(r, a.in[I_ABWIN], INAB, 0, D, 1536, (bf16_t*)(ws + WS_W_IN0), 0, a.in[I_NMIX], lane)) continue;
        if (tconv_job(r, a.in[I_ABWIN], INAB, 1544, D, 1024, (bf16_t*)(ws + WS_W_IN0), 1536, a.in[I_NMIX], lane)) continue;
        if (tconv_job(r, a.in[I_ABWOUT], D, 0, D, D, (bf16_t*)(ws + WS_W_OUT0), 0, nullptr, lane)) continue;
        if (tconv_job(r, a.in[I_CWIN], 2 * CW, 0, D, 2 * CW, (bf16_t*)(ws + WS_W_IN1), 0, a.in[I_NMIX] + D, lane)) continue;
        if (tconv_job(r, a.in[I_CWOUT], D, 0, CW, D, (bf16_t*)(ws + WS_W_OUT1), 0, nullptr, lane)) continue;
        if (tconv_job(r, a.in[I_XWQ], D, 0, D, D, (bf16_t*)(ws + WS_W_Q), 0, a.in[I_NCROSS], lane)) continue;
        if (tconv_job(r, a.in[I_XWQ] + (size_t)D * D, D, 0, D, D, (bf16_t*)(ws + WS_W_Q) + (size_t)D * D, 0, a.in[I_NCROSS] + D, lane)) continue;
        if (tconv_job(r, a.in[I_XWKV], 2 * D, 0, D, 2 * D, (bf16_t*)(ws + WS_W_KV), 0, a.in[I_NMEM], lane)) continue;
        if (tconv_job(r, a.in[I_XWKV] + (size_t)D * 2 * D, 2 * D, 0, D, 2 * D, (bf16_t*)(ws + WS_W_KV) + (size_t)2 * D * D, 0, a.in[I_NMEM] + D, lane)) continue;
        if (tconv_job(r, a.in[I_XWO], D, 0, D, D, (bf16_t*)(ws + WS_W_O), 0, nullptr, lane)) continue;
        tconv_job(r, a.in[I_XWO] + (size_t)D * D, D, 0, D, D, (bf16_t*)(ws + WS_W_O) + (size_t)D * D, 0, nullptr, lane);
    }
    conv_moe_layer(a, 0);
    const int gt = blockIdx.x * NTHREADS + tid, NGT = gridDim.x * NTHREADS;
    for (int i = gt; i < 2 * 256 * D; i += NGT) {
        const int l = i / (256 * D), n = (i / D) & 255, k = i & (D - 1);
        float v = 0.f;
        if (n < 4) v = a.in[I_MWG][((size_t)l * D + k) * 4 + n] * a.in[I_NFFN][l * D + k];
        else if (n < 36) v = a.in[I_MWE][((size_t)l * D + k) * 32 + (n - 4)] * a.in[I_NFFN][l * D + k];
        ((bf16_t*)(ws + WS_W_R))[i] = f2bf(v);
    }
    for (int i = gt; i < CG * CCH * CCH; i += NGT) { const int t = (i >> 7) & 127, s = i & 127; ((bf16_t*)(ws + WS_TRIL))[i] = f2bf(s <= t ? a.in[I_CWS][i] : 0.f); }
    __syncthreads();
    LAS float* wf = (LAS float*)(lds + 73728);
    for (int i = tid; i < D * 8; i += NTHREADS) { const int k = i >> 3, h = i & 7;
        wf[((((k >> 8) * 4 + (k & 3)) * 2 + (h >> 2)) * 64 + ((k & 255) >> 2)) * 4 + (h & 3)] = a.in[I_ABWIN][(size_t)k * INAB + 1536 + h] * a.in[I_NMIX][k]; }
    __syncthreads();
    bf16_t* X = (bf16_t*)(ws + WS_X); float* xstat = (float*)(ws + WS_XSTAT); float* flog = (float*)(ws + WS_FLOG);
    for (int row0 = gw; row0 < T; row0 += 4 * NGW) {
        f32x4 v[4][4];
#pragma unroll
        for (int rr = 0; rr < 4; ++rr) { const int row = row0 + rr * NGW; const f32x4* xr = (const f32x4*)(a.in[I_X] + (size_t)(row < T ? row : row0) * D) + lane;
#pragma unroll
            for (int j = 0; j < 4; ++j) v[rr][j] = xr[64 * j]; }
#pragma unroll
        for (int rr = 0; rr < 4; ++rr) {
            const int row = row0 + rr * NGW; if (row >= T) break;
            float ss = 0.f; float fl[8];
#pragma unroll
            for (int h = 0; h < 8; ++h) fl[h] = 0.f;
#pragma unroll
            for (int j = 0; j < 4; ++j) ss += (v[rr][j].x * v[rr][j].x + v[rr][j].y * v[rr][j].y) + (v[rr][j].z * v[rr][j].z + v[rr][j].w * v[rr][j].w);
#pragma unroll
            for (int j = 0; j < 4; ++j)
#pragma unroll
                for (int e = 0; e < 4; ++e) { const f32x4 w0 = *(const LAS f32x4*)(wf + (((j * 4 + e) * 2 + 0) * 64 + lane) * 4), w1 = *(const LAS f32x4*)(wf + (((j * 4 + e) * 2 + 1) * 64 + lane) * 4);
#pragma unroll
                    for (int h = 0; h < 4; ++h) { fl[h] += v[rr][j][e] * w0[h]; fl[4 + h] += v[rr][j][e] * w1[h]; } }
            ss = wave_sum(ss);
#pragma unroll
            for (int h = 0; h < 8; ++h) fl[h] = wave_sum(fl[h]);
            u32x2* o8 = (u32x2*)(X + (size_t)row * D) + lane;
#pragma unroll
            for (int j = 0; j < 4; ++j) { u32x2 o; o.x = pk2(v[rr][j].x, v[rr][j].y); o.y = pk2(v[rr][j].z, v[rr][j].w); o8[64 * j] = o; }
            if (lane < 16) xstat[(size_t)row * 16 + lane] = lane == 0 ? ss : 0.f;
            const float s = rsqrtf(ss * (1.f / D) + EPS);
            if (lane < 8) { float f = fl[0];
#pragma unroll
                for (int h = 1; h < 8; ++h) f = lane == h ? fl[h] : f;
                flog[(size_t)row * 8 + lane] = f * s; }
        }
    }
    bf16_t* MB = (bf16_t*)(ws + WS_MEMB); float* memstat = (float*)(ws + WS_MISC + MISC_MEMSTAT);
    for (int row = gw; row < NB * MEML; row += NGW) {
        const f32x4* xr = (const f32x4*)(a.in[I_MEM] + (size_t)row * D) + lane; float ss = 0.f;
        u32x2* o8 = (u32x2*)(MB + (size_t)row * D) + lane;
#pragma unroll
        for (int j = 0; j < 4; ++j) { const f32x4 v = xr[64 * j]; ss += (v.x * v.x + v.y * v.y) + (v.z * v.z + v.w * v.w); u32x2 o; o.x = pk2(v.x, v.y); o.y = pk2(v.z, v.w); o8[64 * j] = o; }
        ss = wave_sum(ss);
        if (lane == 0) memstat[row] = ss;
    }
}

__device__ __forceinline__ void phase_cumsum(const Args& a, LAS unsigned char* lds) {
    const int tid = threadIdx.x, lane = tid & 63, wave = tid >> 6;
    const float* flog = (const float*)(a.ws + WS_FLOG); float* csum = (float*)(a.ws + WS_CSUM);
    LAS float* wsum = (LAS float*)lds;
    for (int u = blockIdx.x; u < NB * AH; u += gridDim.x) {
        const int b = u >> 3, h = u & 7; const float fb = a.in[I_FBIAS][h];
        float v[8]; float run = 0.f;
#pragma unroll
        for (int j = 0; j < 8; ++j) { const float x = flog[((size_t)b * SEQ + 8 * tid + j) * 8 + h] + fb; const float lf = fminf(x, 0.f) - log1pf(__expf(-fabsf(x))); run += lf; v[j] = run; }
        float inc = run;
#pragma unroll
        for (int o = 1; o < 64; o <<= 1) { const float t = __shfl_up(inc, o); if (lane >= o) inc += t; }
        __syncthreads();
        if (lane == 63) wsum[wave] = inc;
        __syncthreads();
        float base = inc - run;
        for (int w = 0; w < wave; ++w) base += wsum[w];
#pragma unroll
        for (int j = 0; j < 8; ++j) csum[(size_t)u * SEQ + 8 * tid + j] = base + v[j];
    }
}

__device__ __forceinline__ void phase_k2fin(const Args& a) {
    const int lane = threadIdx.x & 63, wave = threadIdx.x >> 6;
    const int gw = blockIdx.x * NWAVES + wave, NGW = gridDim.x * NWAVES;
    bf16_t* K2 = (bf16_t*)(a.ws + WS_K2); const float* k2stat = (const float*)(a.ws + WS_MISC + MISC_K2STAT);
    for (int it = gw; it < 2 * NB * XH * MEML; it += NGW) {
        const int key = it & 255, h = (it >> 8) & 3, b = (it >> 10) & 7, l = it >> 13;
        const f32x4 st = *(const f32x4*)(k2stat + ((size_t)l * 2048 + b * 256 + key) * 16 + 4 * h);
        const float rn = rsqrtf(((st.x + st.y) + (st.z + st.w)) * (1.f / XHD) + EPS);
        u32x2* p = (u32x2*)(K2 + (size_t)it * 256) + lane; const u32x2 v = *p;
        const float* qg = a.in[I_XQG] + l * XHD + 4 * lane; const float* kg = a.in[I_XKG] + l * XHD + 4 * lane;
        u32x2 o; o.x = pk2(bf_lo(v.x) * rn * qg[0] * kg[0], bf_hi(v.x) * rn * qg[1] * kg[1]); o.y = pk2(bf_lo(v.y) * rn * qg[2] * kg[2], bf_hi(v.y) * rn * qg[3] * kg[3]);
        *p = o;
    }
    const bf16_t* V2 = (const bf16_t*)(a.ws + WS_ARENA + AR_V2TMP); bf16_t* V2T = (bf16_t*)(a.ws + WS_V2T);
    const int gt = blockIdx.x * NTHREADS + threadIdx.x, NGT = gridDim.x * NTHREADS;
    for (int it = gt; it < 64 * 256 * 32; it += NGT) {
        const int d = it & 255, k8 = (it >> 8) & 31, tile = it >> 13;
        const bf16_t* src = V2 + (size_t)tile * 65536 + (size_t)(8 * k8) * 256 + d;
        u32x4 w; w.x = (unsigned)src[0] | ((unsigned)src[256] << 16); w.y = (unsigned)src[512] | ((unsigned)src[768] << 16); w.z = (unsigned)src[1024] | ((unsigned)src[1280] << 16); w.w = (unsigned)src[1536] | ((unsigned)src[1792] << 16);
        *(u32x4*)(V2T + (size_t)tile * 65536 + (size_t)d * 256 + 8 * k8) = w;
    }
}

__device__ __forceinline__ void lru_unit(const Args& a, LAS unsigned char* lds, int b, int g, int ch, int pass) {
    const int tid = threadIdx.x, c = tid & 63, tq = tid >> 6;
    LAS float* xc = (LAS float*)lds;
    LAS float* wA = (LAS float*)(lds + 33792);
    LAS float* wX = (LAS float*)(lds + 33792 + 16384);
    LAS float* seg = (LAS float*)(lds + 33792 + 32768);
    const bf16_t* XB = (const bf16_t*)(a.ws + WS_ARENA + AR_XB); const bf16_t* GATE = (const bf16_t*)(a.ws + WS_ARENA + AR_GATE);
    bf16_t* AR = (bf16_t*)(a.ws + WS_ARENA + AR_AR); float* lsum = (float*)(a.ws + WS_LSUM);
    const int ch0 = 64 * g + c; const size_t row0 = (size_t)b * SEQ + 128 * ch;
    __syncthreads();
    for (int i = tid; i < 4096; i += NTHREADS) { wA[i] = a.in[I_WA][g * 4096 + i]; wX[i] = a.in[I_WX][g * 4096 + i]; }
    {
        const float w0 = a.in[I_CONVW][0 * BW + ch0], w1 = a.in[I_CONVW][1 * BW + ch0], w2 = a.in[I_CONVW][2 * BW + ch0], w3 = a.in[I_CONVW][3 * BW + ch0], cb = a.in[I_CONVB][ch0];
        float xm3, xm2, xm1; const int tl0 = 16 * tq, s0 = 128 * ch + tl0;
        xm3 = s0 >= 3 ? bf2f(XB[(row0 + tl0 - 3) * BW + ch0]) : 0.f; xm2 = s0 >= 2 ? bf2f(XB[(row0 + tl0 - 2) * BW + ch0]) : 0.f; xm1 = s0 >= 1 ? bf2f(XB[(row0 + tl0 - 1) * BW + ch0]) : 0.f;
#pragma unroll 4
        for (int j = 0; j < 16; ++j) { const float x0 = bf2f(XB[(row0 + tl0 + j) * BW + ch0]); xc[(tl0 + j) * 65 + c] = w0 * xm3 + w1 * xm2 + w2 * xm1 + w3 * x0 + cb; xm3 = xm2; xm2 = xm1; xm1 = x0; }
    }
    __syncthreads();
    float ra[16], rx[16];
#pragma unroll
    for (int j = 0; j < 16; ++j) { ra[j] = 0.f; rx[j] = 0.f; }
    for (int k = 0; k < 64; ++k) { const float wa = wA[k * 64 + c], wx = wX[k * 64 + c];
#pragma unroll
        for (int j = 0; j < 16; ++j) { const float x = xc[(16 * tq + j) * 65 + k]; ra[j] += x * wa; rx[j] += x * wx; } }
    const float ba = a.in[I_BA][ch0], bx = a.in[I_BX][ch0], lam = a.in[I_LAM][ch0];
    const float sp = (lam > 0.f ? 0.f : -lam) + log1pf(__expf(-fabsf(lam)));
    float av[16], bv[16]; float Pp = 1.f, hh = 0.f;
#pragma unroll
    for (int j = 0; j < 16; ++j) { const float r = sigmoidf(ra[j] + ba), ig = sigmoidf(rx[j] + bx); const float la = -8.f * r * sp; const float aa = __expf(la);
        const float beta = sqrtf(fmaxf(-expm1f(2.f * la), 0.f)); av[j] = aa; bv[j] = beta * (ig * xc[(16 * tq + j) * 65 + c]); Pp *= aa; hh = aa * hh + bv[j]; }
    seg[(tq * 64 + c) * 2] = Pp; seg[(tq * 64 + c) * 2 + 1] = hh;
    __syncthreads();
    if (pass == 0) {
        if (tq == 0) { float PA = 1.f, H = 0.f;
            for (int q = 0; q < 8; ++q) { const float pq = seg[(q * 64 + c) * 2], hq = seg[(q * 64 + c) * 2 + 1]; H = pq * H + hq; PA *= pq; }
            float* o = lsum + (((size_t)b * 32 + ch) * BW + ch0) * 2; o[0] = PA; o[1] = H; }
    } else {
        float H = 0.f;
        for (int q = 0; q < ch; ++q) { const float* o = lsum + (((size_t)b * 32 + q) * BW + ch0) * 2; H = o[0] * H + o[1]; }
        for (int q = 0; q < tq; ++q) H = seg[(q * 64 + c) * 2] * H + seg[(q * 64 + c) * 2 + 1];
#pragma unroll
        for (int j = 0; j < 16; ++j) { H = av[j] * H + bv[j]; const size_t row = row0 + 16 * tq + j; AR[row * D + 512 + ch0] = f2bf(bf2f(GATE[row * BW + ch0]) * H); }
    }
}
__device__ __forceinline__ void phase_lru(const Args& a, LAS unsigned char* lds, int pass) {
    for (int u = blockIdx.x; u < NB * 8 * 32; u += gridDim.x) { const int ch = u & 31, g = (u >> 5) & 7, b = u >> 8; lru_unit(a, lds, b, g, ch, pass); }
    __syncthreads();
}

__device__ __forceinline__ void phase_attn_naive(const Args& a) {
    const int tid = threadIdx.x;
    const bf16_t* Q = (const bf16_t*)(a.ws + WS_ARENA + AR_Q); const bf16_t* Kb = (const bf16_t*)(a.ws + WS_ARENA + AR_K); const bf16_t* Vb = (const bf16_t*)(a.ws + WS_ARENA + AR_V);
    bf16_t* AR = (bf16_t*)(a.ws + WS_ARENA + AR_AR); const float* csum = (const float*)(a.ws + WS_CSUM);
    const int NU = NB * AH * (SEQ / NTHREADS);
    for (int i = blockIdx.x; i < NU; i += gridDim.x) {
        const int uu = NU - 1 - i;
        const int qb = uu / (NB * AH), bh = uu % (NB * AH), b = bh >> 3, h = bh & 7;
        const int t = qb * NTHREADS + tid; const size_t row = (size_t)b * SEQ + t;
        u32x4 qp[8]; float o[64];
#pragma unroll
        for (int d8 = 0; d8 < 8; ++d8) qp[d8] = *(const u32x4*)(Q + row * AW + h * HD + 8 * d8);
#pragma unroll
        for (int d = 0; d < 64; ++d) o[d] = 0.f;
        const float* cs = csum + (size_t)bh * SEQ; const float ci = cs[t] * LOG2E;
        float mx = -INFINITY, l = 0.f;
        const int jmax = qb * NTHREADS + (tid | 63);
        for (int j = 0; j <= jmax; ++j) {
            const size_t kr = ((size_t)b * SEQ + j) * AW + h * HD;
            float s = 0.f;
#pragma unroll
            for (int d8 = 0; d8 < 8; ++d8) { const u32x4 v = *(const u32x4*)(Kb + kr + 8 * d8); const u32x4 q = qp[d8];
                s += bf_lo(q.x) * bf_lo(v.x) + bf_hi(q.x) * bf_hi(v.x) + bf_lo(q.y) * bf_lo(v.y) + bf_hi(q.y) * bf_hi(v.y) + bf_lo(q.z) * bf_lo(v.z) + bf_hi(q.z) * bf_hi(v.z) + bf_lo(q.w) * bf_lo(v.w) + bf_hi(q.w) * bf_hi(v.w); }
            s += ci - cs[j] * LOG2E;
            if (j > t) s = -INFINITY;
            const float mn = fmaxf(mx, s); const float sc = exp2f(mx - mn), p = exp2f(s - mn);
            l = l * sc + p; mx = mn;
#pragma unroll
            for (int d8 = 0; d8 < 8; ++d8) { const u32x4 v = *(const u32x4*)(Vb + kr + 8 * d8);
                o[8 * d8] = o[8 * d8] * sc + p * bf_lo(v.x); o[8 * d8 + 1] = o[8 * d8 + 1] * sc + p * bf_hi(v.x); o[8 * d8 + 2] = o[8 * d8 + 2] * sc + p * bf_lo(v.y); o[8 * d8 + 3] = o[8 * d8 + 3] * sc + p * bf_hi(v.y);
                o[8 * d8 + 4] = o[8 * d8 + 4] * sc + p * bf_lo(v.z); o[8 * d8 + 5] = o[8 * d8 + 5] * sc + p * bf_hi(v.z); o[8 * d8 + 6] = o[8 * d8 + 6] * sc + p * bf_lo(v.w); o[8 * d8 + 7] = o[8 * d8 + 7] * sc + p * bf_hi(v.w); }
        }
        const float inv = 1.f / l;
#pragma unroll
        for (int d8 = 0; d8 < 8; ++d8) { u32x4 w; w.x = pk2(o[8 * d8] * inv, o[8 * d8 + 1] * inv); w.y = pk2(o[8 * d8 + 2] * inv, o[8 * d8 + 3] * inv); w.z = pk2(o[8 * d8 + 4] * inv, o[8 * d8 + 5] * inv); w.w = pk2(o[8 * d8 + 6] * inv, o[8 * d8 + 7] * inv);
            *(u32x4*)(AR + row * D + h * HD + 8 * d8) = w; }
    }
}

#include <hip/hip_bf16.h>
#include <cmath>
namespace attn_body {
using bf16=__hip_bfloat16;
using bf16x8=__attribute__((ext_vector_type(8)))short;
using s16x4=__attribute__((ext_vector_type(4)))short;
using f32x16=__attribute__((ext_vector_type(16)))float;
using u32x4=__attribute__((ext_vector_type(4)))unsigned;
using f32x4_t=__attribute__((ext_vector_type(4)))float;
constexpr int BATCH=8,NHEAD=8,SEQ=4096,D=64,DM=NHEAD*D,DMO=1024;
constexpr int NW=8,QBLK=32,QB=QBLK*NW,KVBLK=64,NQB=SEQ/QB;
constexpr int ATTN_PITCH=DM, ATTN_UNIT_ROWS=QB;
__device__ __forceinline__ int crow(int r,int hi){return (r&3)+8*(r>>2)+4*hi;}
#define SBAR() __builtin_amdgcn_sched_barrier(0)
__device__ __forceinline__ void cmask(f32x16&p0,f32x16&p1,int jb,int qrel,int hi){
  const float NEG=-INFINITY; int kb=64*jb+4*hi;
  #pragma unroll
  for(int r=0;r<16;++r){int kv=kb+(r&3)+8*(r>>2); if(kv>qrel)p0[r]=NEG; if(kv+32>qrel)p1[r]=NEG;}
}

constexpr int NSLOT=3, SLOTB=8192;
constexpr int LDS_K=0, LDS_V=NSLOT*SLOTB, LDS_WS=2*NSLOT*SLOTB, LDS_OST=LDS_WS+NW*64*4, LDS_CB=LDS_OST+NW*4096, LDS_BYTES=LDS_CB+SEQ*4;
constexpr float C2=0.125f*1.4426950408889634f;
__device__ __forceinline__ void glds16(const void*gsrc,unsigned lds_dst){unsigned keep;
  asm volatile("s_mov_b32 %0, m0\n\ts_mov_b32 m0, %2\n\ts_nop 0\n\tglobal_load_lds_dwordx4 %1, off\n\ts_mov_b32 m0, %0":"=&s"(keep):"v"(gsrc),"s"(lds_dst):"memory");}
__device__ __forceinline__ float max3f(float a,float b,float c){float r;asm("v_max3_f32 %0, %1, %2, %3":"=v"(r):"v"(a),"v"(b),"v"(c));return r;}
__device__ __forceinline__ float max2f(float a,float b){float r;asm("v_max_f32_e32 %0, %1, %2":"=v"(r):"v"(a),"v"(b));return r;}
__device__ __forceinline__ float fadd_s(float a,float b){float r;asm("v_add_f32_e32 %0, %1, %2":"=v"(r):"v"(a),"v"(b));return r;}
__device__ __forceinline__ float fsub_s(float a,float b){float r;asm("v_sub_f32_e32 %0, %1, %2":"=v"(r):"v"(a),"v"(b));return r;}
typedef float f32x2_t __attribute__((ext_vector_type(2))); typedef __bf16 bf16x2_t __attribute__((ext_vector_type(2)));
__device__ __forceinline__ unsigned cvtpk_s(float lo,float hi){f32x2_t v={lo,hi};bf16x2_t b=__builtin_convertvector(v,bf16x2_t);return __builtin_bit_cast(unsigned,b);}
#define WAIT_BAR(N) asm volatile("s_waitcnt vmcnt(" #N ") lgkmcnt(0)\n\ts_barrier":::"memory")

__device__ __forceinline__ void qkt(f32x16&p0,f32x16&p1,const char*Kslot,const bf16x8*qr,int r32,int hi){
  const char*kb=Kslot+hi*1024+r32*16;
  #pragma unroll
  for(int d0=0;d0<4;++d0){
    const bf16x8 b0=*reinterpret_cast<const bf16x8*>(kb+d0*2048);
    const bf16x8 b1=*reinterpret_cast<const bf16x8*>(kb+d0*2048+512);
    {p0=__builtin_amdgcn_mfma_f32_32x32x16_bf16(b0,qr[d0],p0,0,0,0);p1=__builtin_amdgcn_mfma_f32_32x32x16_bf16(b1,qr[d0],p1,0,0,0);}}
}
typedef __attribute__((address_space(3))) const char* lds_cptr;
typedef short v4i16_t __attribute__((ext_vector_type(4)));
__device__ __forceinline__ void kload8(bf16x8*kf,lds_cptr kp){
  kf[0]=*(const __attribute__((address_space(3))) bf16x8*)(kp);      kf[1]=*(const __attribute__((address_space(3))) bf16x8*)(kp+512);
  kf[2]=*(const __attribute__((address_space(3))) bf16x8*)(kp+2048); kf[3]=*(const __attribute__((address_space(3))) bf16x8*)(kp+2560);
  kf[4]=*(const __attribute__((address_space(3))) bf16x8*)(kp+4096); kf[5]=*(const __attribute__((address_space(3))) bf16x8*)(kp+4608);
  kf[6]=*(const __attribute__((address_space(3))) bf16x8*)(kp+6144); kf[7]=*(const __attribute__((address_space(3))) bf16x8*)(kp+6656);
}
__device__ __forceinline__ void kload2(bf16x8*kf,lds_cptr kp,int j){ kf[2*j]=*(const __attribute__((address_space(3))) bf16x8*)(kp+j*2048); kf[2*j+1]=*(const __attribute__((address_space(3))) bf16x8*)(kp+j*2048+512); }
__device__ __forceinline__ s16x4 vtr(lds_cptr p){ return __builtin_bit_cast(s16x4,__builtin_amdgcn_ds_read_tr16_b64_v4i16((__attribute__((address_space(3))) v4i16_t*)p)); }
__device__ __forceinline__ float rowmax(const f32x16&p0,const f32x16&p1){
  float a=max3f(p0[0],p0[1],p1[0]),b=max3f(p0[2],p0[3],p1[1]);a=max3f(a,p1[2],p1[3]);
  #pragma unroll
  for(int r=4;r<16;r+=4){a=max3f(a,p0[r],p0[r+1]);b=max3f(b,p0[r+2],p0[r+3]);a=max3f(a,p1[r],p1[r+1]);b=max3f(b,p1[r+2],p1[r+3]);}
  const float m=max2f(a,b);
  auto rr=__builtin_amdgcn_permlane32_swap(__float_as_uint(m),__float_as_uint(m),false,false);
  return max2f(__uint_as_float(rr[0]),__uint_as_float(rr[1]));
}
__device__ __forceinline__ void pv(f32x16*o,int vb,bf16x8 pa0,bf16x8 pa1,bf16x8 pa2,bf16x8 pa3){
  #pragma unroll
  for(int d0=0;d0<2;++d0){s16x4 lo[4],hi[4];
    #pragma unroll
    for(int ks=0;ks<4;++ks){
      asm volatile("ds_read_b64_tr_b16 %0,%1 offset:%c2":"=&v"(lo[ks]):"v"(vb),"i"(d0*4096+ks*1024):"memory");
      asm volatile("ds_read_b64_tr_b16 %0,%1 offset:%c2":"=&v"(hi[ks]):"v"(vb),"i"(d0*4096+ks*1024+512):"memory");}
    asm volatile("s_waitcnt lgkmcnt(0)":::"memory");SBAR();
    #define PK(k) (bf16x8){lo[k][0],lo[k][1],lo[k][2],lo[k][3],hi[k][0],hi[k][1],hi[k][2],hi[k][3]}
    o[d0]=__builtin_amdgcn_mfma_f32_32x32x16_bf16(pa0,PK(0),o[d0],0,0,0);
    o[d0]=__builtin_amdgcn_mfma_f32_32x32x16_bf16(pa1,PK(1),o[d0],0,0,0);
    o[d0]=__builtin_amdgcn_mfma_f32_32x32x16_bf16(pa2,PK(2),o[d0],0,0,0);
    o[d0]=__builtin_amdgcn_mfma_f32_32x32x16_bf16(pa3,PK(3),o[d0],0,0,0);
    #undef PK
  }
}

#ifndef ATTN_STORE16
#define ATTN_STORE16(p,v) (*(u32x4*)(p)=(v))
#endif
template<int THRL> __device__ __forceinline__ void attn_unit(int b,int h,int qb,const bf16*Q,const bf16*__restrict__ K,const bf16*__restrict__ V,bf16*O,const float*__restrict__ csum,char*shm){
  int tid_=threadIdx.x; asm volatile("":"+v"(tid_));
  const int tid=tid_,lane=tid&63,r32=lane&31,hi=lane>>5; const int wid=__builtin_amdgcn_readfirstlane(tid>>6);
  const lds_cptr shm3=(lds_cptr)shm;
  const long rowbase=(long)b*SEQ; const int q0=qb*QB;
  const bf16*Qw=Q+(rowbase+q0+wid*QBLK)*DM+h*D;
  const bf16*Kh=K+rowbase*DM+h*D,*Vh=V+rowbase*DM+h*D;
  const unsigned lds0=(unsigned)(uintptr_t)shm;
  float*wsf=(float*)(shm+LDS_WS)+wid*64;
  const bf16*ksrc=Kh+(long)lane*DM+wid*8;
  const bf16*vsrc=Vh+(long)(16*(wid&3)+(lane>>2))*DM+(wid>>2)*32+(lane&3)*8;
  const unsigned kdst=lds0+LDS_K+wid*1024, vdst=lds0+LDS_V+wid*1024;
  #define DMA_K(t,slot) glds16(ksrc+(long)(t)*KVBLK*DM,(unsigned)__builtin_amdgcn_readfirstlane(kdst+(slot)))
  #define DMA_V(t,slot) glds16(vsrc+(long)(t)*KVBLK*DM,(unsigned)__builtin_amdgcn_readfirstlane(vdst+(slot)))
  const int vb0=(int)(lds0+LDS_V)+((lane>>4)&1)*32+(lane&3)*8+(4*hi+((lane&15)>>2))*64;
  const char*Kbase=shm+LDS_K; bf16x8 kf[8];
  const lds_cptr kp0=shm3+LDS_K+hi*1024+r32*16; const lds_cptr vp0=shm3+LDS_V+((lane>>4)&1)*32+(lane&3)*8+(4*hi+((lane&15)>>2))*64;
  const int NT=(q0+QB)/KVBLK;
  { const float*cs=csum+(long)(b*NHEAD+h)*SEQ; const float cref=cs[q0]; float*cbw=(float*)(shm+LDS_CB);
    for(int j=tid;j<q0+QB;j+=NW*64)cbw[j]=(cref-cs[j])*1.4426950408889634f; }
  const __attribute__((address_space(3))) f32x4_t* cbp=(const __attribute__((address_space(3))) f32x4_t*)(shm3+LDS_CB+16*hi);
  #define LOADB(X0,X1,t) do{ _Pragma("unroll") for(int g_=0;g_<4;++g_){ const f32x4_t b0_=cbp[16*(t)+2*g_], b1_=cbp[16*(t)+2*g_+8]; \
      X0[4*g_]=b0_[0];X0[4*g_+1]=b0_[1];X0[4*g_+2]=b0_[2];X0[4*g_+3]=b0_[3]; X1[4*g_]=b1_[0];X1[4*g_+1]=b1_[1];X1[4*g_+2]=b1_[2];X1[4*g_+3]=b1_[3]; } }while(0)
  DMA_K(0,0);DMA_V(0,0);DMA_K(1,SLOTB);
  bf16x8 qr[4];
  #pragma unroll
  for(int d0=0;d0<4;++d0)qr[d0]=*reinterpret_cast<const bf16x8*>(&Qw[(long)r32*DM+d0*16+hi*8]);
  float mhat=0.f,l_reg=0.f;f32x16 o[2];o[0]=f32x16{};o[1]=f32x16{};
  const int qrel=wid*QBLK+r32;
  #define CMASK(P0,P1,t) do{int jb_=(t)-(NT-4); if(jb_>=0)cmask(P0,P1,jb_,qrel,hi);}while(0)
  bool resc=false;
  #define START(P0,P1) do{ const float rm=rowmax(P0,P1); resc=false; \
    { const float dl=rm; mhat=fadd_s(mhat,dl); \
      _Pragma("unroll") for(int r=0;r<16;++r){P0[r]=fsub_s(P0[r],dl);P1[r]=fsub_s(P1[r],dl);} } \
    _Pragma("unroll") for(int r=0;r<16;++r)P0[r]=__builtin_amdgcn_exp2f(P0[r]); }while(0)
  #define RESC() do{ if(resc){ asm volatile("s_waitcnt lgkmcnt(0)":::"memory"); \
      _Pragma("unroll") for(int d_=0;d_<2;++d_) _Pragma("unroll") for(int r=0;r<16;++r)o[d_][r]*=wsf[crow(r,hi)]; } }while(0)
  f32x16 pA0,pA1,pB0,pB1;
  int sl_prev=0,sl_cur=0,sl_next=SLOTB;
  #define ROT() do{sl_prev=sl_cur;sl_cur=sl_next;sl_next=(sl_next==(NSLOT-1)*SLOTB)?0:sl_next+SLOTB;}while(0)
  DMA_K(2,2*SLOTB);
  WAIT_BAR(3);
  LOADB(pA0,pA1,0);qkt(pA0,pA1,Kbase,qr,r32,hi);asm volatile("s_nop 15\n\ts_nop 7":"+v"(pA0),"+v"(pA1));CMASK(pA0,pA1,0);
  START(pA0,pA1);
  LOADB(pB0,pB1,1);
  _Pragma("unroll") for(int r=0;r<16;++r)pA1[r]=__builtin_amdgcn_exp2f(pA1[r]);
  WAIT_BAR(0);
  DMA_K(3,0);DMA_V(1,SLOTB);
  ROT();
  kload8(kf,kp0+sl_cur);
  WAIT_BAR(2);
  s16x4 vlo[8],vhi[8]; u32x4 pw0,pw1,pw2,pw3;
  #define PKW(P,B) cvtpk_s(P[B],P[B+1])
  #define PAF(k) __builtin_bit_cast(bf16x8,pw##k)
  #define VFR(i) (bf16x8){vlo[i][0],vlo[i][1],vlo[i][2],vlo[i][3],vhi[i][0],vhi[i][1],vhi[i][2],vhi[i][3]}
  #define PIN(x) asm volatile("":"+v"(x))
  #define MX3(a,b,c) __builtin_fmaxf(__builtin_fmaxf((a),(b)),(c))
  #define GAPA(MF,A0,A1,A2,A3,W0,W1,PW) do{ MF; sacc+=A0; sacc+=A1; sacc+=A2; sacc+=A3; PIN(sacc); W0; W1; PIN(PW); SBAR(); }while(0)
  #define EX(v) __builtin_amdgcn_exp2f(v)
  #define GAPB(MF,X,B) do{ MF; X[B]=EX(X[B]); X[B+1]=EX(X[B+1]); X[B+2]=EX(X[B+2]); X[B+3]=EX(X[B+3]); PIN(X); SBAR(); }while(0)
  #define VRD(i) do{ vlo[i]=vtr(vp_+(((i)>>2)*4096+((i)&3)*1024)); vhi[i]=vtr(vp_+(((i)>>2)*4096+((i)&3)*1024+512)); }while(0)
  #define KRD(G,j) do{ if(G){ kload2(kf,kp0+sl_next,j); SBAR(); } }while(0)
  #define STEP(C0,C1,P0,P1,t,GK,GV,GL) do{ SBAR(); \
    _Pragma("unroll") for(int r=0;r<16;++r){C0[r]-=mhat;C1[r]-=mhat;} \
    const lds_cptr vp_=vp0+sl_prev; \
    VRD(0); SBAR(); float sacc=(P0[0]+P0[1]); \
    GAPA(C0=__builtin_amdgcn_mfma_f32_32x32x16_bf16(kf[0],qr[0],C0,0,0,0), P0[2],P0[3],P0[4],P0[5],     pw0[0]=PKW(P0,0), pw0[1]=PKW(P0,2), pw0); \
    VRD(4); SBAR(); GAPA(C1=__builtin_amdgcn_mfma_f32_32x32x16_bf16(kf[1],qr[0],C1,0,0,0), P0[6],P0[7],P0[8],P0[9],     pw0[2]=PKW(P0,4), pw0[3]=PKW(P0,6), pw0); \
    VRD(1); SBAR(); GAPA(C0=__builtin_amdgcn_mfma_f32_32x32x16_bf16(kf[2],qr[1],C0,0,0,0),   P0[10],P0[11],P0[12],P0[13], pw1[0]=PKW(P0,8), pw1[1]=PKW(P0,10), pw1); \
    VRD(5); SBAR(); GAPA(C1=__builtin_amdgcn_mfma_f32_32x32x16_bf16(kf[3],qr[1],C1,0,0,0),   P0[14],P0[15],P1[0],P1[1],   pw1[2]=PKW(P0,12),pw1[3]=PKW(P0,14), pw1); \
    VRD(2); SBAR(); GAPA(C0=__builtin_amdgcn_mfma_f32_32x32x16_bf16(kf[4],qr[2],C0,0,0,0),   P1[2],P1[3],P1[4],P1[5],     pw2[0]=PKW(P1,0), pw2[1]=PKW(P1,2), pw2); \
    VRD(6); SBAR(); GAPA(C1=__builtin_amdgcn_mfma_f32_32x32x16_bf16(kf[5],qr[2],C1,0,0,0),   P1[6],P1[7],P1[8],P1[9],     pw2[2]=PKW(P1,4), pw2[3]=PKW(P1,6), pw2); \
    VRD(3); SBAR(); GAPA(C0=__builtin_amdgcn_mfma_f32_32x32x16_bf16(kf[6],qr[3],C0,0,0,0),   P1[10],P1[11],P1[12],P1[13], pw3[0]=PKW(P1,8), pw3[1]=PKW(P1,10), pw3); \
    VRD(7); SBAR(); GAPA(C1=__builtin_amdgcn_mfma_f32_32x32x16_bf16(kf[7],qr[3],C1,0,0,0),   P1[14],P1[15],0.f,0.f,       pw3[2]=PKW(P1,12),pw3[3]=PKW(P1,14), pw3); \
    l_reg+=sacc; LOADB(P0,P1,(t)+1); \
    if(GK){DMA_K((t)+3,sl_cur);} if(GV){DMA_V((t)+1,sl_next);} \
    CMASK(C0,C1,t); \
    { float a=MX3(C0[0],C0[1],C1[0]),b=MX3(C0[2],C0[3],C1[1]); a=MX3(a,C1[2],C1[3]); \
      _Pragma("unroll") for(int r=4;r<16;r+=4){a=MX3(a,C0[r],C0[r+1]);b=MX3(b,C0[r+2],C0[r+3]);a=MX3(a,C1[r],C1[r+1]);b=MX3(b,C1[r+2],C1[r+3]);} \
      float rm=__builtin_fmaxf(a,b); { auto rr=__builtin_amdgcn_permlane32_swap(__float_as_uint(rm),__float_as_uint(rm),false,false); rm=__builtin_fmaxf(__uint_as_float(rr[0]),__uint_as_float(rr[1])); } \
      resc=false; \
      if(__builtin_expect(__any(rm>(float)THRL),0)){ const float dl=__builtin_fmaxf(rm,0.f); mhat+=dl; \
        _Pragma("unroll") for(int r=0;r<16;++r){C0[r]-=dl;C1[r]-=dl;} \
        const float f=__builtin_amdgcn_exp2f(-dl); l_reg*=f; if(hi==0)wsf[r32]=f; resc=true; } } \
    SBAR(); \
    GAPB(o[0]=__builtin_amdgcn_mfma_f32_32x32x16_bf16(PAF(0),VFR(0),o[0],0,0,0), C0,0); \
    GAPB(o[1]=__builtin_amdgcn_mfma_f32_32x32x16_bf16(PAF(0),VFR(4),o[1],0,0,0), C0,4); \
    KRD(GL,0); GAPB(o[0]=__builtin_amdgcn_mfma_f32_32x32x16_bf16(PAF(1),VFR(1),o[0],0,0,0), C0,8); \
    KRD(GL,1); GAPB(o[1]=__builtin_amdgcn_mfma_f32_32x32x16_bf16(PAF(1),VFR(5),o[1],0,0,0), C0,12); \
    KRD(GL,2); GAPB(o[0]=__builtin_amdgcn_mfma_f32_32x32x16_bf16(PAF(2),VFR(2),o[0],0,0,0), C1,0); \
    KRD(GL,3); GAPB(o[1]=__builtin_amdgcn_mfma_f32_32x32x16_bf16(PAF(2),VFR(6),o[1],0,0,0), C1,4); \
    GAPB(o[0]=__builtin_amdgcn_mfma_f32_32x32x16_bf16(PAF(3),VFR(3),o[0],0,0,0), C1,8); \
    GAPB(o[1]=__builtin_amdgcn_mfma_f32_32x32x16_bf16(PAF(3),VFR(7),o[1],0,0,0), C1,12); \
    }while(0)
  int t=1;
  #undef CMASK
  #define CMASK(P0,P1,t) do{}while(0)
  for(;t+5<NT;t+=2){
    STEP(pB0,pB1,pA0,pA1,t,true,true,true);     WAIT_BAR(2); RESC(); ROT();
    STEP(pA0,pA1,pB0,pB1,t+1,true,true,true);   WAIT_BAR(2); RESC(); ROT();
  }
  #undef CMASK
  #define CMASK(P0,P1,t) do{int jb_=(t)-(NT-4); if(jb_>=0)cmask(P0,P1,jb_,qrel,hi);}while(0)
  #define ENDW(tt) do{ if((tt)+3<NT){WAIT_BAR(2);} else if((tt)+2<NT){WAIT_BAR(1);} else {WAIT_BAR(0);} }while(0)
  for(;t+1<NT;t+=2){
    STEP(pB0,pB1,pA0,pA1,t,(t+3<NT),(t+1<NT),(t+1<NT));       ENDW(t);   RESC(); ROT();
    STEP(pA0,pA1,pB0,pB1,t+1,(t+4<NT),(t+2<NT),(t+2<NT));     ENDW(t+1); RESC(); ROT();
  }
  STEP(pB0,pB1,pA0,pA1,NT-1,false,false,false); RESC();
  { float sacc=pB0[0]+pB0[1]; _Pragma("unroll") for(int r=2;r<16;++r)sacc+=pB0[r]; _Pragma("unroll") for(int r=0;r<16;++r)sacc+=pB1[r]; l_reg+=sacc;
    pw0=(u32x4){PKW(pB0,0),PKW(pB0,2),PKW(pB0,4),PKW(pB0,6)};pw1=(u32x4){PKW(pB0,8),PKW(pB0,10),PKW(pB0,12),PKW(pB0,14)};pw2=(u32x4){PKW(pB1,0),PKW(pB1,2),PKW(pB1,4),PKW(pB1,6)};pw3=(u32x4){PKW(pB1,8),PKW(pB1,10),PKW(pB1,12),PKW(pB1,14)};
    SBAR(); pv(o,vb0+sl_cur,PAF(0),PAF(1),PAF(2),PAF(3)); }
  #undef PKW
  #undef PAF
  #undef VFR
  #undef PIN
  #undef MX3
  #undef GAPA
  #undef GAPB
  #undef EX
  #undef VRD
  #undef KRD
  #undef STEP
  #undef ENDW
  {auto rr=__builtin_amdgcn_permlane32_swap(__float_as_uint(l_reg),__float_as_uint(l_reg),false,false);l_reg=__uint_as_float(rr[0])+__uint_as_float(rr[1]);}
  if(hi==0)wsf[32+r32]=l_reg;asm volatile("s_waitcnt lgkmcnt(0)":::"memory");
  float rli[16];
  #pragma unroll
  for(int r=0;r<16;++r)rli[r]=__builtin_amdgcn_rcpf(wsf[32+crow(r,hi)]);
  bf16*Ow=O+(rowbase+q0+wid*QBLK)*DMO+h*D;
  { bf16*stg=(bf16*)(shm+LDS_OST)+wid*2048;
    #pragma unroll
    for(int r=0;r<16;++r){const int orow=crow(r,hi);
      #pragma unroll
      for(int d0=0;d0<2;++d0)stg[orow*64+d0*32+r32]=__float2bfloat16(o[d0][r]*rli[r]);}
    asm volatile("s_waitcnt lgkmcnt(0)":::"memory");
    #pragma unroll
    for(int i=0;i<4;++i){const int row=i*8+(lane>>3),ch=lane&7; const u32x4 v=*(const u32x4*)(stg+row*64+ch*8); ATTN_STORE16(Ow+(long)row*DMO+ch*8,v);} }
  asm volatile("s_waitcnt lgkmcnt(0)\n\ts_barrier":::"memory");
  #undef LOADB
  #undef DMA_K
  #undef DMA_V
  #undef CMASK
  #undef START
  #undef RESC
  #undef ROT
}
constexpr int ATTN_LDS_BYTES=LDS_BYTES;
struct AttnTensors { const bf16* Q; const bf16* K; const bf16* V; bf16* O; const float* csum; };
struct AttnUnit { int bh; int qb; };
template<int THRL> __device__ __forceinline__ void attn_phase(char*lds,const AttnTensors&T){
  const int G=gridDim.x,bx=blockIdx.x; const int vcu=(G%8==0)?(bx%8)*(G/8)+bx/8:bx;
  for(int v=vcu;v<256;v+=G){ const int s=v&3,bh=v>>2;
    for(int i=0;i<4;++i){ const int qb=(i==0)?15-s:(i==1)?8+s:(i==2)?7-s:s; attn_unit<THRL>(bh/NHEAD,bh%NHEAD,qb,T.Q,T.K,T.V,T.O,T.csum,lds); } }
}
#undef SBAR
#undef WAIT_BAR
}

__device__ __forceinline__ void phase_mix_naive(const Args& a, LAS unsigned char* lds) {
    const int tid = threadIdx.x, lane = tid & 63, wave = tid >> 6;
    LAS float* vt = (LAS float*)lds;
    bf16_t* Ub = (bf16_t*)(a.ws + WS_ARENA + AR_U); const bf16_t* V3 = (const bf16_t*)(a.ws + WS_ARENA + AR_V3); const float* vstat = (const float*)(a.ws + WS_VSTAT);
    const bf16_t* tril = (const bf16_t*)(a.ws + WS_TRIL);
    for (int u = blockIdx.x; u < (T / CCH) * CG; u += gridDim.x) {
        const int g = u & 7, n = u >> 3; const size_t row0 = (size_t)n * CCH;
        __syncthreads();
        for (int i = tid; i < 128 * 64; i += NTHREADS) {
            const int s = i >> 6, c4 = (i & 63) * 4; const size_t row = row0 + s;
            const float* st = vstat + row * 32; float tot = 0.f;
#pragma unroll
            for (int j = 0; j < 32; ++j) tot += st[j];
            const float rs = rsqrtf(tot * (1.f / CW) + EPS);
            const u32x2 v = *(const u32x2*)(V3 + row * CW + 256 * g + c4); const float* gn = a.in[I_CVG] + 256 * g + c4;
            *(LAS f32x4*)(vt + s * 256 + c4) = (f32x4){bf_lo(v.x) * rs * gn[0], bf_hi(v.x) * rs * gn[1], bf_lo(v.y) * rs * gn[2], bf_hi(v.y) * rs * gn[3]};
        }
        __syncthreads();
        for (int tt = 0; tt < 16; ++tt) {
            const int t = wave * 16 + tt; const bf16_t* wrow = tril + ((size_t)g * 128 + t) * 128;
            f32x4 acc = (f32x4){0.f, 0.f, 0.f, 0.f};
            for (int s = 0; s <= t; ++s) { const float w = bf2f(wrow[s]); const f32x4 v = *(const LAS f32x4*)(vt + s * 256 + 4 * lane); acc += v * w; }
            const float bs = a.in[I_CBS][g * 128 + t];
            u32x2* up = (u32x2*)(Ub + (row0 + t) * CW + 256 * g + 4 * lane); const u32x2 uv = *up;
            u32x2 o; o.x = pk2(bf_lo(uv.x) * (acc.x + bs), bf_hi(uv.x) * (acc.y + bs)); o.y = pk2(bf_lo(uv.y) * (acc.z + bs), bf_hi(uv.y) * (acc.w + bs));
            *up = o;
        }
    }
    __syncthreads();
}

__device__ __forceinline__ void phase_mix_fast(const Args& a, LAS unsigned char* lds) {
    typedef short v4i16_t __attribute__((ext_vector_type(4)));
    typedef float f32x16 __attribute__((ext_vector_type(16)));
    const int tid = threadIdx.x, lane = tid & 63, wave = __builtin_amdgcn_readfirstlane(tid >> 6), r32 = lane & 31, hi = lane >> 5;
    constexpr int RS = 576;
    LAS unsigned char* tile = lds; LAS float* rsl = (LAS float*)(lds + 128 * RS);
    bf16_t* Ub = (bf16_t*)(a.ws + WS_ARENA + AR_U); const bf16_t* V3 = (const bf16_t*)(a.ws + WS_ARENA + AR_V3); const float* vstat = (const float*)(a.ws + WS_VSTAT);
    const bf16_t* tril = (const bf16_t*)(a.ws + WS_TRIL);
    const int q = (lane & 15) >> 2, p = lane & 3, cblk = (lane >> 4) & 1;
    for (int u = blockIdx.x; u < (T / CCH) * CG; u += gridDim.x) {
        const int g = u & 7, n = u >> 3; const size_t row0 = (size_t)n * CCH;
        __syncthreads();
        if (tid < 128) { const f32x4* st = (const f32x4*)(vstat + (row0 + tid) * 32); float tot = 0.f;
#pragma unroll
            for (int j = 0; j < 8; ++j) { const f32x4 v = st[j]; tot += (v.x + v.y) + (v.z + v.w); }
            rsl[tid] = rsqrtf(tot * (1.f / CW) + EPS); }
        __syncthreads();
#pragma unroll
        for (int j = 0; j < 8; ++j) {
            const int i = tid + 512 * j, s = i >> 5, c8 = (i & 31) * 8;
            const u32x4 v = *(const u32x4*)(V3 + (row0 + s) * CW + 256 * g + c8);
            const float* gn = a.in[I_CVG] + 256 * g + c8; const f32x4 g0 = *(const f32x4*)gn, g1 = *(const f32x4*)(gn + 4); const float rs = rsl[s];
            u32x4 w; w.x = pk2(bf_lo(v.x) * rs * g0.x, bf_hi(v.x) * rs * g0.y); w.y = pk2(bf_lo(v.y) * rs * g0.z, bf_hi(v.y) * rs * g0.w);
            w.z = pk2(bf_lo(v.z) * rs * g1.x, bf_hi(v.z) * rs * g1.y); w.w = pk2(bf_lo(v.w) * rs * g1.z, bf_hi(v.w) * rs * g1.w);
            *(LAS u32x4*)(tile + s * RS + c8 * 2) = w;
        }
        __syncthreads();
        f32x16 acc[4];
#pragma unroll
        for (int tb = 0; tb < 4; ++tb) acc[tb] = f32x16{};
        const LAS unsigned char* abase = tile + (8 * hi + q) * RS + (32 * wave + 16 * cblk + 4 * p) * 2;
        const bf16_t* wbase = tril + ((size_t)g * 128 + r32) * 128 + 8 * hi;
#pragma unroll
        for (int ks = 0; ks < 8; ++ks) {
            const v4i16_t lo = __builtin_amdgcn_ds_read_tr16_b64_v4i16((LAS v4i16_t*)(abase + (16 * ks) * RS));
            const v4i16_t h2 = __builtin_amdgcn_ds_read_tr16_b64_v4i16((LAS v4i16_t*)(abase + (16 * ks + 4) * RS));
            const bf16x8 af = (bf16x8){lo[0], lo[1], lo[2], lo[3], h2[0], h2[1], h2[2], h2[3]};
#pragma unroll
            for (int tb = 0; tb < 4; ++tb) if (ks <= 2 * tb + 1) {
                const bf16x8 bfr = *(const bf16x8*)(wbase + (size_t)(32 * tb) * 128 + 16 * ks);
                acc[tb] = __builtin_amdgcn_mfma_f32_32x32x16_bf16(af, bfr, acc[tb], 0, 0, 0);
            }
        }
#pragma unroll
        for (int tb = 0; tb < 4; ++tb) {
            const int t = 32 * tb + r32; const float bs = a.in[I_CBS][g * 128 + t];
            bf16_t* up = Ub + (row0 + t) * CW + 256 * g + 32 * wave + 4 * hi;
#pragma unroll
            for (int gr = 0; gr < 4; ++gr) {
                u32x2* pp = (u32x2*)(up + 8 * gr); const u32x2 uv = *pp;
                u32x2 o; o.x = pk2(bf_lo(uv.x) * (acc[tb][4 * gr] + bs), bf_hi(uv.x) * (acc[tb][4 * gr + 1] + bs)); o.y = pk2(bf_lo(uv.y) * (acc[tb][4 * gr + 2] + bs), bf_hi(uv.y) * (acc[tb][4 * gr + 3] + bs));
                *pp = o;
            }
        }
    }
    __syncthreads();
}

__device__ __forceinline__ void phase_route(const Args& a, LAS unsigned char* lds, int l) {
    const int tid = threadIdx.x;
    LAS int* hist = (LAS int*)lds; LAS int* base = hist + 32;
    const float* rlog = (const float*)(a.ws + WS_RLOG); float* pairw = (float*)(a.ws + WS_PAIRW); int* list = (int*)(a.ws + WS_LIST); int* cnt = (int*)(a.ws + WS_CTL) + 64 * l;
    for (int cb = blockIdx.x; cb < T / 256; cb += gridDim.x) {
        __syncthreads();
        if (tid < 32) hist[tid] = 0;
        __syncthreads();
        int e0 = 0, e1 = 0, r0 = 0, r1 = 0; const int tok = cb * 256 + (tid & 255);
        if (tid < 256) {
            const float* lg = rlog + (size_t)tok * 40;
            int gi = 0; float gm = lg[0];
#pragma unroll
            for (int j = 1; j < 4; ++j) if (lg[j] > gm) { gm = lg[j]; gi = j; }
            float gs = 0.f;
#pragma unroll
            for (int j = 0; j < 4; ++j) gs += __expf(lg[j] - gm);
            const float gw = 1.f / gs;
            const float* el = lg + 4 + 8 * gi;
            int i0 = 0; float v0 = el[0];
#pragma unroll
            for (int j = 1; j < 8; ++j) if (el[j] > v0) { v0 = el[j]; i0 = j; }
            int i1 = -1; float v1 = -INFINITY;
#pragma unroll
            for (int j = 0; j < 8; ++j) if (j != i0 && el[j] > v1) { v1 = el[j]; i1 = j; }
            const float ex = __expf(v1 - v0), den = 1.f / (1.f + ex);
            pairw[2 * tok] = gw * den; pairw[2 * tok + 1] = gw * ex * den;
            e0 = gi * 8 + i0; e1 = gi * 8 + i1;
            r0 = atomicAdd((int*)&hist[e0], 1); r1 = atomicAdd((int*)&hist[e1], 1);
        }
        __syncthreads();
        if (tid < 32) base[tid] = hist[tid] ? atomicAdd(&cnt[tid], hist[tid]) : 0;
        __syncthreads();
        if (tid < 256) { list[(size_t)e0 * 65536 + base[e0] + r0] = 2 * tok; list[(size_t)e1 * 65536 + base[e1] + r1] = 2 * tok + 1; }
    }
    __syncthreads();
}

__device__ __forceinline__ void phase_combine(const Args& a, bool last) {
    const int lane = threadIdx.x & 63, wave = threadIdx.x >> 6;
    const int gw = blockIdx.x * NWAVES + wave, NGW = gridDim.x * NWAVES;
    bf16_t* X = (bf16_t*)(a.ws + WS_X); const bf16_t* Y = (const bf16_t*)(a.ws + WS_ARENA + AR_Y); float* xstat = (float*)(a.ws + WS_XSTAT);
    for (int row = gw; row < T; row += NGW) {
        float ss = 0.f;
#pragma unroll
        for (int hlf = 0; hlf < 2; ++hlf) {
            const int c0 = 512 * hlf + 8 * lane;
            const u32x4 xv = *(const u32x4*)(X + (size_t)row * D + c0), y0 = *(const u32x4*)(Y + (size_t)(2 * row) * D + c0), y1 = *(const u32x4*)(Y + (size_t)(2 * row + 1) * D + c0);
            float v[8] = {bf_lo(xv.x), bf_hi(xv.x), bf_lo(xv.y), bf_hi(xv.y), bf_lo(xv.z), bf_hi(xv.z), bf_lo(xv.w), bf_hi(xv.w)};
            const float p[8] = {bf_lo(y0.x), bf_hi(y0.x), bf_lo(y0.y), bf_hi(y0.y), bf_lo(y0.z), bf_hi(y0.z), bf_lo(y0.w), bf_hi(y0.w)};
            const float q[8] = {bf_lo(y1.x), bf_hi(y1.x), bf_lo(y1.y), bf_hi(y1.y), bf_lo(y1.z), bf_hi(y1.z), bf_lo(y1.w), bf_hi(y1.w)};
#pragma unroll
            for (int j = 0; j < 8; ++j) v[j] = (v[j] + p[j]) + q[j];
            if (last) { float* o = a.out + (size_t)row * D + c0; *(f32x4*)o = (f32x4){v[0], v[1], v[2], v[3]}; *(f32x4*)(o + 4) = (f32x4){v[4], v[5], v[6], v[7]}; }
            else { u32x4 w; w.x = pk2(v[0], v[1]); w.y = pk2(v[2], v[3]); w.z = pk2(v[4], v[5]); w.w = pk2(v[6], v[7]); *(u32x4*)(X + (size_t)row * D + c0) = w;
                const float r[8] = {bf_lo(w.x), bf_hi(w.x), bf_lo(w.y), bf_hi(w.y), bf_lo(w.z), bf_hi(w.z), bf_lo(w.w), bf_hi(w.w)};
#pragma unroll
                for (int j = 0; j < 8; ++j) ss += r[j] * r[j]; }
        }
        if (!last) { ss = wave_sum(ss); if (lane < 16) xstat[(size_t)row * 16 + lane] = lane == 0 ? ss : 0.f; }
    }
}

#define XB_TMO      128
#define XB_XCNT(j)  (256  + 64 * (j))
#define XB_XSUB(j)  (1280 + 64 * (j))
#define XB_XGEN(j)  (2304 + 64 * (j))
#define XB_TOP      3328
#define XB_TOPGEN   3392
#define XCD_BAR_WORDS 3456
#define XB_SPIN_CAP (1u << 22)

__device__ __forceinline__ unsigned xb_ld(unsigned* p)              { return __hip_atomic_load(p, __ATOMIC_RELAXED, __HIP_MEMORY_SCOPE_AGENT); }
__device__ __forceinline__ unsigned xb_add(unsigned* p, unsigned v) { return __hip_atomic_fetch_add(p, v, __ATOMIC_RELAXED, __HIP_MEMORY_SCOPE_AGENT); }
__device__ __forceinline__ unsigned xb_xcc_id() { return (unsigned)__builtin_amdgcn_s_getreg((3 << 11) | 20) & 0xFu; }
#define XB_SPIN(cond, bar) do { unsigned _sp = 0; while (cond) { __builtin_amdgcn_s_sleep(1); \
    if ((++_sp & 255u) == 0u) { if (xb_ld(&(bar)[XB_TMO])) break; if (_sp > XB_SPIN_CAP) { atomicAdd(&(bar)[XB_TMO], 1u); break; } } } } while (0)

struct XcdBarrier {
    unsigned* bar; unsigned x;
    volatile LAS unsigned* st;
};

__device__ __forceinline__ XcdBarrier xcd_barrier_post(unsigned* bar, volatile LAS unsigned* st) {
    XcdBarrier b; b.bar = bar; b.x = xb_xcc_id(); b.st = st;
    if (threadIdx.x == 0) (void)xb_add(&bar[XB_XCNT(b.x)], 1u);
    return b;
}
__device__ __forceinline__ void xcd_barrier_complete(unsigned* bar, unsigned x, unsigned& nloc, unsigned& nx) {
    const unsigned G = gridDim.x * gridDim.y * gridDim.z;
    unsigned sum, cnt, mine, sp = 0u;
    for (;;) {
        sum = 0u; cnt = 0u; mine = 0u;
#pragma unroll
        for (unsigned j = 0; j < 16; ++j) { const unsigned c = xb_ld(&bar[XB_XCNT(j)]); sum += c; cnt += (c > 0u) ? 1u : 0u; mine = (j == x) ? c : mine; }
        if (sum == G) break;
        __builtin_amdgcn_s_sleep(1);
        if ((++sp & 255u) == 0u) { if (xb_ld(&bar[XB_TMO])) break; if (sp > XB_SPIN_CAP) { atomicAdd(&bar[XB_TMO], 1u); break; } }
    }
    nloc = mine > 0u ? mine : 1u; nx = cnt > 0u ? cnt : 1u;
}

__device__ __forceinline__ void xcd_barrier(const XcdBarrier& b) {
    asm volatile("s_waitcnt vmcnt(0)" ::: "memory");
    __syncthreads();
    if (threadIdx.x == 0) {
        unsigned* bar = b.bar;
        __builtin_amdgcn_s_waitcnt(0);
        unsigned nloc = b.st[0], nx = b.st[1];
        if (nloc == 0u) { xcd_barrier_complete(bar, b.x, nloc, nx); b.st[0] = nloc; b.st[1] = nx; }
        const unsigned old = xb_add(&bar[XB_XSUB(b.x)], 1u);
        const unsigned gen = old / nloc;
        if (old + 1u == (gen + 1u) * nloc) {
            __builtin_amdgcn_fence(__ATOMIC_RELEASE, "agent");
            asm volatile("s_waitcnt vmcnt(0)" ::: "memory");
            const unsigned og = xb_add(&bar[XB_TOP], 1u);
            const unsigned tg = og / nx;
            if (og + 1u == (tg + 1u) * nx) xb_add(&bar[XB_TOPGEN], 1u);
            else XB_SPIN(xb_ld(&bar[XB_TOPGEN]) == tg, bar);
            __builtin_amdgcn_fence(__ATOMIC_ACQUIRE, "agent");
            xb_add(&bar[XB_XGEN(b.x)], 1u);
            asm volatile("s_waitcnt vmcnt(0)" ::: "memory");
        } else {
            XB_SPIN(xb_ld(&bar[XB_XGEN(b.x)]) == gen, bar);
            __builtin_amdgcn_fence(__ATOMIC_ACQUIRE, "agent");
            asm volatile("s_waitcnt vmcnt(0)" ::: "memory");
        }
    }
    __syncthreads();
}

constexpr int NPHASES = 26;
#ifdef ONLY_PHASE
#define PH(k) if (((k) == ONLY_PHASE || (k) == ONLY_PHASE2) && a.ph_lo <= (k) && (k) < a.ph_hi)
#else
#define PH(k) if (a.ph_lo <= (k) && (k) < a.ph_hi)
#endif
#ifdef PROBE_LO
#define STAMP(k) do { if (blockIdx.x == 0 && threadIdx.x == 0) ((unsigned long long*)(a.ws + WS_CTL + 24576))[k] = __builtin_amdgcn_s_memrealtime(); } while (0)
#else
#define STAMP(k) do { } while (0)
#endif
#if USE_CG_SYNC
#define SYNC(k) do { if ((k) + 1 < a.ph_hi) cg::this_grid().sync(); } while (0)
#else
#define SYNC(k) do { if ((k) + 1 < a.ph_hi) xcd_barrier(bar); } while (0)
#endif

template <int L> __device__ __forceinline__ void layer_tail(const Args& a, LAS unsigned char* lds, const int base, const XcdBarrier& bar) {
    unsigned char* ws = a.ws; unsigned char* ar = ws + WS_ARENA;
    bf16_t* X = (bf16_t*)(ws + WS_X); float* xstat = (float*)(ws + WS_XSTAT);
    volatile LAS int* tpre = (volatile LAS int*)(lds + 131072);
    PH(base + 0) { STAMP(base + 0); PCrossQ p; p.nM = T / 256; p.nN = 4; p.X = X; p.W = (const bf16_t*)(ws + WS_W_Q) + (size_t)L * D * D; p.xstat = xstat; p.Q2 = (bf16_t*)(ar + AR_Q2); p.qstat = (float*)(ws + WS_QSTAT); p.lda = D; p.ldb = D; p.K = D; run_gemm(lds, p); SYNC(base + 0); }
    PH(base + 1) { STAMP(base + 1); PCrossS p; p.nM = T / 256; p.nN = 4; p.Q2 = (const bf16_t*)(ar + AR_Q2); p.K2 = (const bf16_t*)(ws + WS_K2) + (size_t)L * 2048 * 1024; p.qstat = (const float*)(ws + WS_QSTAT); p.P = (bf16_t*)(ar + AR_P); p.psum = (float*)(ws + WS_PSUM); p.lda = D; p.ldb = 256; p.K = 256; run_gemm(lds, p); SYNC(base + 1); }
    PH(base + 2) { STAMP(base + 2); PCrossPV p; p.nM = T / 256; p.nN = 4; p.P = (const bf16_t*)(ar + AR_P); p.V2T = (const bf16_t*)(ws + WS_V2T) + (size_t)L * 2048 * 1024; p.psum = (const float*)(ws + WS_PSUM); p.O = (bf16_t*)(ar + AR_O); p.lda = D; p.ldb = 256; p.K = 256; run_gemm(lds, p); SYNC(base + 2); }
    PH(base + 3) { STAMP(base + 3); PResid p; p.nM = T / 256; p.nN = 4; p.A = (const bf16_t*)(ar + AR_O); p.W = (const bf16_t*)(ws + WS_W_O) + (size_t)L * D * D; p.X = X; p.xstat = xstat; p.lda = D; p.ldb = D; p.K = D; run_gemm(lds, p); SYNC(base + 3); }
    PH(base + 4) { STAMP(base + 4); PRouter p; p.nM = T / 256; p.nN = 1; p.X = X; p.W = (const bf16_t*)(ws + WS_W_R) + (size_t)L * 256 * D; p.xstat = xstat; p.bg = a.in[I_MBG] + L * 4; p.be = a.in[I_MBE] + L * 32; p.rlog = (float*)(ws + WS_RLOG); p.lda = D; p.ldb = D; p.K = D; run_gemm(lds, p); SYNC(base + 4); }
    PH(base + 5) { STAMP(base + 5); phase_route(a, lds, L); SYNC(base + 5); }
    PH(base + 6) { STAMP(base + 6); PMoeUp p; p.cnt = (const int*)(ws + WS_CTL) + 64 * L; p.list = (const int*)(ws + WS_LIST); p.tpre = tpre; p.X = X; p.W = (const bf16_t*)(ws + WS_W_GU); p.xstat = xstat; p.H = (bf16_t*)(ar + AR_H); p.lda = D; p.ldb = D; p.K = D;
        moe_sched_build(p.cnt, tpre); run_gemm(lds, p); SYNC(base + 6); }
    PH(base + 7) { STAMP(base + 7); PMoeDown p; p.cnt = (const int*)(ws + WS_CTL) + 64 * L; p.list = (const int*)(ws + WS_LIST); p.tpre = tpre; p.H = (const bf16_t*)(ar + AR_H); p.W = (const bf16_t*)(ws + WS_W_DN); p.pairw = (const float*)(ws + WS_PAIRW); p.Y = (bf16_t*)(ar + AR_Y); p.lda = DEXP; p.ldb = DEXP; p.K = DEXP;
        moe_sched_build(p.cnt, tpre); run_gemm(lds, p); SYNC(base + 7); }
    PH(base + 8) { STAMP(base + 8); phase_combine(a, L == 1); SYNC(base + 8); }
}

__global__ void __launch_bounds__(NTHREADS, 2) fwd_kernel(Args a) {
    extern __shared__ __attribute__((aligned(16))) unsigned char lds_raw[];
    LAS unsigned char* lds = (LAS unsigned char*)lds_raw;
    unsigned char* ws = a.ws;
    bf16_t* X = (bf16_t*)(ws + WS_X); float* xstat = (float*)(ws + WS_XSTAT);
    unsigned char* ar = ws + WS_ARENA;
    volatile LAS unsigned* bst = (volatile LAS unsigned*)(lds + 131072 + 256);
    if (threadIdx.x < 2) bst[threadIdx.x] = 0u;
    __syncthreads();
    XcdBarrier bar = xcd_barrier_post((unsigned*)(ws + WS_CTL + 4096), bst);
    PH(0) { STAMP(0); phase_prologue(a, lds);
#if defined(REPEAT_PRO)
        __syncthreads(); phase_prologue(a, lds);
#endif
        SYNC(0); }
    PH(1) { STAMP(1);
        phase_cumsum(a, lds);
        { PInProj0 p; p.nM = T / 256; p.nN = 10; p.X = X; p.W = (const bf16_t*)(ws + WS_W_IN0); p.xstat = xstat; p.qg = a.in[I_AQG]; p.kg = a.in[I_AKG];
          p.Q = (bf16_t*)(ar + AR_Q); p.Kq = (bf16_t*)(ar + AR_K); p.V = (bf16_t*)(ar + AR_V); p.XB = (bf16_t*)(ar + AR_XB); p.GATE = (bf16_t*)(ar + AR_GATE); p.lda = D; p.ldb = D; p.K = D;
          run_gemm(lds, p); }
        { PMemKV m; m.nM = 8; m.nN = 16; m.A = (const bf16_t*)(ws + WS_MEMB); m.W = (const bf16_t*)(ws + WS_W_KV); m.memstat = (const float*)(ws + WS_MISC + MISC_MEMSTAT);
          m.k2stat_ = (float*)(ws + WS_MISC + MISC_K2STAT); m.K2_ = (bf16_t*)(ws + WS_K2); m.V2T_ = (bf16_t*)(ws + WS_ARENA + AR_V2TMP); m.lda = D; m.ldb = D; m.K = D;
          run_gemm(lds, m); }
        SYNC(1);
    }
    PH(2) { STAMP(2); phase_k2fin(a); phase_lru(a, lds, 0);
#if defined(REPEAT_LRU)
        phase_lru(a, lds, 0);
#endif
        SYNC(2); }
    PH(3) { STAMP(3); phase_lru(a, lds, 1);
#if FAST_ATTN
        { const attn_body::AttnTensors AT{(const attn_body::bf16*)(ar + AR_Q), (const attn_body::bf16*)(ar + AR_K), (const attn_body::bf16*)(ar + AR_V), (attn_body::bf16*)(ar + AR_AR), (const float*)(ws + WS_CSUM)};
          __syncthreads(); attn_body::attn_phase<ATTN_THRL>((char*)lds_raw, AT); __syncthreads(); }
#else
        phase_attn_naive(a);
#endif
        SYNC(3); }
    PH(4) { STAMP(4); PResid p; p.nM = T / 256; p.nN = 4; p.A = (const bf16_t*)(ar + AR_AR); p.W = (const bf16_t*)(ws + WS_W_OUT0); p.X = X; p.xstat = xstat; p.lda = D; p.ldb = D; p.K = D; run_gemm(lds, p); SYNC(4); }
    layer_tail<0>(a, lds, 5, bar);
    PH(14) { STAMP(14); conv_moe_layer(a, 1);
        PInProj1 p; p.nM = T / 256; p.nN = 16; p.X = X; p.W = (const bf16_t*)(ws + WS_W_IN1); p.xstat = xstat; p.bias = a.in[I_CBIN]; p.Ub = (bf16_t*)(ar + AR_U); p.V3 = (bf16_t*)(ar + AR_V3); p.vstat = (float*)(ws + WS_VSTAT); p.lda = D; p.ldb = D; p.K = D;
        __syncthreads(); run_gemm(lds, p); SYNC(14); }
#if FAST_MIX
    PH(15) { STAMP(15); phase_mix_fast(a, lds); SYNC(15); }
#else
    PH(15) { STAMP(15); phase_mix_naive(a, lds); SYNC(15); }
#endif
    PH(16) { STAMP(16); PResid p; p.nM = T / 256; p.nN = 4; p.A = (const bf16_t*)(ar + AR_U); p.W = (const bf16_t*)(ws + WS_W_OUT1); p.X = X; p.xstat = xstat; p.lda = CW; p.ldb = CW; p.K = CW; run_gemm(lds, p); SYNC(16); }
    layer_tail<1>(a, lds, 17, bar);
#ifdef PROBE_LO
    __syncthreads();
    if (blockIdx.x == 0 && threadIdx.x == 0) { STAMP(26); const unsigned long long* ts = (const unsigned long long*)(a.ws + WS_CTL + 24576);
        a.out[0] = 10.f + (float)(ts[PROBE_HI + 1] - ts[PROBE_LO]) / (100.f * PROBE_DIV); }
#endif
}

extern "C" void kernel_launch(void* const* d_in, const int* in_sizes, int n_in, void* d_out, int out_size, void* d_ws, size_t ws_size, hipStream_t stream) {
    static int grid = 0;
    if (grid == 0) {
        if (n_in != 36 || out_size != T * D || ws_size < WS_END) { fprintf(stderr, "kernel_launch: unexpected sizes n_in %d out %d ws %zu\n", n_in, out_size, ws_size); grid = -1; return; }
        int dev = 0, cus = 0, per_cu = 0;
        hipGetDevice(&dev); hipDeviceGetAttribute(&cus, hipDeviceAttributeMultiprocessorCount, dev);
        hipFuncSetAttribute((const void*)fwd_kernel, hipFuncAttributeMaxDynamicSharedMemorySize, LDS_BYTES);
        hipOccupancyMaxActiveBlocksPerMultiprocessor(&per_cu, (const void*)fwd_kernel, NTHREADS, LDS_BYTES);
        if (per_cu < 1) { fprintf(stderr, "kernel_launch: occupancy query says %d blocks per CU\n", per_cu); per_cu = 1; }
        (void)hipGetLastError();
        grid = cus;
    }
    if (grid < 0) return;
    (void)hipMemsetAsync((char*)d_ws + WS_CTL, 0, 32768, stream);
    Args a{};
    for (int i = 0; i < 36; ++i) a.in[i] = (const float*)d_in[i];
    a.out = (float*)d_out; a.ws = (unsigned char*)d_ws;
#if ONE_LAUNCH
    a.ph_lo = 0; a.ph_hi = NPHASES;
#if USE_CG_SYNC
    void* args[] = {&a};
    hipError_t e = hipLaunchCooperativeKernel((const void*)fwd_kernel, dim3(grid), dim3(NTHREADS), args, LDS_BYTES, stream);
    if (e != hipSuccess) fprintf(stderr, "cooperative launch failed: %s (grid %d)\n", hipGetErrorString(e), grid);
#else
    hipLaunchKernelGGL(fwd_kernel, dim3(grid), dim3(NTHREADS), LDS_BYTES, stream, a);
#endif
#else
    for (int ph = 0; ph < NPHASES; ++ph) { a.ph_lo = ph; a.ph_hi = ph + 1; hipLaunchKernelGGL(fwd_kernel, dim3(grid), dim3(NTHREADS), LDS_BYTES, stream, a); }
#endif
}
```

```cpp
#include <hip/hip_runtime.h>
#include <hip/hip_cooperative_groups.h>
#include <cstdint>
#include <cstdio>
namespace cg = cooperative_groups;

#ifndef FAST_CORE
#define FAST_CORE 1
#endif
#ifndef FAST_LRU
#define FAST_LRU 1
#endif
#ifndef FAST_MIX
#define FAST_MIX 1
#endif
#ifndef USE_CG_SYNC
#define USE_CG_SYNC 0
#endif
#ifndef FAST_ATTN
#define FAST_ATTN 1
#endif
#ifndef ATTN_THRL
#define ATTN_THRL 32
#endif
#ifndef ONLY_PHASE2
#define ONLY_PHASE2 -1
#endif
#ifndef ONE_LAUNCH
#define ONE_LAUNCH 1
#endif

#define LAS __attribute__((address_space(3)))
typedef unsigned short bf16_t;
typedef short bf16x8 __attribute__((ext_vector_type(8)));
typedef float f32x4 __attribute__((ext_vector_type(4)));
typedef float f32x2 __attribute__((ext_vector_type(2)));
typedef unsigned u32x4 __attribute__((ext_vector_type(4)));
typedef unsigned u32x2 __attribute__((ext_vector_type(2)));

constexpr int NB = 8, SEQ = 4096, T = NB * SEQ, D = 1024;
constexpr int AH = 8, HD = 64, AW = 512, BW = 512;
constexpr int INAB = 2568;
constexpr int CW = 2048, CG = 8, CCH = 128;
constexpr int MEML = 256, XH = 4, XHD = 256;
constexpr int NGRP = 4, EPG = 8, NEXP = 32, DEXP = 512;
constexpr float EPS = 1e-6f;
constexpr float LOG2E = 1.4426950408889634f;
constexpr float C2 = 0.125f * LOG2E;
constexpr float C3 = 0.0625f * LOG2E;
constexpr int NTHREADS = 512, NWAVES = 8;
constexpr int LDS_BYTES = 147456;

constexpr size_t MiB = 1ull << 20;
constexpr size_t WS_CTL = 0;
constexpr size_t WS_W_IN0 = 1 * MiB, WS_W_OUT0 = 6 * MiB, WS_W_IN1 = 8 * MiB, WS_W_OUT1 = 16 * MiB;
constexpr size_t WS_W_Q = 20 * MiB, WS_W_KV = 24 * MiB, WS_W_O = 32 * MiB, WS_W_R = 36 * MiB, WS_TRIL = 37 * MiB;
constexpr size_t WS_WLRU = 37 * MiB + 512 * 1024;
constexpr size_t WS_W_GU = 38 * MiB, WS_W_DN = 102 * MiB;
constexpr size_t WS_X = 134 * MiB, WS_MEMB = 198 * MiB, WS_K2 = 202 * MiB, WS_V2T = 210 * MiB;
constexpr size_t WS_XSTAT = 218 * MiB, WS_VSTAT = 220 * MiB, WS_QSTAT = 224 * MiB, WS_PSUM = 226 * MiB;
constexpr size_t WS_FLOG = 228 * MiB, WS_CSUM = 229 * MiB, WS_LSUM = 230 * MiB, WS_MISC = 231 * MiB;
constexpr size_t WS_RLOG = 232 * MiB, WS_PAIRW = 238 * MiB, WS_LIST = 239 * MiB, WS_ARENA = 248 * MiB, WS_VW = 504 * MiB, WS_LISTS = 536 * MiB, WS_LISTW = 544 * MiB, WS_END = 552 * MiB;
constexpr size_t AR_Q = 0, AR_K = 32 * MiB, AR_V = 64 * MiB, AR_XB = 96 * MiB, AR_GATE = 128 * MiB, AR_AR = 160 * MiB;
constexpr size_t AR_V2TMP = 224 * MiB;
constexpr size_t AR_Q2 = 0, AR_P = 64 * MiB, AR_O = 128 * MiB;
constexpr size_t AR_H = 0, AR_Y = 64 * MiB;
constexpr size_t AR_U = 0, AR_V3 = 128 * MiB;
constexpr size_t MISC_MEMSTAT = 0, MISC_K2STAT = 65536;

struct Args { const float* in[36]; float* out; unsigned char* ws; int ph_lo, ph_hi; };
#define AIN(i) (((const float* const __attribute__((address_space(4)))*)__builtin_amdgcn_kernarg_segment_ptr())[i])
enum { I_X = 0, I_MEM, I_NMIX, I_NCROSS, I_NMEM, I_NFFN, I_ABWIN, I_FBIAS, I_AQG, I_AKG, I_CONVW, I_CONVB, I_WA, I_BA, I_WX, I_BX, I_LAM, I_ABWOUT,
       I_CWIN, I_CBIN, I_CVG, I_CWS, I_CBS, I_CWOUT, I_XWQ, I_XWKV, I_XWO, I_XQG, I_XKG, I_MWG, I_MBG, I_MWE, I_MBE, I_MGATE, I_MUP, I_MDOWN };

__device__ __forceinline__ float bf_lo(unsigned u) { return __uint_as_float(u << 16); }
__device__ __forceinline__ float bf_hi(unsigned u) { return __uint_as_float(u & 0xffff0000u); }
__device__ __forceinline__ float bf2f(bf16_t v) { return __uint_as_float((unsigned)v << 16); }
__device__ __forceinline__ unsigned pk2(float lo, float hi) { typedef __bf16 bf2_t __attribute__((ext_vector_type(2))); f32x2 v = {lo, hi}; bf2_t b = __builtin_convertvector(v, bf2_t); return __builtin_bit_cast(unsigned, b); }
__device__ __forceinline__ bf16_t f2bf(float f) { return (bf16_t)(pk2(f, 0.f) & 0xffffu); }
__device__ __forceinline__ float wave_sum(float v) {
#pragma unroll
    for (int o = 1; o < 64; o <<= 1) v += __shfl_xor(v, o);
    return v;
}
__device__ __forceinline__ float frcp(float x) { return __builtin_amdgcn_rcpf(x); }
__device__ __forceinline__ float frsq(float x) { return __builtin_amdgcn_rsqf(x); }
__device__ __forceinline__ float fexp2(float x) { return __builtin_amdgcn_exp2f(x); }
__device__ __forceinline__ float gelu_tanh(float x) { const float t = x * x; const float y = x * (-0.10294324f * t + -2.3022082f); return x * frcp(1.f + fexp2(y)); }
__device__ __forceinline__ float sigmoidf(float x) { return frcp(1.f + fexp2(-LOG2E * x)); }
__device__ __forceinline__ float rowscale16(const float* stat, int row, int fq, float invn) { const f32x4 a = *(const f32x4*)(stat + (size_t)row * 16 + 4 * fq); float t = (a.x + a.y) + (a.z + a.w); t += __shfl_xor(t, 16); t += __shfl_xor(t, 32); return frsq(t * invn + EPS); }
__device__ __forceinline__ float sum16(const float* p) { const f32x4 a = *(const f32x4*)p, b = *(const f32x4*)(p + 4), c = *(const f32x4*)(p + 8), d = *(const f32x4*)(p + 12);
    return ((a.x + a.y) + (a.z + a.w)) + ((b.x + b.y) + (b.z + b.w)) + ((c.x + c.y) + (c.z + c.w)) + ((d.x + d.y) + (d.z + d.w)); }
__device__ __forceinline__ int perm32(int rho) { const int n = rho >> 4, i = rho & 15; return 8 * (i >> 2) + 4 * n + (i & 3); }

struct U { int pm, pn, e, cnt; };
__device__ __forceinline__ int brow_std(int bj, int S) { return 64 * (S >> 5) + 32 * bj + perm32(S & 31); }
typedef f32x4 Acc[2][2][4][2];

template <class P> __device__ __forceinline__ void gemm_naive(const P& p) {
    const int tid = threadIdx.x, wid = tid >> 6, lane = tid & 63, wr = wid >> 2, wc = wid & 3, fr = lane & 15, fq = lane >> 4;
    for (int i = 0;; ++i) {
        U u; if (!p.unit(i * (int)gridDim.x + (int)blockIdx.x, u)) break;
        Acc acc;
#pragma unroll
        for (int a = 0; a < 2; ++a)
#pragma unroll
            for (int b = 0; b < 2; ++b)
#pragma unroll
                for (int m = 0; m < 4; ++m)
#pragma unroll
                    for (int n = 0; n < 2; ++n) acc[a][b][m][n] = (f32x4){0.f, 0.f, 0.f, 0.f};
        const bf16_t* A = p.a_ptr(u); const bf16_t* B = p.b_ptr(u); const int lda = p.lda, ldb = p.ldb, K = p.K;
        unsigned aoff[8], boff[16];
#pragma unroll
        for (int ai = 0; ai < 2; ++ai)
#pragma unroll
            for (int m = 0; m < 4; ++m) aoff[ai * 4 + m] = (unsigned)p.a_row(u, 128 * ai + 64 * wr + 16 * m + fr) * (unsigned)lda;
#pragma unroll
        for (int bj = 0; bj < 2; ++bj)
#pragma unroll
            for (int n = 0; n < 2; ++n)
#pragma unroll
                for (int e = 0; e < 4; ++e) boff[bj * 8 + n * 4 + e] = (unsigned)P::b_row(bj, 32 * wc + 16 * n + 4 * fq + e) * (unsigned)ldb;
        for (int k0 = 0; k0 < K; k0 += 2) {
            float af[8][2];
#pragma unroll
            for (int r = 0; r < 8; ++r) { const unsigned v = *(const unsigned*)(A + aoff[r] + k0); af[r][0] = bf_lo(v); af[r][1] = bf_hi(v); }
#pragma unroll
            for (int bj = 0; bj < 2; ++bj)
#pragma unroll
                for (int n = 0; n < 2; ++n)
#pragma unroll
                    for (int e = 0; e < 4; ++e) {
                        const unsigned v = *(const unsigned*)(B + boff[bj * 8 + n * 4 + e] + k0);
                        const float b0 = bf_lo(v), b1 = bf_hi(v);
#pragma unroll
                        for (int ai = 0; ai < 2; ++ai)
#pragma unroll
                            for (int m = 0; m < 4; ++m) { const float* x = af[ai * 4 + m]; acc[ai][bj][m][n][e] += x[0] * b0 + x[1] * b1; }
                    }
        }
        p.epi(acc, u, wr, wc, fr, fq);
    }
}

__device__ __forceinline__ int xcd_remap(int L, int nwg) { const int q = nwg >> 3, r = nwg & 7, xcd = L & 7, off = L >> 3; return (xcd < r ? xcd * (q + 1) : r * (q + 1) + (xcd - r) * q) + off; }
struct PlainSched {
    int nM, nN;
    __device__ __forceinline__ bool unit(int L, U& u) const {
        const int nwg = nM * nN; if (L >= nwg) return false;
        const int wgid = xcd_remap(L, nwg);
        const int nig = 8 * nN, gid = wgid / nig, fm = gid * 8, gsz = (nM - fm) < 8 ? (nM - fm) : 8, w = wgid - gid * nig;
        u.pn = w / gsz; u.pm = fm + (w - u.pn * gsz); u.e = 0; u.cnt = 0; return true;
    }
};

struct PInProj0 : PlainSched {
    static constexpr bool GATHER = false; static constexpr int ID = 0;
    const bf16_t* X; const bf16_t* W; const float* xstat; const float* qg; const float* kg; bf16_t *Q, *Kq, *V, *XB, *GATE; int lda, ldb, K;
    __device__ __forceinline__ const bf16_t* a_ptr(const U& u) const { return X + (size_t)u.pm * 256 * D; }
    __device__ __forceinline__ int a_row(const U&, int R) const { return R; }
    __device__ __forceinline__ const bf16_t* b_ptr(const U& u) const { return W + (size_t)u.pn * 256 * D; }
    static __device__ __forceinline__ int b_row(int bj, int S) { return brow_std(bj, S); }
    __device__ __forceinline__ void epi(Acc& acc, const U& u, int wr, int wc, int fr, int fq) const {
        const int kind = u.pn >> 1, half = u.pn & 1;
        bf16_t* dst = kind == 0 ? Q : kind == 1 ? Kq : kind == 2 ? V : kind == 3 ? XB : GATE;
        const float* gain = kind == 0 ? qg : kg;
        float sc[8];
#pragma unroll
        for (int ai = 0; ai < 2; ++ai)
#pragma unroll
            for (int m = 0; m < 4; ++m) {
                const int row = u.pm * 256 + 128 * ai + 64 * wr + 16 * m + fr;
                const float s = rowscale16(xstat, row, fq, 1.f / D);
                float r = s;
                if (kind <= 1) {
                    float ss = 0.f;
#pragma unroll
                    for (int bj = 0; bj < 2; ++bj)
#pragma unroll
                        for (int n = 0; n < 2; ++n)
#pragma unroll
                            for (int e = 0; e < 4; ++e) { const float v = acc[ai][bj][m][n][e] * s; ss += v * v; }
                    ss += __shfl_xor(ss, 16); ss += __shfl_xor(ss, 32);
                    r = s * frsq(ss * (1.f / HD) + EPS) * (kind == 0 ? C2 : 1.f);
                }
                sc[ai * 4 + m] = r;
            }
#pragma unroll
        for (int bj = 0; bj < 2; ++bj) {
            float g[8];
#pragma unroll
            for (int j = 0; j < 8; ++j) g[j] = kind <= 1 ? gain[32 * bj + 8 * fq + j] : 1.f;
#pragma unroll
            for (int ai = 0; ai < 2; ++ai)
#pragma unroll
                for (int m = 0; m < 4; ++m) {
                    const int row = u.pm * 256 + 128 * ai + 64 * wr + 16 * m + fr;
                    float v[8];
#pragma unroll
                    for (int j = 0; j < 8; ++j) v[j] = acc[ai][bj][m][j >> 2][j & 3] * sc[ai * 4 + m] * g[j];
                    if (kind == 4) {
#pragma unroll
                        for (int j = 0; j < 8; ++j) v[j] = gelu_tanh(v[j]);
                    }
                    u32x4 w; w.x = pk2(v[0], v[1]); w.y = pk2(v[2], v[3]); w.z = pk2(v[4], v[5]); w.w = pk2(v[6], v[7]);
                    *(u32x4*)(dst + (size_t)row * 512 + 256 * half + 64 * wc + 32 * bj + 8 * fq) = w;
                }
        }
    }
};

struct PMemKV : PlainSched {
    static constexpr bool GATHER = false; static constexpr int ID = 1;
    const bf16_t* A; const bf16_t* W; const float* memstat; float* k2stat_; bf16_t* K2_; bf16_t* V2T_; int lda, ldb, K;
    __device__ __forceinline__ const bf16_t* a_ptr(const U& u) const { return A + (size_t)u.pm * 256 * D; }
    __device__ __forceinline__ int a_row(const U&, int R) const { return R; }
    __device__ __forceinline__ const bf16_t* b_ptr(const U& u) const { return W + (size_t)u.pn * 256 * D; }
    static __device__ __forceinline__ int b_row(int bj, int S) { return brow_std(bj, S); }
    __device__ __forceinline__ void epi(Acc& acc, const U& u, int wr, int wc, int fr, int fq) const {
        const int b = u.pm, h = u.pn & 3, ly = u.pn >> 3; const bool isv = (u.pn & 4) != 0;
        float* k2stat = k2stat_ + (size_t)ly * 2048 * 16; bf16_t* K2 = K2_ + (size_t)ly * 2048 * 1024; bf16_t* V2T = V2T_ + (size_t)ly * 2048 * 1024;
        bf16_t* dst = (isv ? V2T : K2) + (size_t)(b * 4 + h) * 65536;
        int lrow = 64 * wr + fr; asm volatile("" : "+v"(lrow));
#pragma unroll
        for (int ai = 0; ai < 2; ++ai)
#pragma unroll
            for (int m = 0; m < 4; ++m) {
                const int key = 128 * ai + 16 * m + lrow, row = b * 256 + key;
                const float s = frsq(memstat[row] * (1.f / D) + EPS);
                float ss = 0.f;
#pragma unroll
                for (int bj = 0; bj < 2; ++bj) {
                    float v[8];
#pragma unroll
                    for (int j = 0; j < 8; ++j) { v[j] = acc[ai][bj][m][j >> 2][j & 3] * s; ss += v[j] * v[j]; }
                    u32x4 w; w.x = pk2(v[0], v[1]); w.y = pk2(v[2], v[3]); w.z = pk2(v[4], v[5]); w.w = pk2(v[6], v[7]);
                    *(u32x4*)(dst + (size_t)key * 256 + 64 * wc + 32 * bj + 8 * fq) = w;
                }
                ss += __shfl_xor(ss, 16); ss += __shfl_xor(ss, 32);
                if (fq == 0 && !isv) k2stat[(size_t)row * 16 + 4 * h + wc] = ss;
            }
    }
};

struct PResid : PlainSched {
    static constexpr bool GATHER = false; static constexpr int ID = 2;
    const bf16_t* A; const bf16_t* W; bf16_t* X; float* xstat; int lda, ldb, K; size_t bstride;
    __device__ __forceinline__ const bf16_t* a_ptr(const U& u) const { return A + (size_t)u.pm * 256 * lda; }
    __device__ __forceinline__ int a_row(const U&, int R) const { return R; }
    __device__ __forceinline__ const bf16_t* b_ptr(const U& u) const { return W + (size_t)(u.pm >> 4) * bstride + (size_t)u.pn * 256 * ldb; }
    static __device__ __forceinline__ int b_row(int bj, int S) { return brow_std(bj, S); }
    __device__ __forceinline__ void epi(Acc& acc, const U& u, int wr, int wc, int fr, int fq) const {
#pragma unroll
        for (int ai = 0; ai < 2; ++ai)
#pragma unroll
            for (int m = 0; m < 4; ++m) {
                const int row = u.pm * 256 + 128 * ai + 64 * wr + 16 * m + fr; float ss = 0.f;
#pragma unroll
                for (int bj = 0; bj < 2; ++bj) {
                    bf16_t* xp = X + (size_t)row * D + 256 * u.pn + 64 * wc + 32 * bj + 8 * fq;
                    const u32x4 o = *(const u32x4*)xp;
                    float v[8] = {bf_lo(o.x), bf_hi(o.x), bf_lo(o.y), bf_hi(o.y), bf_lo(o.z), bf_hi(o.z), bf_lo(o.w), bf_hi(o.w)};
#pragma unroll
                    for (int n = 0; n < 2; ++n)
#pragma unroll
                        for (int e = 0; e < 4; ++e) v[n * 4 + e] += acc[ai][bj][m][n][e];
                    u32x4 w; w.x = pk2(v[0], v[1]); w.y = pk2(v[2], v[3]); w.z = pk2(v[4], v[5]); w.w = pk2(v[6], v[7]);
                    *(u32x4*)xp = w;
                    const float r[8] = {bf_lo(w.x), bf_hi(w.x), bf_lo(w.y), bf_hi(w.y), bf_lo(w.z), bf_hi(w.z), bf_lo(w.w), bf_hi(w.w)};
#pragma unroll
                    for (int j = 0; j < 8; ++j) ss += r[j] * r[j];
                }
                ss += __shfl_xor(ss, 16); ss += __shfl_xor(ss, 32);
                if (fq == 0) xstat[(size_t)row * 16 + 4 * u.pn + wc] = ss;
            }
    }
};

struct PCrossQ : PlainSched {
    static constexpr bool GATHER = false; static constexpr int ID = 3;
    const bf16_t* X; const bf16_t* W; const float* xstat; bf16_t* Q2; float* qstat; int lda, ldb, K;
    __device__ __forceinline__ const bf16_t* a_ptr(const U& u) const { return X + (size_t)u.pm * 256 * D; }
    __device__ __forceinline__ int a_row(const U&, int R) const { return R; }
    __device__ __forceinline__ const bf16_t* b_ptr(const U& u) const { return W + (size_t)u.pn * 256 * D; }
    static __device__ __forceinline__ int b_row(int bj, int S) { return brow_std(bj, S); }
    __device__ __forceinline__ void epi(Acc& acc, const U& u, int wr, int wc, int fr, int fq) const {
#pragma unroll
        for (int ai = 0; ai < 2; ++ai)
#pragma unroll
            for (int m = 0; m < 4; ++m) {
                const int row = u.pm * 256 + 128 * ai + 64 * wr + 16 * m + fr; float ss = 0.f;
                const float s = rowscale16(xstat, row, fq, 1.f / D);
#pragma unroll
                for (int bj = 0; bj < 2; ++bj) {
                    float v[8];
#pragma unroll
                    for (int n = 0; n < 2; ++n)
#pragma unroll
                        for (int e = 0; e < 4; ++e) v[n * 4 + e] = acc[ai][bj][m][n][e] * s;
                    u32x4 w; w.x = pk2(v[0], v[1]); w.y = pk2(v[2], v[3]); w.z = pk2(v[4], v[5]); w.w = pk2(v[6], v[7]);
                    *(u32x4*)(Q2 + (size_t)row * D + 256 * u.pn + 64 * wc + 32 * bj + 8 * fq) = w;
                    const float r[8] = {bf_lo(w.x), bf_hi(w.x), bf_lo(w.y), bf_hi(w.y), bf_lo(w.z), bf_hi(w.z), bf_lo(w.w), bf_hi(w.w)};
#pragma unroll
                    for (int j = 0; j < 8; ++j) ss += r[j] * r[j];
                }
                ss += __shfl_xor(ss, 16); ss += __shfl_xor(ss, 32);
                if (fq == 0) qstat[(size_t)row * 16 + 4 * u.pn + wc] = ss;
            }
    }
};

struct PCrossS : PlainSched {
    static constexpr bool GATHER = false; static constexpr int ID = 4;
    const bf16_t* Q2; const bf16_t* K2; const float* qstat; bf16_t* P; LAS float* xs; int lda, ldb, K;
    __device__ __forceinline__ const bf16_t* a_ptr(const U& u) const { return Q2 + (size_t)u.pm * 256 * D + 256 * u.pn; }
    __device__ __forceinline__ int a_row(const U&, int R) const { return R; }
    __device__ __forceinline__ const bf16_t* b_ptr(const U& u) const { return K2 + (size_t)((u.pm >> 4) * 4 + u.pn) * 65536; }
    static __device__ __forceinline__ int b_row(int bj, int S) { return brow_std(bj, S); }
    __device__ __forceinline__ void epi(Acc& acc, const U& u, int wr, int wc, int fr, int fq) const {
#pragma unroll
        for (int ai = 0; ai < 2; ++ai)
#pragma unroll
            for (int m = 0; m < 4; ++m) {
                const int lr = 128 * ai + 64 * wr + 16 * m + fr, row = u.pm * 256 + lr; float ss = 0.f;
                const f32x4 qs = *(const f32x4*)(qstat + (size_t)row * 16 + 4 * u.pn);
                const float rn = frsq(((qs.x + qs.y) + (qs.z + qs.w)) * (1.f / XHD) + EPS) * C3;
#pragma unroll
                for (int bj = 0; bj < 2; ++bj)
#pragma unroll
                    for (int n = 0; n < 2; ++n)
#pragma unroll
                        for (int e = 0; e < 4; ++e) { const float v = fexp2(acc[ai][bj][m][n][e] * rn); acc[ai][bj][m][n][e] = v; ss += v; }
                ss += __shfl_xor(ss, 16); ss += __shfl_xor(ss, 32);
                if (fq == 0) xs[lr * 4 + wc] = ss;
            }
        asm volatile("s_waitcnt lgkmcnt(0)" ::: "memory"); __builtin_amdgcn_s_barrier(); asm volatile("" ::: "memory");
#pragma unroll
        for (int ai = 0; ai < 2; ++ai)
#pragma unroll
            for (int m = 0; m < 4; ++m) {
                const int lr = 128 * ai + 64 * wr + 16 * m + fr, row = u.pm * 256 + lr;
                const f32x4 ps = *(const LAS f32x4*)(xs + lr * 4);
                const float inv = frcp((ps.x + ps.y) + (ps.z + ps.w));
#pragma unroll
                for (int bj = 0; bj < 2; ++bj) {
                    float v[8];
#pragma unroll
                    for (int j = 0; j < 8; ++j) v[j] = acc[ai][bj][m][j >> 2][j & 3] * inv;
                    u32x4 w; w.x = pk2(v[0], v[1]); w.y = pk2(v[2], v[3]); w.z = pk2(v[4], v[5]); w.w = pk2(v[6], v[7]);
                    *(u32x4*)(P + (size_t)row * D + 256 * u.pn + 64 * wc + 32 * bj + 8 * fq) = w;
                }
            }
        asm volatile("s_waitcnt lgkmcnt(0)" ::: "memory"); __builtin_amdgcn_s_barrier(); asm volatile("" ::: "memory");
    }
};

struct PVW {
    static constexpr bool GATHER = false; static constexpr int ID = 5;
    const bf16_t* WO; const bf16_t* V2; bf16_t* VW; int lda, ldb, K;
    __device__ __forceinline__ bool unit(int L, U& u) const { if (L >= 256) return false; u.pm = L & 3; u.pn = (L >> 2) & 3; u.e = L >> 4; u.cnt = 0; return true; }
    __device__ __forceinline__ const bf16_t* a_ptr(const U& u) const { return WO + (size_t)(u.e >> 3) * D * D + (size_t)u.pm * 256 * D + 256 * u.pn; }
    __device__ __forceinline__ int a_row(const U&, int R) const { return R; }
    __device__ __forceinline__ const bf16_t* b_ptr(const U& u) const { return V2 + (size_t)(u.e * 4 + u.pn) * 65536; }
    static __device__ __forceinline__ int b_row(int bj, int S) { return brow_std(bj, S); }
    __device__ __forceinline__ void epi(Acc& acc, const U& u, int wr, int wc, int fr, int fq) const {
        int lrow = 64 * wr + fr; asm volatile("" : "+v"(lrow));
#pragma unroll
        for (int ai = 0; ai < 2; ++ai)
#pragma unroll
            for (int m = 0; m < 4; ++m) {
                const int n = 256 * u.pm + 128 * ai + 16 * m + lrow;
#pragma unroll
                for (int bj = 0; bj < 2; ++bj) {
                    u32x4 w; w.x = pk2(acc[ai][bj][m][0][0], acc[ai][bj][m][0][1]); w.y = pk2(acc[ai][bj][m][0][2], acc[ai][bj][m][0][3]); w.z = pk2(acc[ai][bj][m][1][0], acc[ai][bj][m][1][1]); w.w = pk2(acc[ai][bj][m][1][2], acc[ai][bj][m][1][3]);
                    *(u32x4*)(VW + ((size_t)u.e * D + n) * D + 256 * u.pn + 64 * wc + 32 * bj + 8 * fq) = w;
                }
            }
    }
};

struct PRouter : PlainSched {
    static constexpr bool GATHER = false; static constexpr int ID = 6;
    const bf16_t* X; const bf16_t* W; const float* xstat; const float* bg; const float* be; float* rlog; int lda, ldb, K;
    __device__ __forceinline__ const bf16_t* a_ptr(const U& u) const { return X + (size_t)u.pm * 256 * D; }
    __device__ __forceinline__ int a_row(const U&, int R) const { return R; }
    __device__ __forceinline__ const bf16_t* b_ptr(const U&) const { return W; }
    static __device__ __forceinline__ int b_row(int bj, int S) { return brow_std(bj, S); }
    __device__ __forceinline__ void epi(Acc& acc, const U& u, int wr, int wc, int fr, int fq) const {
        if (wc != 0) return;
#pragma unroll
        for (int ai = 0; ai < 2; ++ai)
#pragma unroll
            for (int m = 0; m < 4; ++m) {
                const int row = u.pm * 256 + 128 * ai + 64 * wr + 16 * m + fr;
                const float s = rowscale16(xstat, row, fq, 1.f / D);
#pragma unroll
                for (int n = 0; n < 2; ++n)
#pragma unroll
                    for (int e = 0; e < 4; ++e) { const int c = 8 * fq + 4 * n + e; rlog[(size_t)row * 40 + c] = acc[ai][0][m][n][e] * s + (c < 4 ? bg[c] : be[c - 4]); }
                if (fq == 0) {
#pragma unroll
                    for (int e = 0; e < 4; ++e) rlog[(size_t)row * 40 + 32 + e] = acc[ai][1][m][0][e] * s + be[28 + e];
                }
            }
    }
};

struct MoeSched {
    const int* cnt; const int* list; const float* lists; const float* listw; volatile LAS int* tpre;
    __device__ __forceinline__ bool unit(int L, U& u) const {
        const int nwg = tpre[32] * 4; if (L >= nwg) return false;
        L = xcd_remap(L, nwg);
        const int mt = L >> 2;
        int e = 0;
        for (int j = 1; j < 32; ++j) e = (mt >= tpre[j]) ? j : e;
        u.e = e; u.pm = mt - tpre[e]; u.pn = L & 3; u.cnt = cnt[e]; return true;
    }
    __device__ __forceinline__ size_t slot_of(const U& u, int R) const { int s = u.pm * 256 + R; s = s < u.cnt ? s : u.cnt - 1; return (size_t)u.e * 65536 + s; }
    __device__ __forceinline__ int pair_of(const U& u, int R) const { return list[slot_of(u, R)]; }
};
__device__ __forceinline__ void moe_sched_build(const int* cnt, volatile LAS int* tpre) {
    __syncthreads();
    if (threadIdx.x == 0) { int acc = 0; for (int e = 0; e < 32; ++e) { tpre[e] = acc; acc += (cnt[e] + 255) >> 8; } tpre[32] = acc; }
    __syncthreads();
}
struct PMoeUp : MoeSched {
    static constexpr bool GATHER = true; static constexpr int ID = 7;
    const bf16_t* X; const bf16_t* W; const float* xstat; bf16_t* H; int lda, ldb, K;
    __device__ __forceinline__ const bf16_t* a_ptr(const U&) const { return X; }
    __device__ __forceinline__ int a_row(const U& u, int R) const { return pair_of(u, R) >> 1; }
    __device__ __forceinline__ const bf16_t* b_ptr(const U& u) const { return W + (size_t)u.e * (1024 * 1024) + (size_t)u.pn * 128 * 1024; }
    static __device__ __forceinline__ int b_row(int bj, int S) { return 512 * bj + 32 * (S >> 5) + perm32(S & 31); }
    __device__ __forceinline__ void epi(Acc& acc, const U& u, int wr, int wc, int fr, int fq) const {
#pragma unroll
        for (int ai = 0; ai < 2; ++ai)
#pragma unroll
            for (int m = 0; m < 4; ++m) {
                const size_t sl = slot_of(u, 128 * ai + 64 * wr + 16 * m + fr); const int pr = list[sl]; const float s = lists[sl];
                float v[8];
#pragma unroll
                for (int n = 0; n < 2; ++n)
#pragma unroll
                    for (int e = 0; e < 4; ++e) { const float g = acc[ai][0][m][n][e] * s, up = acc[ai][1][m][n][e] * s; v[n * 4 + e] = g * frcp(1.f + fexp2(-LOG2E * g)) * up; }
                u32x4 w; w.x = pk2(v[0], v[1]); w.y = pk2(v[2], v[3]); w.z = pk2(v[4], v[5]); w.w = pk2(v[6], v[7]);
                *(u32x4*)(H + (size_t)pr * DEXP + 128 * u.pn + 32 * wc + 8 * fq) = w;
            }
    }
};
struct PMoeDown : MoeSched {
    static constexpr bool GATHER = true; static constexpr int ID = 8;
    const bf16_t* H; const bf16_t* W; const float* pairw; bf16_t* Y; int lda, ldb, K;
    __device__ __forceinline__ const bf16_t* a_ptr(const U&) const { return H; }
    __device__ __forceinline__ int a_row(const U& u, int R) const { return pair_of(u, R); }
    __device__ __forceinline__ const bf16_t* b_ptr(const U& u) const { return W + (size_t)u.e * (1024 * 512) + (size_t)u.pn * 256 * 512; }
    static __device__ __forceinline__ int b_row(int bj, int S) { return brow_std(bj, S); }
    __device__ __forceinline__ void epi(Acc& acc, const U& u, int wr, int wc, int fr, int fq) const {
#pragma unroll
        for (int ai = 0; ai < 2; ++ai)
#pragma unroll
            for (int m = 0; m < 4; ++m) {
                const size_t sl = slot_of(u, 128 * ai + 64 * wr + 16 * m + fr); const int pr = list[sl]; const float wgt = listw[sl];
#pragma unroll
                for (int bj = 0; bj < 2; ++bj) {
                    float v[8];
#pragma unroll
                    for (int n = 0; n < 2; ++n)
#pragma unroll
                        for (int e = 0; e < 4; ++e) v[n * 4 + e] = acc[ai][bj][m][n][e] * wgt;
                    u32x4 w; w.x = pk2(v[0], v[1]); w.y = pk2(v[2], v[3]); w.z = pk2(v[4], v[5]); w.w = pk2(v[6], v[7]);
                    *(u32x4*)(Y + (size_t)pr * D + 256 * u.pn + 64 * wc + 32 * bj + 8 * fq) = w;
                }
            }
    }
};
struct PInProj1 : PlainSched {
    static constexpr bool GATHER = false; static constexpr int ID = 9;
    const bf16_t* X; const bf16_t* W; const float* xstat; const float* bias; bf16_t* Ub; bf16_t* V3; float* vstat; int lda, ldb, K;
    __device__ __forceinline__ const bf16_t* a_ptr(const U& u) const { return X + (size_t)u.pm * 256 * D; }
    __device__ __forceinline__ int a_row(const U&, int R) const { return R; }
    __device__ __forceinline__ const bf16_t* b_ptr(const U& u) const { return W + (size_t)u.pn * 256 * D; }
    static __device__ __forceinline__ int b_row(int bj, int S) { return brow_std(bj, S); }
    __device__ __forceinline__ void epi(Acc& acc, const U& u, int wr, int wc, int fr, int fq) const {
        const bool isv = u.pn >= 8; const int pn8 = u.pn & 7; bf16_t* dst = isv ? V3 : Ub;
#pragma unroll
        for (int ai = 0; ai < 2; ++ai)
#pragma unroll
            for (int m = 0; m < 4; ++m) {
                const int row = u.pm * 256 + 128 * ai + 64 * wr + 16 * m + fr; float ss = 0.f;
                const float s = rowscale16(xstat, row, fq, 1.f / D);
#pragma unroll
                for (int bj = 0; bj < 2; ++bj) {
                    const int lc = 64 * wc + 32 * bj + 8 * fq;
                    const f32x4 b0 = *(const f32x4*)(bias + 256 * u.pn + lc), b1 = *(const f32x4*)(bias + 256 * u.pn + lc + 4);
                    float v[8];
#pragma unroll
                    for (int e = 0; e < 4; ++e) { v[e] = acc[ai][bj][m][0][e] * s + b0[e]; v[4 + e] = acc[ai][bj][m][1][e] * s + b1[e]; }
                    if (isv) {
#pragma unroll
                        for (int j = 0; j < 8; ++j) v[j] = gelu_tanh(v[j]);
                    }
                    u32x4 w; w.x = pk2(v[0], v[1]); w.y = pk2(v[2], v[3]); w.z = pk2(v[4], v[5]); w.w = pk2(v[6], v[7]);
                    *(u32x4*)(dst + (size_t)row * CW + 256 * pn8 + lc) = w;
                    const float r[8] = {bf_lo(w.x), bf_hi(w.x), bf_lo(w.y), bf_hi(w.y), bf_lo(w.z), bf_hi(w.z), bf_lo(w.w), bf_hi(w.w)};
#pragma unroll
                    for (int j = 0; j < 8; ++j) ss += r[j] * r[j];
                }
                if (isv) { ss += __shfl_xor(ss, 16); ss += __shfl_xor(ss, 32); if (fq == 0) vstat[(size_t)row * 32 + 4 * pn8 + wc] = ss; }
            }
    }
};

__device__ __forceinline__ int lds_byte(int r, int c) { const int st = (r >> 4) * 2 + (c >> 5), rr = r & 15, cc = c & 31, ob = rr * 64 + cc * 2; return st * 1024 + (ob ^ (((ob >> 9) & 1) << 5)); }
__device__ __forceinline__ void stage_rc(int b, int& R, int& C) { const int st = b / 1024, sb = b % 1024, swz = sb ^ (((sb >> 9) & 1) << 5); R = (st >> 1) * 16 + swz / 64; C = (st & 1) * 32 + (swz % 64) / 2; }

template <class P> __device__ __forceinline__ void gemm_fast(LAS unsigned char* lds, const P& p) {
    constexpr int HTB = 16384;
    const int tid = threadIdx.x, wid = __builtin_amdgcn_readfirstlane(tid >> 6), lane = tid & 63, wr = wid >> 2, wc = wid & 3, fr = lane & 15, fq = lane >> 4;
    const int K = p.K, nt = K / 64, lda = p.lda, ldb = p.ldb;
    const int G = (int)gridDim.x, cu = (int)blockIdx.x;
    int Rs[2], Cs[2];
#pragma unroll
    for (int i = 0; i < 2; ++i) stage_rc(tid * 16 + i * 8192, Rs[i], Cs[i]);
    unsigned boffs[4];
#pragma unroll
    for (int bj = 0; bj < 2; ++bj)
#pragma unroll
        for (int i = 0; i < 2; ++i) boffs[bj * 2 + i] = (unsigned)(P::b_row(bj, Rs[i]) * ldb + Cs[i]) * 2u;
    const unsigned ldsw = (unsigned)wid * 1024u;
    const int aoff_l = lds_byte(wr * 64 + fr, fq * 8), boff_l = lds_byte(wc * 32 + fr, fq * 8);
#define GF_SA(b, h) (((b) * 2 + (h)) * HTB)
#define GF_SB(b, h) ((4 + (b) * 2 + (h)) * HTB)
#define GF_STAGE(bufoff, gbase, o0, o1) do { \
        __builtin_amdgcn_global_load_lds((const unsigned*)((const char*)(gbase) + (o0)), (LAS unsigned*)(lds + (bufoff) + ldsw), 16, 0, 0); \
        __builtin_amdgcn_global_load_lds((const unsigned*)((const char*)(gbase) + (o1)), (LAS unsigned*)(lds + (bufoff) + ldsw + 8192), 16, 0, 0); } while (0)
#define GF_LDA(dst, b, h) do { _Pragma("unroll") for (int m = 0; m < 4; ++m) _Pragma("unroll") for (int k = 0; k < 2; ++k) dst[m][k] = *(const LAS bf16x8*)(lds + GF_SA(b, h) + aoff_l + m * 2048 + k * 1024); } while (0)
#define GF_LDB(dst, b, h) do { _Pragma("unroll") for (int n = 0; n < 2; ++n) _Pragma("unroll") for (int k = 0; k < 2; ++k) dst[n][k] = *(const LAS bf16x8*)(lds + GF_SB(b, h) + boff_l + n * 2048 + k * 1024); } while (0)
#define GF_MMA(ai, bj, At, Bt) do { __builtin_amdgcn_s_setprio(1); _Pragma("unroll") for (int m = 0; m < 4; ++m) _Pragma("unroll") for (int n = 0; n < 2; ++n) _Pragma("unroll") for (int k = 0; k < 2; ++k) \
        acc[ai][bj][m][n] = __builtin_amdgcn_mfma_f32_16x16x32_bf16(Bt[n][k], At[m][k], acc[ai][bj][m][n], 0, 0, 0); __builtin_amdgcn_s_setprio(0); } while (0)
#define GF_WAIT_V(n) asm volatile("s_waitcnt vmcnt(" #n ")" ::: "memory")
#define GF_WAIT_L(n) asm volatile("s_waitcnt lgkmcnt(" #n ")" ::: "memory")
#define GF_BAR __builtin_amdgcn_s_barrier()
#define GF_SCHED __builtin_amdgcn_sched_barrier(0)
#define GF_AOFFS(dst, u) do { _Pragma("unroll") for (int h = 0; h < 2; ++h) _Pragma("unroll") for (int i = 0; i < 2; ++i) dst[h * 2 + i] = (unsigned)(p.a_row(u, 128 * h + Rs[i]) * lda + Cs[i]) * 2u; } while (0)
    U cur, nxt; int ui = 0;
    if (!p.unit(cu, cur)) return;
    Acc acc;
#pragma unroll
    for (int a = 0; a < 2; ++a)
#pragma unroll
        for (int b = 0; b < 2; ++b)
#pragma unroll
            for (int m = 0; m < 4; ++m)
#pragma unroll
                for (int n = 0; n < 2; ++n) acc[a][b][m][n] = (f32x4){0.f, 0.f, 0.f, 0.f};
    bf16x8 At[4][2], B0[2][2], B1[2][2];
    unsigned aoffs[4], naoffs[4];
    GF_AOFFS(aoffs, cur);
    const char* cA = (const char*)p.a_ptr(cur); const char* cB = (const char*)p.b_ptr(cur);
    GF_STAGE(GF_SB(0, 0), cB, boffs[0], boffs[1]); GF_STAGE(GF_SB(0, 1), cB, boffs[2], boffs[3]); GF_STAGE(GF_SA(0, 0), cA, aoffs[0], aoffs[1]); GF_STAGE(GF_SA(0, 1), cA, aoffs[2], aoffs[3]);
    if (wr == 1) GF_BAR;
    GF_WAIT_V(2); GF_BAR;
    GF_STAGE(GF_SB(1, 0), cB + 128, boffs[0], boffs[1]); GF_STAGE(GF_SA(1, 0), cA + 128, aoffs[0], aoffs[1]); GF_STAGE(GF_SB(1, 1), cB + 128, boffs[2], boffs[3]);
    GF_WAIT_V(6); GF_BAR;
    for (;;) {
        const bool has_next = p.unit((ui + 1) * G + cu, nxt);
        const char* nA = cA; const char* nB = cB;
#pragma unroll
        for (int j = 0; j < 4; ++j) naoffs[j] = aoffs[j];
        if (has_next) { nA = (const char*)p.a_ptr(nxt); nB = (const char*)p.b_ptr(nxt);
            if (P::GATHER) {
                int t2 = threadIdx.x; asm volatile("" : "+v"(t2));
#pragma unroll
                for (int h = 0; h < 2; ++h)
#pragma unroll
                    for (int i = 0; i < 2; ++i) { int R2, C2_; stage_rc(t2 * 16 + i * 8192, R2, C2_); naoffs[h * 2 + i] = (unsigned)p.a_row(nxt, 128 * h + R2); } } }
        for (int t = 0; t < nt; t += 2) {
            const bool last = (t == nt - 2);
            const char* a1 = cA + (size_t)(t + 1) * 128;
            const char* a2 = last ? nA : cA + (size_t)(t + 2) * 128; const char* b2 = last ? nB : cB + (size_t)(t + 2) * 128;
            const char* a3 = a2 + 128; const char* b3 = b2 + 128;
            unsigned o[4];
#pragma unroll
            for (int j = 0; j < 4; ++j) o[j] = aoffs[j];
            if (P::GATHER && last) {
                int t3 = threadIdx.x; asm volatile("" : "+v"(t3));
#pragma unroll
                for (int j = 0; j < 4; ++j) { int R3, C3_; stage_rc(t3 * 16 + (j & 1) * 8192, R3, C3_); unsigned r = naoffs[j]; asm volatile("" : "+v"(r)); r = has_next ? (r * (unsigned)lda + (unsigned)C3_) * 2u : aoffs[j]; naoffs[j] = r; o[j] = r; } }
            GF_LDB(B0, 0, 0); GF_LDB(B1, 0, 1); GF_SCHED; GF_LDA(At, 0, 0); GF_STAGE(GF_SA(1, 1), a1, aoffs[2], aoffs[3]);
            GF_WAIT_V(8); GF_WAIT_L(0); GF_BAR; GF_MMA(0, 0, At, B0); GF_MMA(0, 1, At, B1); GF_BAR; GF_SCHED;
            GF_LDA(At, 0, 1); GF_STAGE(GF_SB(0, 0), b2, boffs[0], boffs[1]); GF_STAGE(GF_SB(0, 1), b2, boffs[2], boffs[3]); GF_STAGE(GF_SA(0, 0), a2, o[0], o[1]);
            GF_WAIT_V(8); GF_WAIT_L(0); GF_BAR; GF_MMA(1, 0, At, B0); GF_MMA(1, 1, At, B1); GF_BAR; GF_SCHED;
            GF_LDB(B0, 1, 0); GF_LDB(B1, 1, 1); GF_SCHED; GF_LDA(At, 1, 0); GF_STAGE(GF_SA(0, 1), a2, o[2], o[3]);
            GF_WAIT_V(8); GF_WAIT_L(0); GF_BAR; GF_MMA(0, 0, At, B0); GF_MMA(0, 1, At, B1); GF_BAR; GF_SCHED;
            GF_LDA(At, 1, 1); GF_STAGE(GF_SB(1, 0), b3, boffs[0], boffs[1]); GF_STAGE(GF_SB(1, 1), b3, boffs[2], boffs[3]); GF_STAGE(GF_SA(1, 0), a3, o[0], o[1]);
            GF_WAIT_V(8); GF_WAIT_L(0); GF_BAR; GF_MMA(1, 0, At, B0); GF_MMA(1, 1, At, B1); GF_BAR; GF_SCHED;
        }
        if (wr == 0) GF_BAR;
        p.epi(acc, cur, wr, wc, fr, fq);
        if (!has_next) break;
#pragma unroll
        for (int a = 0; a < 2; ++a)
#pragma unroll
            for (int b = 0; b < 2; ++b)
#pragma unroll
                for (int m = 0; m < 4; ++m)
#pragma unroll
                    for (int n = 0; n < 2; ++n) acc[a][b][m][n] = (f32x4){0.f, 0.f, 0.f, 0.f};
        cur = nxt; cA = nA; cB = nB; ++ui;
#pragma unroll
        for (int j = 0; j < 4; ++j) aoffs[j] = naoffs[j];
        if (wr == 1) GF_BAR;
    }
    GF_WAIT_V(0);
    GF_BAR;
#undef GF_SA
#undef GF_SB
#undef GF_STAGE
#undef GF_LDA
#undef GF_LDB
#undef GF_MMA
#undef GF_WAIT_V
#undef GF_WAIT_L
#undef GF_BAR
#undef GF_SCHED
#undef GF_AOFFS
}

#ifndef FAST_MASK
#define FAST_MASK 0xffffffffu
#endif
template <class P> __device__ __forceinline__ void run_gemm(LAS unsigned char* lds, const P& p) {
#if FAST_CORE
    if constexpr (((FAST_MASK >> P::ID) & 1u) != 0u) { gemm_fast<P>(lds, p); __syncthreads();
#ifdef REPEAT_GEMM_ID
        if constexpr (P::ID == REPEAT_GEMM_ID) { gemm_fast<P>(lds, p); __syncthreads(); }
#endif
    }
    else gemm_naive<P>(p);
#else
    (void)lds;
    gemm_naive<P>(p);
#endif
}

__device__ __forceinline__ void tconv_task(const float* W, int ldw, int n0, bf16_t* dst, int ldd, int drow0, const float* ksc, int kb, int nb, int lane) {
    const int k0 = 32 * kb; const float* src = W + (size_t)k0 * ldw + n0 + 256 * nb + 4 * lane;
    f32x4 v[32];
#pragma unroll
    for (int j = 0; j < 32; ++j) v[j] = *(const f32x4*)(src + (size_t)j * ldw);
    if (ksc) {
#pragma unroll
        for (int j = 0; j < 32; ++j) v[j] *= ksc[k0 + j];
    }
#pragma unroll
    for (int e = 0; e < 4; ++e) {
        u32x4* o = (u32x4*)(dst + (size_t)(drow0 + 256 * nb + 4 * lane + e) * ldd + k0);
#pragma unroll
        for (int c = 0; c < 4; ++c) { u32x4 w; w.x = pk2(v[8 * c][e], v[8 * c + 1][e]); w.y = pk2(v[8 * c + 2][e], v[8 * c + 3][e]); w.z = pk2(v[8 * c + 4][e], v[8 * c + 5][e]); w.w = pk2(v[8 * c + 6][e], v[8 * c + 7][e]); o[c] = w; }
    }
}
__device__ __forceinline__ bool tconv_job(int& r, const float* W, int ldw, int n0, int Kd, int Nc, bf16_t* dst, int drow0, const float* ksc, int lane) {
    const int nkb = Kd / 32, nnb = Nc / 256, items = nkb * nnb;
    if (r >= items) { r -= items; return false; }
    const int kb = r / nnb, nb = r - kb * nnb;
    tconv_task(W, ldw, n0, dst, Kd, drow0, ksc, kb, nb, lane);
    return true;
}
__device__ __forceinline__ void conv_moe_layer(const Args& a, int l) {
    const int lane = threadIdx.x & 63, wave = threadIdx.x >> 6;
    const int gw = blockIdx.x * NWAVES + wave, NGW = gridDim.x * NWAVES;
    bf16_t* WGU = (bf16_t*)(a.ws + WS_W_GU); bf16_t* WDN = (bf16_t*)(a.ws + WS_W_DN);
    const float* g = AIN(I_NFFN) + l * D;
    for (int it = gw; it < 3 * 32 * 64; it += NGW) {
        const int kind = it / 2048, r = it - kind * 2048, e = r >> 6, q = r & 63;
        if (kind == 0) { const float* W = AIN(I_MGATE) + ((size_t)l * 32 + e) * (D * DEXP); tconv_task(W, DEXP, 0, WGU + (size_t)e * 1024 * 1024, D, 0, g, q >> 1, q & 1, lane); }
        else if (kind == 1) { const float* W = AIN(I_MUP) + ((size_t)l * 32 + e) * (D * DEXP); tconv_task(W, DEXP, 0, WGU + (size_t)e * 1024 * 1024, D, 512, g, q >> 1, q & 1, lane); }
        else { const float* W = AIN(I_MDOWN) + ((size_t)l * 32 + e) * (DEXP * D); tconv_task(W, D, 0, WDN + (size_t)e * 1024 * 512, DEXP, 0, nullptr, q >> 2, q & 3, lane); }
    }
}
__device__ __forceinline__ void phase_prologue(const Args& a, LAS unsigned char* lds) {
    const int tid = threadIdx.x, lane = tid & 63, wave = tid >> 6;
    const int gw = blockIdx.x * NWAVES + wave, NGW = gridDim.x * NWAVES;
    unsigned char* ws = a.ws;
    constexpr int NITEMS = 192 + 128 + 128 + 512 + 256 + 2 * 128 + 2 * 256 + 2 * 128;
    for (int it = gw; it < NITEMS; it += NGW) {
        int r = it;
        if (tconv_job(r, AIN(I_ABWIN), INAB, 0, D, 1536, (bf16_t*)(ws + WS_W_IN0), 0, AIN(I_NMIX), lane)) continue;
        if (tconv_job(r, AIN(I_ABWIN), INAB, 1544, D, 1024, (bf16_t*)(ws + WS_W_IN0), 1536, AIN(I_NMIX), lane)) continue;
        if (tconv_job(r, AIN(I_ABWOUT), D, 0, D, D, (bf16_t*)(ws + WS_W_OUT0), 0, nullptr, lane)) continue;
        if (tconv_job(r, AIN(I_CWIN), 2 * CW, 0, D, 2 * CW, (bf16_t*)(ws + WS_W_IN1), 0, AIN(I_NMIX) + D, lane)) continue;
        if (tconv_job(r, AIN(I_CWOUT), D, 0, CW, D, (bf16_t*)(ws + WS_W_OUT1), 0, nullptr, lane)) continue;
        if (tconv_job(r, AIN(I_XWQ), D, 0, D, D, (bf16_t*)(ws + WS_W_Q), 0, AIN(I_NCROSS), lane)) continue;
        if (tconv_job(r, AIN(I_XWQ) + (size_t)D * D, D, 0, D, D, (bf16_t*)(ws + WS_W_Q) + (size_t)D * D, 0, AIN(I_NCROSS) + D, lane)) continue;
        if (tconv_job(r, AIN(I_XWKV), 2 * D, 0, D, 2 * D, (bf16_t*)(ws + WS_W_KV), 0, AIN(I_NMEM), lane)) continue;
        if (tconv_job(r, AIN(I_XWKV) + (size_t)D * 2 * D, 2 * D, 0, D, 2 * D, (bf16_t*)(ws + WS_W_KV) + (size_t)2 * D * D, 0, AIN(I_NMEM) + D, lane)) continue;
        if (tconv_job(r, AIN(I_XWO), D, 0, D, D, (bf16_t*)(ws + WS_W_O), 0, nullptr, lane)) continue;
        tconv_job(r, AIN(I_XWO) + (size_t)D * D, D, 0, D, D, (bf16_t*)(ws + WS_W_O) + (size_t)D * D, 0, nullptr, lane);
    }
    conv_moe_layer(a, 0);
    const int gt = blockIdx.x * NTHREADS + tid, NGT = gridDim.x * NTHREADS;
    for (int i = gt; i < 2 * 256 * D; i += NGT) {
        const int l = i / (256 * D), n = (i / D) & 255, k = i & (D - 1);
        float v = 0.f;
        if (n < 4) v = AIN(I_MWG)[((size_t)l * D + k) * 4 + n] * AIN(I_NFFN)[l * D + k];
        else if (n < 36) v = AIN(I_MWE)[((size_t)l * D + k) * 32 + (n - 4)] * AIN(I_NFFN)[l * D + k];
        ((bf16_t*)(ws + WS_W_R))[i] = f2bf(v);
    }
    for (int i = gt; i < 8 * 128 * 64; i += NGT) { const int k = i & 63, n = (i >> 6) & 127, g = i >> 13; ((bf16_t*)(ws + WS_WLRU))[i] = f2bf(n < 64 ? AIN(I_WA)[(g * 64 + k) * 64 + n] : AIN(I_WX)[(g * 64 + k) * 64 + n - 64]); }
    for (int i = gt; i < CG * CCH * CCH; i += NGT) { const int t = (i >> 7) & 127, s = i & 127; ((bf16_t*)(ws + WS_TRIL))[i] = f2bf(s <= t ? AIN(I_CWS)[i] : 0.f); }
    __syncthreads();
    LAS float* wf = (LAS float*)(lds + 73728);
    for (int i = tid; i < D * 8; i += NTHREADS) { const int k = i >> 3, h = i & 7;
        wf[((((k >> 8) * 4 + (k & 3)) * 2 + (h >> 2)) * 64 + ((k & 255) >> 2)) * 4 + (h & 3)] = AIN(I_ABWIN)[(size_t)k * INAB + 1536 + h] * AIN(I_NMIX)[k]; }
    __syncthreads();
    bf16_t* X = (bf16_t*)(ws + WS_X); float* xstat = (float*)(ws + WS_XSTAT); float* flog = (float*)(ws + WS_FLOG);
    for (int row0 = gw; row0 < T; row0 += 4 * NGW) {
        f32x4 v[4][4];
#pragma unroll
        for (int rr = 0; rr < 4; ++rr) { const int row = row0 + rr * NGW; const f32x4* xr = (const f32x4*)(AIN(I_X) + (size_t)(row < T ? row : row0) * D) + lane;
#pragma unroll
            for (int j = 0; j < 4; ++j) v[rr][j] = xr[64 * j]; }
#pragma unroll
        for (int rr = 0; rr < 4; ++rr) {
            const int row = row0 + rr * NGW; if (row >= T) break;
            float ss = 0.f; float fl[8];
#pragma unroll
            for (int h = 0; h < 8; ++h) fl[h] = 0.f;
#pragma unroll
            for (int j = 0; j < 4; ++j) ss += (v[rr][j].x * v[rr][j].x + v[rr][j].y * v[rr][j].y) + (v[rr][j].z * v[rr][j].z + v[rr][j].w * v[rr][j].w);
#pragma unroll
            for (int j = 0; j < 4; ++j)
#pragma unroll
                for (int e = 0; e < 4; ++e) { const f32x4 w0 = *(const LAS f32x4*)(wf + (((j * 4 + e) * 2 + 0) * 64 + lane) * 4), w1 = *(const LAS f32x4*)(wf + (((j * 4 + e) * 2 + 1) * 64 + lane) * 4);
#pragma unroll
                    for (int h = 0; h < 4; ++h) { fl[h] += v[rr][j][e] * w0[h]; fl[4 + h] += v[rr][j][e] * w1[h]; } }
            ss = wave_sum(ss);
            float w4[4], w2[2], w1;
#pragma unroll
            for (int i = 0; i < 4; ++i) { const bool up = (lane & 32) != 0; const float mine = up ? fl[4 + i] : fl[i], send = up ? fl[i] : fl[4 + i]; w4[i] = mine + __shfl_xor(send, 32); }
#pragma unroll
            for (int i = 0; i < 2; ++i) { const bool up = (lane & 16) != 0; const float mine = up ? w4[2 + i] : w4[i], send = up ? w4[i] : w4[2 + i]; w2[i] = mine + __shfl_xor(send, 16); }
            { const bool up = (lane & 8) != 0; const float mine = up ? w2[1] : w2[0], send = up ? w2[0] : w2[1]; w1 = mine + __shfl_xor(send, 8); }
            w1 += __shfl_xor(w1, 4); w1 += __shfl_xor(w1, 2); w1 += __shfl_xor(w1, 1);
            u32x2* o8 = (u32x2*)(X + (size_t)row * D) + lane;
#pragma unroll
            for (int j = 0; j < 4; ++j) { u32x2 o; o.x = pk2(v[rr][j].x, v[rr][j].y); o.y = pk2(v[rr][j].z, v[rr][j].w); o8[64 * j] = o; }
            if (lane < 16) xstat[(size_t)row * 16 + lane] = lane == 0 ? ss : 0.f;
            const float s = rsqrtf(ss * (1.f / D) + EPS);
            if ((lane & 7) == 0) flog[(size_t)row * 8 + (lane >> 3)] = w1 * s;
        }
    }
    bf16_t* MB = (bf16_t*)(ws + WS_MEMB); float* memstat = (float*)(ws + WS_MISC + MISC_MEMSTAT);
    for (int row = gw; row < NB * MEML; row += NGW) {
        const f32x4* xr = (const f32x4*)(AIN(I_MEM) + (size_t)row * D) + lane; float ss = 0.f;
        u32x2* o8 = (u32x2*)(MB + (size_t)row * D) + lane;
#pragma unroll
        for (int j = 0; j < 4; ++j) { const f32x4 v = xr[64 * j]; ss += (v.x * v.x + v.y * v.y) + (v.z * v.z + v.w * v.w); u32x2 o; o.x = pk2(v.x, v.y); o.y = pk2(v.z, v.w); o8[64 * j] = o; }
        ss = wave_sum(ss);
        if (lane == 0) memstat[row] = ss;
    }
}

__device__ __forceinline__ void phase_cumsum(const Args& a, LAS unsigned char* lds) {
    const int tid = threadIdx.x, lane = tid & 63, wave = tid >> 6;
    const float* flog = (const float*)(a.ws + WS_FLOG); float* csum = (float*)(a.ws + WS_CSUM);
    LAS float* wsum = (LAS float*)lds;
    for (int u = blockIdx.x; u < NB * AH; u += gridDim.x) {
        const int b = u >> 3, h = u & 7; const float fb = AIN(I_FBIAS)[h];
        float v[8]; float run = 0.f;
#pragma unroll
        for (int j = 0; j < 8; ++j) { const float x = flog[((size_t)b * SEQ + 8 * tid + j) * 8 + h] + fb; const float lf = fminf(x, 0.f) - log1pf(__expf(-fabsf(x))); run += lf; v[j] = run; }
        float inc = run;
#pragma unroll
        for (int o = 1; o < 64; o <<= 1) { const float t = __shfl_up(inc, o); if (lane >= o) inc += t; }
        __syncthreads();
        if (lane == 63) wsum[wave] = inc;
        __syncthreads();
        float base = inc - run;
        for (int w = 0; w < wave; ++w) base += wsum[w];
#pragma unroll
        for (int j = 0; j < 8; ++j) csum[(size_t)u * SEQ + 8 * tid + j] = base + v[j];
    }
}

__device__ __forceinline__ void phase_k2fin(const Args& a) {
    const int lane = threadIdx.x & 63, wave = threadIdx.x >> 6;
    const int gw = blockIdx.x * NWAVES + wave, NGW = gridDim.x * NWAVES;
    bf16_t* K2 = (bf16_t*)(a.ws + WS_K2); const float* k2stat = (const float*)(a.ws + WS_MISC + MISC_K2STAT);
    for (int it = gw; it < 2 * NB * XH * MEML; it += NGW) {
        const int key = it & 255, h = (it >> 8) & 3, b = (it >> 10) & 7, l = it >> 13;
        const f32x4 st = *(const f32x4*)(k2stat + ((size_t)l * 2048 + b * 256 + key) * 16 + 4 * h);
        const float rn = rsqrtf(((st.x + st.y) + (st.z + st.w)) * (1.f / XHD) + EPS);
        u32x2* p = (u32x2*)(K2 + (size_t)it * 256) + lane; const u32x2 v = *p;
        const float* qg = AIN(I_XQG) + l * XHD + 4 * lane; const float* kg = AIN(I_XKG) + l * XHD + 4 * lane;
        u32x2 o; o.x = pk2(bf_lo(v.x) * rn * qg[0] * kg[0], bf_hi(v.x) * rn * qg[1] * kg[1]); o.y = pk2(bf_lo(v.y) * rn * qg[2] * kg[2], bf_hi(v.y) * rn * qg[3] * kg[3]);
        *p = o;
    }
}

__device__ __forceinline__ void lru_unit(const Args& a, LAS unsigned char* lds, int b, int g, int ch, int pass) {
    const int tid = threadIdx.x, c = tid & 63, tq = tid >> 6;
    LAS float* xc = (LAS float*)lds;
    LAS float* wA = (LAS float*)(lds + 33792);
    LAS float* wX = (LAS float*)(lds + 33792 + 16384);
    LAS float* seg = (LAS float*)(lds + 33792 + 32768);
    const bf16_t* XB = (const bf16_t*)(a.ws + WS_ARENA + AR_XB); const bf16_t* GATE = (const bf16_t*)(a.ws + WS_ARENA + AR_GATE);
    bf16_t* AR = (bf16_t*)(a.ws + WS_ARENA + AR_AR); float* lsum = (float*)(a.ws + WS_LSUM);
    const int ch0 = 64 * g + c; const size_t row0 = (size_t)b * SEQ + 128 * ch;
    __syncthreads();
    for (int i = tid; i < 4096; i += NTHREADS) { wA[i] = AIN(I_WA)[g * 4096 + i]; wX[i] = AIN(I_WX)[g * 4096 + i]; }
    {
        const float w0 = AIN(I_CONVW)[0 * BW + ch0], w1 = AIN(I_CONVW)[1 * BW + ch0], w2 = AIN(I_CONVW)[2 * BW + ch0], w3 = AIN(I_CONVW)[3 * BW + ch0], cb = AIN(I_CONVB)[ch0];
        float xm3, xm2, xm1; const int tl0 = 16 * tq, s0 = 128 * ch + tl0;
        xm3 = s0 >= 3 ? bf2f(XB[(row0 + tl0 - 3) * BW + ch0]) : 0.f; xm2 = s0 >= 2 ? bf2f(XB[(row0 + tl0 - 2) * BW + ch0]) : 0.f; xm1 = s0 >= 1 ? bf2f(XB[(row0 + tl0 - 1) * BW + ch0]) : 0.f;
#pragma unroll 4
        for (int j = 0; j < 16; ++j) { const float x0 = bf2f(XB[(row0 + tl0 + j) * BW + ch0]); xc[(tl0 + j) * 65 + c] = w0 * xm3 + w1 * xm2 + w2 * xm1 + w3 * x0 + cb; xm3 = xm2; xm2 = xm1; xm1 = x0; }
    }
    __syncthreads();
    float ra[16], rx[16];
#pragma unroll
    for (int j = 0; j < 16; ++j) { ra[j] = 0.f; rx[j] = 0.f; }
    for (int k = 0; k < 64; ++k) { const float wa = wA[k * 64 + c], wx = wX[k * 64 + c];
#pragma unroll
        for (int j = 0; j < 16; ++j) { const float x = xc[(16 * tq + j) * 65 + k]; ra[j] += x * wa; rx[j] += x * wx; } }
    const float ba = AIN(I_BA)[ch0], bx = AIN(I_BX)[ch0], lam = AIN(I_LAM)[ch0];
    const float sp = (lam > 0.f ? 0.f : -lam) + log1pf(__expf(-fabsf(lam)));
    float av[16], bv[16]; float Pp = 1.f, hh = 0.f;
#pragma unroll
    for (int j = 0; j < 16; ++j) { const float r = sigmoidf(ra[j] + ba), ig = sigmoidf(rx[j] + bx); const float la = -8.f * r * sp; const float aa = __expf(la);
        const float beta = sqrtf(fmaxf(-expm1f(2.f * la), 0.f)); av[j] = aa; bv[j] = beta * (ig * xc[(16 * tq + j) * 65 + c]); Pp *= aa; hh = aa * hh + bv[j]; }
    seg[(tq * 64 + c) * 2] = Pp; seg[(tq * 64 + c) * 2 + 1] = hh;
    __syncthreads();
    if (pass == 0) {
        if (tq == 0) { float PA = 1.f, H = 0.f;
            for (int q = 0; q < 8; ++q) { const float pq = seg[(q * 64 + c) * 2], hq = seg[(q * 64 + c) * 2 + 1]; H = pq * H + hq; PA *= pq; }
            float* o = lsum + (((size_t)b * 32 + ch) * BW + ch0) * 2; o[0] = PA; o[1] = H; }
    } else {
        float H = 0.f;
        for (int q = 0; q < ch; ++q) { const float* o = lsum + (((size_t)b * 32 + q) * BW + ch0) * 2; H = o[0] * H + o[1]; }
        for (int q = 0; q < tq; ++q) H = seg[(q * 64 + c) * 2] * H + seg[(q * 64 + c) * 2 + 1];
#pragma unroll
        for (int j = 0; j < 16; ++j) { H = av[j] * H + bv[j]; const size_t row = row0 + 16 * tq + j; AR[row * D + 512 + ch0] = f2bf(bf2f(GATE[row * BW + ch0]) * H); }
    }
}
struct LruC { float p, h; };
__device__ __forceinline__ LruC lru_comp(LruC f, LruC s) { LruC r; r.p = f.p * s.p; r.h = s.p * f.h + s.h; return r; }
__device__ __forceinline__ void lru_unit_fast(const Args& a, LAS unsigned char* lds, int b, int g, int ch, int pass) {
    const int tid = threadIdx.x, lane = tid & 63, wave = __builtin_amdgcn_readfirstlane(tid >> 6), fr = lane & 15, fq = lane >> 4, cb = wave & 3, th = wave >> 2;
    LAS unsigned char* xbt = lds;
    LAS unsigned char* at = lds + 33280;
    LAS float* xch = (LAS float*)(lds + 33280 + 36864);
    const bf16_t* XB = (const bf16_t*)(a.ws + WS_ARENA + AR_XB); const bf16_t* GATE = (const bf16_t*)(a.ws + WS_ARENA + AR_GATE);
    bf16_t* AR = (bf16_t*)(a.ws + WS_ARENA + AR_AR); float* lsum = (float*)(a.ws + WS_LSUM); const bf16_t* WL = (const bf16_t*)(a.ws + WS_WLRU);
    const size_t row0 = (size_t)b * SEQ + 256 * ch; const int cl = 16 * cb + fr, cg = 64 * g + cl;
    __syncthreads();
    for (int i = tid; i < 259 * 8; i += NTHREADS) { const int r = i >> 3, pc = i & 7, tl = r - 3;
        u32x4 v = (u32x4){0u, 0u, 0u, 0u};
        if (256 * ch + tl >= 0) v = *(const u32x4*)(XB + (row0 + tl) * BW + 64 * g + 8 * pc);
        *(LAS u32x4*)(xbt + r * 128 + pc * 16) = v; }
    bf16x8 wfa[2], wfx[2];
#pragma unroll
    for (int ks = 0; ks < 2; ++ks) { wfa[ks] = *(const bf16x8*)(WL + ((size_t)(g * 128 + cl) * 64 + 8 * fq + 32 * ks)); wfx[ks] = *(const bf16x8*)(WL + ((size_t)(g * 128 + 64 + cl) * 64 + 8 * fq + 32 * ks)); }
    const float w0 = AIN(I_CONVW)[0 * BW + cg], w1 = AIN(I_CONVW)[1 * BW + cg], w2 = AIN(I_CONVW)[2 * BW + cg], w3 = AIN(I_CONVW)[3 * BW + cg], cbias = AIN(I_CONVB)[cg];
    const float ba = AIN(I_BA)[cg], bx = AIN(I_BX)[cg], lam = AIN(I_LAM)[cg];
    const float sp8 = -8.f * LOG2E * ((lam > 0.f ? 0.f : -lam) + log1pf(__expf(-fabsf(lam))));
    __syncthreads();
    float xc[8][4];
#pragma unroll
    for (int tb = 0; tb < 8; ++tb) {
        const int tl0 = 128 * th + 16 * tb + 4 * fq; float x[7];
#pragma unroll
        for (int j = 0; j < 7; ++j) x[j] = bf2f(*(const LAS bf16_t*)(xbt + (tl0 + j) * 128 + cl * 2));
#pragma unroll
        for (int e = 0; e < 4; ++e) { xc[tb][e] = w0 * x[e] + w1 * x[e + 1] + w2 * x[e + 2] + w3 * x[e + 3] + cbias; *(LAS bf16_t*)(at + (tl0 + e) * 144 + cl * 2) = f2bf(xc[tb][e]); }
    }
    __syncthreads();
    float av[8][4], bv[8][4]; LruC before[8]; LruC run; run.p = 1.f; run.h = 0.f;
#pragma unroll
    for (int tb = 0; tb < 8; ++tb) {
        const LAS unsigned char* ap = at + (128 * th + 16 * tb + fr) * 144 + 16 * fq;
        const bf16x8 a0 = *(const LAS bf16x8*)ap, a1 = *(const LAS bf16x8*)(ap + 64);
        f32x4 da = __builtin_amdgcn_mfma_f32_16x16x32_bf16(a0, wfa[0], (f32x4){0.f, 0.f, 0.f, 0.f}, 0, 0, 0); da = __builtin_amdgcn_mfma_f32_16x16x32_bf16(a1, wfa[1], da, 0, 0, 0);
        f32x4 dx = __builtin_amdgcn_mfma_f32_16x16x32_bf16(a0, wfx[0], (f32x4){0.f, 0.f, 0.f, 0.f}, 0, 0, 0); dx = __builtin_amdgcn_mfma_f32_16x16x32_bf16(a1, wfx[1], dx, 0, 0, 0);
        LruC loc; loc.p = 1.f; loc.h = 0.f;
#pragma unroll
        for (int e = 0; e < 4; ++e) {
            const float r = sigmoidf(da[e] + ba), ig = sigmoidf(dx[e] + bx); const float l2 = sp8 * r; const float aa = fexp2(l2);
            const float beta = __builtin_amdgcn_sqrtf(fmaxf(1.f - aa * aa, 0.f)); av[tb][e] = aa; bv[tb][e] = beta * (ig * xc[tb][e]);
            loc.h = aa * loc.h + bv[tb][e]; loc.p *= aa;
        }
        LruC inc = loc;
        { LruC pv; pv.p = __shfl_up(inc.p, 16); pv.h = __shfl_up(inc.h, 16); if (fq >= 1) inc = lru_comp(pv, inc); }
        { LruC pv; pv.p = __shfl_up(inc.p, 32); pv.h = __shfl_up(inc.h, 32); if (fq >= 2) inc = lru_comp(pv, inc); }
        LruC ex; ex.p = __shfl_up(inc.p, 16); ex.h = __shfl_up(inc.h, 16); if (fq == 0) { ex.p = 1.f; ex.h = 0.f; }
        LruC tot; tot.p = __shfl(inc.p, fr + 48); tot.h = __shfl(inc.h, fr + 48);
        before[tb] = lru_comp(run, ex); run = lru_comp(run, tot);
    }
    if (th == 0 && fq == 0) { xch[(cb * 16 + fr) * 2] = run.p; xch[(cb * 16 + fr) * 2 + 1] = run.h; }
    __syncthreads();
    LruC first; first.p = xch[(cb * 16 + fr) * 2]; first.h = xch[(cb * 16 + fr) * 2 + 1];
    if (pass == 0) {
        if (th == 1 && fq == 0) { const LruC c2 = lru_comp(first, run); float* o = lsum + (((size_t)b * 16 + ch) * BW + cg) * 2; o[0] = c2.p; o[1] = c2.h; }
    } else {
        float H = 0.f;
        for (int q = 0; q < ch; ++q) { const f32x2 o = *(const f32x2*)(lsum + (((size_t)b * 16 + q) * BW + cg) * 2); H = o.x * H + o.y; }
        if (th == 1) H = first.p * H + first.h;
#pragma unroll
        for (int tb = 0; tb < 8; ++tb) {
            float h = before[tb].p * H + before[tb].h; const size_t row = row0 + 128 * th + 16 * tb + 4 * fq;
#pragma unroll
            for (int e = 0; e < 4; ++e) { h = av[tb][e] * h + bv[tb][e]; AR[(row + e) * D + 512 + cg] = f2bf(bf2f(GATE[(row + e) * BW + cg]) * h); }
        }
    }
}
__device__ __forceinline__ void phase_lru(const Args& a, LAS unsigned char* lds, int pass) {
#if FAST_LRU
    for (int u = blockIdx.x; u < NB * 8 * 16; u += gridDim.x) { const int ch = u & 15, g = (u >> 4) & 7, b = u >> 7; lru_unit_fast(a, lds, b, g, ch, pass); }
#else
    for (int u = blockIdx.x; u < NB * 8 * 32; u += gridDim.x) { const int ch = u & 31, g = (u >> 5) & 7, b = u >> 8; lru_unit(a, lds, b, g, ch, pass); }
#endif
    __syncthreads();
}

__device__ __forceinline__ void phase_attn_naive(const Args& a) {
    const int tid = threadIdx.x;
    const bf16_t* Q = (const bf16_t*)(a.ws + WS_ARENA + AR_Q); const bf16_t* Kb = (const bf16_t*)(a.ws + WS_ARENA + AR_K); const bf16_t* Vb = (const bf16_t*)(a.ws + WS_ARENA + AR_V);
    bf16_t* AR = (bf16_t*)(a.ws + WS_ARENA + AR_AR); const float* csum = (const float*)(a.ws + WS_CSUM);
    const int NU = NB * AH * (SEQ / NTHREADS);
    for (int i = blockIdx.x; i < NU; i += gridDim.x) {
        const int uu = NU - 1 - i;
        const int qb = uu / (NB * AH), bh = uu % (NB * AH), b = bh >> 3, h = bh & 7;
        const int t = qb * NTHREADS + tid; const size_t row = (size_t)b * SEQ + t;
        u32x4 qp[8]; float o[64];
#pragma unroll
        for (int d8 = 0; d8 < 8; ++d8) qp[d8] = *(const u32x4*)(Q + row * AW + h * HD + 8 * d8);
#pragma unroll
        for (int d = 0; d < 64; ++d) o[d] = 0.f;
        const float* cs = csum + (size_t)bh * SEQ; const float ci = cs[t] * LOG2E;
        float mx = -INFINITY, l = 0.f;
        const int jmax = qb * NTHREADS + (tid | 63);
        for (int j = 0; j <= jmax; ++j) {
            const size_t kr = ((size_t)b * SEQ + j) * AW + h * HD;
            float s = 0.f;
#pragma unroll
            for (int d8 = 0; d8 < 8; ++d8) { const u32x4 v = *(const u32x4*)(Kb + kr + 8 * d8); const u32x4 q = qp[d8];
                s += bf_lo(q.x) * bf_lo(v.x) + bf_hi(q.x) * bf_hi(v.x) + bf_lo(q.y) * bf_lo(v.y) + bf_hi(q.y) * bf_hi(v.y) + bf_lo(q.z) * bf_lo(v.z) + bf_hi(q.z) * bf_hi(v.z) + bf_lo(q.w) * bf_lo(v.w) + bf_hi(q.w) * bf_hi(v.w); }
            s += ci - cs[j] * LOG2E;
            if (j > t) s = -INFINITY;
            const float mn = fmaxf(mx, s); const float sc = exp2f(mx - mn), p = exp2f(s - mn);
            l = l * sc + p; mx = mn;
#pragma unroll
            for (int d8 = 0; d8 < 8; ++d8) { const u32x4 v = *(const u32x4*)(Vb + kr + 8 * d8);
                o[8 * d8] = o[8 * d8] * sc + p * bf_lo(v.x); o[8 * d8 + 1] = o[8 * d8 + 1] * sc + p * bf_hi(v.x); o[8 * d8 + 2] = o[8 * d8 + 2] * sc + p * bf_lo(v.y); o[8 * d8 + 3] = o[8 * d8 + 3] * sc + p * bf_hi(v.y);
                o[8 * d8 + 4] = o[8 * d8 + 4] * sc + p * bf_lo(v.z); o[8 * d8 + 5] = o[8 * d8 + 5] * sc + p * bf_hi(v.z); o[8 * d8 + 6] = o[8 * d8 + 6] * sc + p * bf_lo(v.w); o[8 * d8 + 7] = o[8 * d8 + 7] * sc + p * bf_hi(v.w); }
        }
        const float inv = 1.f / l;
#pragma unroll
        for (int d8 = 0; d8 < 8; ++d8) { u32x4 w; w.x = pk2(o[8 * d8] * inv, o[8 * d8 + 1] * inv); w.y = pk2(o[8 * d8 + 2] * inv, o[8 * d8 + 3] * inv); w.z = pk2(o[8 * d8 + 4] * inv, o[8 * d8 + 5] * inv); w.w = pk2(o[8 * d8 + 6] * inv, o[8 * d8 + 7] * inv);
            *(u32x4*)(AR + row * D + h * HD + 8 * d8) = w; }
    }
}

#include <hip/hip_bf16.h>
#include <cmath>
namespace attn_body {
using bf16=__hip_bfloat16;
using bf16x8=__attribute__((ext_vector_type(8)))short;
using s16x4=__attribute__((ext_vector_type(4)))short;
using f32x16=__attribute__((ext_vector_type(16)))float;
using u32x4=__attribute__((ext_vector_type(4)))unsigned;
using f32x4_t=__attribute__((ext_vector_type(4)))float;
constexpr int BATCH=8,NHEAD=8,SEQ=4096,D=64,DM=NHEAD*D,DMO=1024;
constexpr int NW=8,QBLK=32,QB=QBLK*NW,KVBLK=64,NQB=SEQ/QB;
constexpr int ATTN_PITCH=DM, ATTN_UNIT_ROWS=QB;
__device__ __forceinline__ int crow(int r,int hi){return (r&3)+8*(r>>2)+4*hi;}
#define SBAR() __builtin_amdgcn_sched_barrier(0)
__device__ __forceinline__ void cmask(f32x16&p0,f32x16&p1,int jb,int qrel,int hi){
  const float NEG=-INFINITY; int kb=64*jb+4*hi;
  #pragma unroll
  for(int r=0;r<16;++r){int kv=kb+(r&3)+8*(r>>2); if(kv>qrel)p0[r]=NEG; if(kv+32>qrel)p1[r]=NEG;}
}

constexpr int NSLOT=3, SLOTB=8192;
constexpr int LDS_K=0, LDS_V=NSLOT*SLOTB, LDS_WS=2*NSLOT*SLOTB, LDS_OST=LDS_WS+NW*64*4, LDS_CB=LDS_OST+NW*4096, LDS_BYTES=LDS_CB+SEQ*4;
constexpr float C2=0.125f*1.4426950408889634f;
__device__ __forceinline__ void glds16(const void*gsrc,unsigned lds_dst){unsigned keep;
  asm volatile("s_mov_b32 %0, m0\n\ts_mov_b32 m0, %2\n\ts_nop 0\n\tglobal_load_lds_dwordx4 %1, off\n\ts_mov_b32 m0, %0":"=&s"(keep):"v"(gsrc),"s"(lds_dst):"memory");}
__device__ __forceinline__ float max3f(float a,float b,float c){float r;asm("v_max3_f32 %0, %1, %2, %3":"=v"(r):"v"(a),"v"(b),"v"(c));return r;}
__device__ __forceinline__ float max2f(float a,float b){float r;asm("v_max_f32_e32 %0, %1, %2":"=v"(r):"v"(a),"v"(b));return r;}
__device__ __forceinline__ float fadd_s(float a,float b){float r;asm("v_add_f32_e32 %0, %1, %2":"=v"(r):"v"(a),"v"(b));return r;}
__device__ __forceinline__ float fsub_s(float a,float b){float r;asm("v_sub_f32_e32 %0, %1, %2":"=v"(r):"v"(a),"v"(b));return r;}
typedef float f32x2_t __attribute__((ext_vector_type(2))); typedef __bf16 bf16x2_t __attribute__((ext_vector_type(2)));
__device__ __forceinline__ unsigned cvtpk_s(float lo,float hi){f32x2_t v={lo,hi};bf16x2_t b=__builtin_convertvector(v,bf16x2_t);return __builtin_bit_cast(unsigned,b);}
#define WAIT_BAR(N) asm volatile("s_waitcnt vmcnt(" #N ") lgkmcnt(0)\n\ts_barrier":::"memory")

__device__ __forceinline__ void qkt(f32x16&p0,f32x16&p1,const char*Kslot,const bf16x8*qr,int r32,int hi){
  const char*kb=Kslot+hi*1024+r32*16;
  #pragma unroll
  for(int d0=0;d0<4;++d0){
    const bf16x8 b0=*reinterpret_cast<const bf16x8*>(kb+d0*2048);
    const bf16x8 b1=*reinterpret_cast<const bf16x8*>(kb+d0*2048+512);
    {p0=__builtin_amdgcn_mfma_f32_32x32x16_bf16(b0,qr[d0],p0,0,0,0);p1=__builtin_amdgcn_mfma_f32_32x32x16_bf16(b1,qr[d0],p1,0,0,0);}}
}
typedef __attribute__((address_space(3))) const char* lds_cptr;
typedef short v4i16_t __attribute__((ext_vector_type(4)));
__device__ __forceinline__ void kload8(bf16x8*kf,lds_cptr kp){
  kf[0]=*(const __attribute__((address_space(3))) bf16x8*)(kp);      kf[1]=*(const __attribute__((address_space(3))) bf16x8*)(kp+512);
  kf[2]=*(const __attribute__((address_space(3))) bf16x8*)(kp+2048); kf[3]=*(const __attribute__((address_space(3))) bf16x8*)(kp+2560);
  kf[4]=*(const __attribute__((address_space(3))) bf16x8*)(kp+4096); kf[5]=*(const __attribute__((address_space(3))) bf16x8*)(kp+4608);
  kf[6]=*(const __attribute__((address_space(3))) bf16x8*)(kp+6144); kf[7]=*(const __attribute__((address_space(3))) bf16x8*)(kp+6656);
}
__device__ __forceinline__ void kload2(bf16x8*kf,lds_cptr kp,int j){ kf[2*j]=*(const __attribute__((address_space(3))) bf16x8*)(kp+j*2048); kf[2*j+1]=*(const __attribute__((address_space(3))) bf16x8*)(kp+j*2048+512); }
__device__ __forceinline__ s16x4 vtr(lds_cptr p){ return __builtin_bit_cast(s16x4,__builtin_amdgcn_ds_read_tr16_b64_v4i16((__attribute__((address_space(3))) v4i16_t*)p)); }
__device__ __forceinline__ float rowmax(const f32x16&p0,const f32x16&p1){
  float a=max3f(p0[0],p0[1],p1[0]),b=max3f(p0[2],p0[3],p1[1]);a=max3f(a,p1[2],p1[3]);
  #pragma unroll
  for(int r=4;r<16;r+=4){a=max3f(a,p0[r],p0[r+1]);b=max3f(b,p0[r+2],p0[r+3]);a=max3f(a,p1[r],p1[r+1]);b=max3f(b,p1[r+2],p1[r+3]);}
  const float m=max2f(a,b);
  auto rr=__builtin_amdgcn_permlane32_swap(__float_as_uint(m),__float_as_uint(m),false,false);
  return max2f(__uint_as_float(rr[0]),__uint_as_float(rr[1]));
}
__device__ __forceinline__ void pv(f32x16*o,int vb,bf16x8 pa0,bf16x8 pa1,bf16x8 pa2,bf16x8 pa3){
  #pragma unroll
  for(int d0=0;d0<2;++d0){s16x4 lo[4],hi[4];
    #pragma unroll
    for(int ks=0;ks<4;++ks){
      asm volatile("ds_read_b64_tr_b16 %0,%1 offset:%c2":"=&v"(lo[ks]):"v"(vb),"i"(d0*4096+ks*1024):"memory");
      asm volatile("ds_read_b64_tr_b16 %0,%1 offset:%c2":"=&v"(hi[ks]):"v"(vb),"i"(d0*4096+ks*1024+512):"memory");}
    asm volatile("s_waitcnt lgkmcnt(0)":::"memory");SBAR();
    #define PK(k) (bf16x8){lo[k][0],lo[k][1],lo[k][2],lo[k][3],hi[k][0],hi[k][1],hi[k][2],hi[k][3]}
    o[d0]=__builtin_amdgcn_mfma_f32_32x32x16_bf16(pa0,PK(0),o[d0],0,0,0);
    o[d0]=__builtin_amdgcn_mfma_f32_32x32x16_bf16(pa1,PK(1),o[d0],0,0,0);
    o[d0]=__builtin_amdgcn_mfma_f32_32x32x16_bf16(pa2,PK(2),o[d0],0,0,0);
    o[d0]=__builtin_amdgcn_mfma_f32_32x32x16_bf16(pa3,PK(3),o[d0],0,0,0);
    #undef PK
  }
}

#ifndef ATTN_STORE16
#define ATTN_STORE16(p,v) (*(u32x4*)(p)=(v))
#endif
template<int THRL> __device__ __forceinline__ void attn_unit(int b,int h,int qb,const bf16*Q,const bf16*__restrict__ K,const bf16*__restrict__ V,bf16*O,const float*__restrict__ csum,char*shm){
  int tid_=threadIdx.x; asm volatile("":"+v"(tid_));
  const int tid=tid_,lane=tid&63,r32=lane&31,hi=lane>>5; const int wid=__builtin_amdgcn_readfirstlane(tid>>6);
  const lds_cptr shm3=(lds_cptr)shm;
  const long rowbase=(long)b*SEQ; const int q0=qb*QB;
  const bf16*Qw=Q+(rowbase+q0+wid*QBLK)*DM+h*D;
  const bf16*Kh=K+rowbase*DM+h*D,*Vh=V+rowbase*DM+h*D;
  const unsigned lds0=(unsigned)(uintptr_t)shm;
  float*wsf=(float*)(shm+LDS_WS)+wid*64;
  const bf16*ksrc=Kh+(long)lane*DM+wid*8;
  const bf16*vsrc=Vh+(long)(16*(wid&3)+(lane>>2))*DM+(wid>>2)*32+(lane&3)*8;
  const unsigned kdst=lds0+LDS_K+wid*1024, vdst=lds0+LDS_V+wid*1024;
  #define DMA_K(t,slot) glds16(ksrc+(long)(t)*KVBLK*DM,(unsigned)__builtin_amdgcn_readfirstlane(kdst+(slot)))
  #define DMA_V(t,slot) glds16(vsrc+(long)(t)*KVBLK*DM,(unsigned)__builtin_amdgcn_readfirstlane(vdst+(slot)))
  const int vb0=(int)(lds0+LDS_V)+((lane>>4)&1)*32+(lane&3)*8+(4*hi+((lane&15)>>2))*64;
  const char*Kbase=shm+LDS_K; bf16x8 kf[8];
  const lds_cptr kp0=shm3+LDS_K+hi*1024+r32*16; const lds_cptr vp0=shm3+LDS_V+((lane>>4)&1)*32+(lane&3)*8+(4*hi+((lane&15)>>2))*64;
  const int NT=(q0+QB)/KVBLK;
  { const float*cs=csum+(long)(b*NHEAD+h)*SEQ; const float cref=cs[q0]; float*cbw=(float*)(shm+LDS_CB);
    for(int j=tid;j<q0+QB;j+=NW*64)cbw[j]=(cref-cs[j])*1.4426950408889634f; }
  const __attribute__((address_space(3))) f32x4_t* cbp=(const __attribute__((address_space(3))) f32x4_t*)(shm3+LDS_CB+16*hi);
  #define LOADB(X0,X1,t) do{ _Pragma("unroll") for(int g_=0;g_<4;++g_){ const f32x4_t b0_=cbp[16*(t)+2*g_], b1_=cbp[16*(t)+2*g_+8]; \
      X0[4*g_]=b0_[0];X0[4*g_+1]=b0_[1];X0[4*g_+2]=b0_[2];X0[4*g_+3]=b0_[3]; X1[4*g_]=b1_[0];X1[4*g_+1]=b1_[1];X1[4*g_+2]=b1_[2];X1[4*g_+3]=b1_[3]; } }while(0)
  DMA_K(0,0);DMA_V(0,0);DMA_K(1,SLOTB);
  bf16x8 qr[4];
  #pragma unroll
  for(int d0=0;d0<4;++d0)qr[d0]=*reinterpret_cast<const bf16x8*>(&Qw[(long)r32*DM+d0*16+hi*8]);
  float mhat=0.f,l_reg=0.f;f32x16 o[2];o[0]=f32x16{};o[1]=f32x16{};
  const int qrel=wid*QBLK+r32;
  #define CMASK(P0,P1,t) do{int jb_=(t)-(NT-4); if(jb_>=0)cmask(P0,P1,jb_,qrel,hi);}while(0)
  bool resc=false;
  #define START(P0,P1) do{ const float rm=rowmax(P0,P1); resc=false; \
    { const float dl=rm; mhat=fadd_s(mhat,dl); \
      _Pragma("unroll") for(int r=0;r<16;++r){P0[r]=fsub_s(P0[r],dl);P1[r]=fsub_s(P1[r],dl);} } \
    _Pragma("unroll") for(int r=0;r<16;++r)P0[r]=__builtin_amdgcn_exp2f(P0[r]); }while(0)
  #define RESC() do{ if(resc){ asm volatile("s_waitcnt lgkmcnt(0)":::"memory"); \
      _Pragma("unroll") for(int d_=0;d_<2;++d_) _Pragma("unroll") for(int r=0;r<16;++r)o[d_][r]*=wsf[crow(r,hi)]; } }while(0)
  f32x16 pA0,pA1,pB0,pB1;
  int sl_prev=0,sl_cur=0,sl_next=SLOTB;
  #define ROT() do{sl_prev=sl_cur;sl_cur=sl_next;sl_next=(sl_next==(NSLOT-1)*SLOTB)?0:sl_next+SLOTB;}while(0)
  DMA_K(2,2*SLOTB);
  WAIT_BAR(3);
  LOADB(pA0,pA1,0);qkt(pA0,pA1,Kbase,qr,r32,hi);asm volatile("s_nop 15\n\ts_nop 7":"+v"(pA0),"+v"(pA1));CMASK(pA0,pA1,0);
  START(pA0,pA1);
  LOADB(pB0,pB1,1);
  _Pragma("unroll") for(int r=0;r<16;++r)pA1[r]=__builtin_amdgcn_exp2f(pA1[r]);
  WAIT_BAR(0);
  DMA_K(3,0);DMA_V(1,SLOTB);
  ROT();
  kload8(kf,kp0+sl_cur);
  WAIT_BAR(2);
  s16x4 vlo[8],vhi[8]; u32x4 pw0,pw1,pw2,pw3;
  #define PKW(P,B) cvtpk_s(P[B],P[B+1])
  #define PAF(k) __builtin_bit_cast(bf16x8,pw##k)
  #define VFR(i) (bf16x8){vlo[i][0],vlo[i][1],vlo[i][2],vlo[i][3],vhi[i][0],vhi[i][1],vhi[i][2],vhi[i][3]}
  #define PIN(x) asm volatile("":"+v"(x))
  #define MX3(a,b,c) __builtin_fmaxf(__builtin_fmaxf((a),(b)),(c))
  #define GAPA(MF,A0,A1,A2,A3,W0,W1,PW) do{ MF; sacc+=A0; sacc+=A1; sacc+=A2; sacc+=A3; PIN(sacc); W0; W1; PIN(PW); SBAR(); }while(0)
  #define EX(v) __builtin_amdgcn_exp2f(v)
  #define GAPB(MF,X,B) do{ MF; X[B]=EX(X[B]); X[B+1]=EX(X[B+1]); X[B+2]=EX(X[B+2]); X[B+3]=EX(X[B+3]); PIN(X); SBAR(); }while(0)
  #define VRD(i) do{ vlo[i]=vtr(vp_+(((i)>>2)*4096+((i)&3)*1024)); vhi[i]=vtr(vp_+(((i)>>2)*4096+((i)&3)*1024+512)); }while(0)
  #define KRD(G,j) do{ if(G){ kload2(kf,kp0+sl_next,j); SBAR(); } }while(0)
  #define STEP(C0,C1,P0,P1,t,GK,GV,GL) do{ SBAR(); \
    _Pragma("unroll") for(int r=0;r<16;++r){C0[r]-=mhat;C1[r]-=mhat;} \
    const lds_cptr vp_=vp0+sl_prev; \
    VRD(0); SBAR(); float sacc=(P0[0]+P0[1]); \
    GAPA(C0=__builtin_amdgcn_mfma_f32_32x32x16_bf16(kf[0],qr[0],C0,0,0,0), P0[2],P0[3],P0[4],P0[5],     pw0[0]=PKW(P0,0), pw0[1]=PKW(P0,2), pw0); \
    VRD(4); SBAR(); GAPA(C1=__builtin_amdgcn_mfma_f32_32x32x16_bf16(kf[1],qr[0],C1,0,0,0), P0[6],P0[7],P0[8],P0[9],     pw0[2]=PKW(P0,4), pw0[3]=PKW(P0,6), pw0); \
    VRD(1); SBAR(); GAPA(C0=__builtin_amdgcn_mfma_f32_32x32x16_bf16(kf[2],qr[1],C0,0,0,0),   P0[10],P0[11],P0[12],P0[13], pw1[0]=PKW(P0,8), pw1[1]=PKW(P0,10), pw1); \
    VRD(5); SBAR(); GAPA(C1=__builtin_amdgcn_mfma_f32_32x32x16_bf16(kf[3],qr[1],C1,0,0,0),   P0[14],P0[15],P1[0],P1[1],   pw1[2]=PKW(P0,12),pw1[3]=PKW(P0,14), pw1); \
    VRD(2); SBAR(); GAPA(C0=__builtin_amdgcn_mfma_f32_32x32x16_bf16(kf[4],qr[2],C0,0,0,0),   P1[2],P1[3],P1[4],P1[5],     pw2[0]=PKW(P1,0), pw2[1]=PKW(P1,2), pw2); \
    VRD(6); SBAR(); GAPA(C1=__builtin_amdgcn_mfma_f32_32x32x16_bf16(kf[5],qr[2],C1,0,0,0),   P1[6],P1[7],P1[8],P1[9],     pw2[2]=PKW(P1,4), pw2[3]=PKW(P1,6), pw2); \
    VRD(3); SBAR(); GAPA(C0=__builtin_amdgcn_mfma_f32_32x32x16_bf16(kf[6],qr[3],C0,0,0,0),   P1[10],P1[11],P1[12],P1[13], pw3[0]=PKW(P1,8), pw3[1]=PKW(P1,10), pw3); \
    VRD(7); SBAR(); GAPA(C1=__builtin_amdgcn_mfma_f32_32x32x16_bf16(kf[7],qr[3],C1,0,0,0),   P1[14],P1[15],0.f,0.f,       pw3[2]=PKW(P1,12),pw3[3]=PKW(P1,14), pw3); \
    l_reg+=sacc; LOADB(P0,P1,(t)+1); \
    if(GK){DMA_K((t)+3,sl_cur);} if(GV){DMA_V((t)+1,sl_next);} \
    CMASK(C0,C1,t); \
    { float a=MX3(C0[0],C0[1],C1[0]),b=MX3(C0[2],C0[3],C1[1]); a=MX3(a,C1[2],C1[3]); \
      _Pragma("unroll") for(int r=4;r<16;r+=4){a=MX3(a,C0[r],C0[r+1]);b=MX3(b,C0[r+2],C0[r+3]);a=MX3(a,C1[r],C1[r+1]);b=MX3(b,C1[r+2],C1[r+3]);} \
      float rm=__builtin_fmaxf(a,b); { auto rr=__builtin_amdgcn_permlane32_swap(__float_as_uint(rm),__float_as_uint(rm),false,false); rm=__builtin_fmaxf(__uint_as_float(rr[0]),__uint_as_float(rr[1])); } \
      resc=false; \
      if(__builtin_expect(__any(rm>(float)THRL),0)){ const float dl=__builtin_fmaxf(rm,0.f); mhat+=dl; \
        _Pragma("unroll") for(int r=0;r<16;++r){C0[r]-=dl;C1[r]-=dl;} \
        const float f=__builtin_amdgcn_exp2f(-dl); l_reg*=f; if(hi==0)wsf[r32]=f; resc=true; } } \
    SBAR(); \
    GAPB(o[0]=__builtin_amdgcn_mfma_f32_32x32x16_bf16(PAF(0),VFR(0),o[0],0,0,0), C0,0); \
    GAPB(o[1]=__builtin_amdgcn_mfma_f32_32x32x16_bf16(PAF(0),VFR(4),o[1],0,0,0), C0,4); \
    KRD(GL,0); GAPB(o[0]=__builtin_amdgcn_mfma_f32_32x32x16_bf16(PAF(1),VFR(1),o[0],0,0,0), C0,8); \
    KRD(GL,1); GAPB(o[1]=__builtin_amdgcn_mfma_f32_32x32x16_bf16(PAF(1),VFR(5),o[1],0,0,0), C0,12); \
    KRD(GL,2); GAPB(o[0]=__builtin_amdgcn_mfma_f32_32x32x16_bf16(PAF(2),VFR(2),o[0],0,0,0), C1,0); \
    KRD(GL,3); GAPB(o[1]=__builtin_amdgcn_mfma_f32_32x32x16_bf16(PAF(2),VFR(6),o[1],0,0,0), C1,4); \
    GAPB(o[0]=__builtin_amdgcn_mfma_f32_32x32x16_bf16(PAF(3),VFR(3),o[0],0,0,0), C1,8); \
    GAPB(o[1]=__builtin_amdgcn_mfma_f32_32x32x16_bf16(PAF(3),VFR(7),o[1],0,0,0), C1,12); \
    }while(0)
  int t=1;
  #undef CMASK
  #define CMASK(P0,P1,t) do{}while(0)
  for(;t+5<NT;t+=2){
    STEP(pB0,pB1,pA0,pA1,t,true,true,true);     WAIT_BAR(2); RESC(); ROT();
    STEP(pA0,pA1,pB0,pB1,t+1,true,true,true);   WAIT_BAR(2); RESC(); ROT();
  }
  #undef CMASK
  #define CMASK(P0,P1,t) do{int jb_=(t)-(NT-4); if(jb_>=0)cmask(P0,P1,jb_,qrel,hi);}while(0)
  #define ENDW(tt) do{ if((tt)+3<NT){WAIT_BAR(2);} else if((tt)+2<NT){WAIT_BAR(1);} else {WAIT_BAR(0);} }while(0)
  for(;t+1<NT;t+=2){
    STEP(pB0,pB1,pA0,pA1,t,(t+3<NT),(t+1<NT),(t+1<NT));       ENDW(t);   RESC(); ROT();
    STEP(pA0,pA1,pB0,pB1,t+1,(t+4<NT),(t+2<NT),(t+2<NT));     ENDW(t+1); RESC(); ROT();
  }
  STEP(pB0,pB1,pA0,pA1,NT-1,false,false,false); RESC();
  { float sacc=pB0[0]+pB0[1]; _Pragma("unroll") for(int r=2;r<16;++r)sacc+=pB0[r]; _Pragma("unroll") for(int r=0;r<16;++r)sacc+=pB1[r]; l_reg+=sacc;
    pw0=(u32x4){PKW(pB0,0),PKW(pB0,2),PKW(pB0,4),PKW(pB0,6)};pw1=(u32x4){PKW(pB0,8),PKW(pB0,10),PKW(pB0,12),PKW(pB0,14)};pw2=(u32x4){PKW(pB1,0),PKW(pB1,2),PKW(pB1,4),PKW(pB1,6)};pw3=(u32x4){PKW(pB1,8),PKW(pB1,10),PKW(pB1,12),PKW(pB1,14)};
    SBAR(); pv(o,vb0+sl_cur,PAF(0),PAF(1),PAF(2),PAF(3)); }
  #undef PKW
  #undef PAF
  #undef VFR
  #undef PIN
  #undef MX3
  #undef GAPA
  #undef GAPB
  #undef EX
  #undef VRD
  #undef KRD
  #undef STEP
  #undef ENDW
  {auto rr=__builtin_amdgcn_permlane32_swap(__float_as_uint(l_reg),__float_as_uint(l_reg),false,false);l_reg=__uint_as_float(rr[0])+__uint_as_float(rr[1]);}
  if(hi==0)wsf[32+r32]=l_reg;asm volatile("s_waitcnt lgkmcnt(0)":::"memory");
  float rli[16];
  #pragma unroll
  for(int r=0;r<16;++r)rli[r]=__builtin_amdgcn_rcpf(wsf[32+crow(r,hi)]);
  bf16*Ow=O+(rowbase+q0+wid*QBLK)*DMO+h*D;
  { bf16*stg=(bf16*)(shm+LDS_OST)+wid*2048;
    #pragma unroll
    for(int r=0;r<16;++r){const int orow=crow(r,hi);
      #pragma unroll
      for(int d0=0;d0<2;++d0)stg[orow*64+d0*32+r32]=__float2bfloat16(o[d0][r]*rli[r]);}
    asm volatile("s_waitcnt lgkmcnt(0)":::"memory");
    #pragma unroll
    for(int i=0;i<4;++i){const int row=i*8+(lane>>3),ch=lane&7; const u32x4 v=*(const u32x4*)(stg+row*64+ch*8); ATTN_STORE16(Ow+(long)row*DMO+ch*8,v);} }
  asm volatile("s_waitcnt lgkmcnt(0)\n\ts_barrier":::"memory");
  #undef LOADB
  #undef DMA_K
  #undef DMA_V
  #undef CMASK
  #undef START
  #undef RESC
  #undef ROT
}
constexpr int ATTN_LDS_BYTES=LDS_BYTES;
struct AttnTensors { const bf16* Q; const bf16* K; const bf16* V; bf16* O; const float* csum; };
struct AttnUnit { int bh; int qb; };
template<int THRL> __device__ __forceinline__ void attn_phase(char*lds,const AttnTensors&T){
  const int G=gridDim.x,bx=blockIdx.x; const int vcu=(G%8==0)?(bx%8)*(G/8)+bx/8:bx;
  for(int v=vcu;v<256;v+=G){ const int s=v&3,bh=v>>2;
    for(int i=0;i<4;++i){ const int qb=(i==0)?15-s:(i==1)?8+s:(i==2)?7-s:s; attn_unit<THRL>(bh/NHEAD,bh%NHEAD,qb,T.Q,T.K,T.V,T.O,T.csum,lds); } }
}
#undef SBAR
#undef WAIT_BAR
}

__device__ __forceinline__ void phase_mix_fast(const Args& a, LAS unsigned char* lds) {
    typedef short v4i16_t __attribute__((ext_vector_type(4)));
    typedef float f32x16 __attribute__((ext_vector_type(16)));
    const int tid = threadIdx.x, lane = tid & 63, wave = __builtin_amdgcn_readfirstlane(tid >> 6), r32 = lane & 31, hi = lane >> 5;
    constexpr int RS = 576;
    LAS unsigned char* tile = lds; LAS float* rsl = (LAS float*)(lds + 128 * RS);
    bf16_t* Ub = (bf16_t*)(a.ws + WS_ARENA + AR_U); const bf16_t* V3 = (const bf16_t*)(a.ws + WS_ARENA + AR_V3); const float* vstat = (const float*)(a.ws + WS_VSTAT);
    const bf16_t* tril = (const bf16_t*)(a.ws + WS_TRIL);
    const int q = (lane & 15) >> 2, p = lane & 3, cblk = (lane >> 4) & 1;
    for (int u = blockIdx.x; u < (T / CCH) * CG; u += gridDim.x) {
        const int g = u & 7, n = u >> 3; const size_t row0 = (size_t)n * CCH;
        __syncthreads();
        if (tid < 128) { const f32x4* st = (const f32x4*)(vstat + (row0 + tid) * 32); float tot = 0.f;
#pragma unroll
            for (int j = 0; j < 8; ++j) { const f32x4 v = st[j]; tot += (v.x + v.y) + (v.z + v.w); }
            rsl[tid] = rsqrtf(tot * (1.f / CW) + EPS); }
        __syncthreads();
#pragma unroll
        for (int j = 0; j < 8; ++j) {
            const int i = tid + 512 * j, s = i >> 5, c8 = (i & 31) * 8;
            const u32x4 v = *(const u32x4*)(V3 + (row0 + s) * CW + 256 * g + c8);
            const float* gn = AIN(I_CVG) + 256 * g + c8; const f32x4 g0 = *(const f32x4*)gn, g1 = *(const f32x4*)(gn + 4); const float rs = rsl[s];
            u32x4 w; w.x = pk2(bf_lo(v.x) * rs * g0.x, bf_hi(v.x) * rs * g0.y); w.y = pk2(bf_lo(v.y) * rs * g0.z, bf_hi(v.y) * rs * g0.w);
            w.z = pk2(bf_lo(v.z) * rs * g1.x, bf_hi(v.z) * rs * g1.y); w.w = pk2(bf_lo(v.w) * rs * g1.z, bf_hi(v.w) * rs * g1.w);
            *(LAS u32x4*)(tile + s * RS + c8 * 2) = w;
        }
        __syncthreads();
        f32x16 acc[4];
#pragma unroll
        for (int tb = 0; tb < 4; ++tb) acc[tb] = f32x16{};
        const LAS unsigned char* abase = tile + (8 * hi + q) * RS + (32 * wave + 16 * cblk + 4 * p) * 2;
        const bf16_t* wbase = tril + ((size_t)g * 128 + r32) * 128 + 8 * hi;
#pragma unroll
        for (int ks = 0; ks < 8; ++ks) {
            const v4i16_t lo = __builtin_amdgcn_ds_read_tr16_b64_v4i16((LAS v4i16_t*)(abase + (16 * ks) * RS));
            const v4i16_t h2 = __builtin_amdgcn_ds_read_tr16_b64_v4i16((LAS v4i16_t*)(abase + (16 * ks + 4) * RS));
            const bf16x8 af = (bf16x8){lo[0], lo[1], lo[2], lo[3], h2[0], h2[1], h2[2], h2[3]};
#pragma unroll
            for (int tb = 0; tb < 4; ++tb) if (ks <= 2 * tb + 1) {
                const bf16x8 bfr = *(const bf16x8*)(wbase + (size_t)(32 * tb) * 128 + 16 * ks);
                acc[tb] = __builtin_amdgcn_mfma_f32_32x32x16_bf16(af, bfr, acc[tb], 0, 0, 0);
            }
        }
#pragma unroll
        for (int tb = 0; tb < 4; ++tb) {
            const int t = 32 * tb + r32; const float bs = AIN(I_CBS)[g * 128 + t];
            bf16_t* up = Ub + (row0 + t) * CW + 256 * g + 32 * wave + 4 * hi;
#pragma unroll
            for (int gr = 0; gr < 4; ++gr) {
                u32x2* pp = (u32x2*)(up + 8 * gr); const u32x2 uv = *pp;
                u32x2 o; o.x = pk2(gelu_tanh(bf_lo(uv.x)) * (acc[tb][4 * gr] + bs), gelu_tanh(bf_hi(uv.x)) * (acc[tb][4 * gr + 1] + bs)); o.y = pk2(gelu_tanh(bf_lo(uv.y)) * (acc[tb][4 * gr + 2] + bs), gelu_tanh(bf_hi(uv.y)) * (acc[tb][4 * gr + 3] + bs));
                *pp = o;
            }
        }
    }
    __syncthreads();
}

__device__ __forceinline__ void phase_route(const Args& a, LAS unsigned char* lds, int l) {
    const int tid = threadIdx.x;
    LAS int* hist = (LAS int*)lds; LAS int* base = hist + 32;
    const float* rlog = (const float*)(a.ws + WS_RLOG); float* pairw = (float*)(a.ws + WS_PAIRW); int* list = (int*)(a.ws + WS_LIST); int* cnt = (int*)(a.ws + WS_CTL) + 64 * l;
    float* lists = (float*)(a.ws + WS_LISTS); float* listw = (float*)(a.ws + WS_LISTW); const float* xstat = (const float*)(a.ws + WS_XSTAT);
    for (int cb = blockIdx.x; cb < T / 256; cb += gridDim.x) {
        __syncthreads();
        if (tid < 32) hist[tid] = 0;
        __syncthreads();
        int e0 = 0, e1 = 0, r0 = 0, r1 = 0; const int tok = cb * 256 + (tid & 255); float pw0 = 0.f, pw1 = 0.f, rsc = 0.f;
        if (tid < 256) {
            const float* lg = rlog + (size_t)tok * 40;
            int gi = 0; float gm = lg[0];
#pragma unroll
            for (int j = 1; j < 4; ++j) if (lg[j] > gm) { gm = lg[j]; gi = j; }
            float gs = 0.f;
#pragma unroll
            for (int j = 0; j < 4; ++j) gs += __expf(lg[j] - gm);
            const float gw = 1.f / gs;
            const float* el = lg + 4 + 8 * gi;
            int i0 = 0; float v0 = el[0];
#pragma unroll
            for (int j = 1; j < 8; ++j) if (el[j] > v0) { v0 = el[j]; i0 = j; }
            int i1 = -1; float v1 = -INFINITY;
#pragma unroll
            for (int j = 0; j < 8; ++j) if (j != i0 && el[j] > v1) { v1 = el[j]; i1 = j; }
            const float ex = __expf(v1 - v0), den = 1.f / (1.f + ex);
            pw0 = gw * den; pw1 = gw * ex * den; rsc = frsq(sum16(xstat + (size_t)tok * 16) * (1.f / D) + EPS);
            e0 = gi * 8 + i0; e1 = gi * 8 + i1;
            r0 = atomicAdd((int*)&hist[e0], 1); r1 = atomicAdd((int*)&hist[e1], 1);
        }
        __syncthreads();
        if (tid < 32) base[tid] = hist[tid] ? atomicAdd(&cnt[tid], hist[tid]) : 0;
        __syncthreads();
        if (tid < 256) { const size_t s0 = (size_t)e0 * 65536 + base[e0] + r0, s1 = (size_t)e1 * 65536 + base[e1] + r1;
            list[s0] = 2 * tok; list[s1] = 2 * tok + 1; lists[s0] = rsc; lists[s1] = rsc; listw[s0] = pw0; listw[s1] = pw1; }
    }
    __syncthreads();
}

__device__ __forceinline__ void phase_combine(const Args& a, bool last) {
    const int lane = threadIdx.x & 63, wave = threadIdx.x >> 6;
    const int gw = blockIdx.x * NWAVES + wave, NGW = gridDim.x * NWAVES;
    bf16_t* X = (bf16_t*)(a.ws + WS_X); const bf16_t* Y = (const bf16_t*)(a.ws + WS_ARENA + AR_Y); float* xstat = (float*)(a.ws + WS_XSTAT);
    for (int row = gw; row < T; row += NGW) {
        float ss = 0.f;
#pragma unroll
        for (int hlf = 0; hlf < 2; ++hlf) {
            const int c0 = 512 * hlf + 8 * lane;
            const u32x4 xv = *(const u32x4*)(X + (size_t)row * D + c0), y0 = *(const u32x4*)(Y + (size_t)(2 * row) * D + c0), y1 = *(const u32x4*)(Y + (size_t)(2 * row + 1) * D + c0);
            float v[8] = {bf_lo(xv.x), bf_hi(xv.x), bf_lo(xv.y), bf_hi(xv.y), bf_lo(xv.z), bf_hi(xv.z), bf_lo(xv.w), bf_hi(xv.w)};
            const float p[8] = {bf_lo(y0.x), bf_hi(y0.x), bf_lo(y0.y), bf_hi(y0.y), bf_lo(y0.z), bf_hi(y0.z), bf_lo(y0.w), bf_hi(y0.w)};
            const float q[8] = {bf_lo(y1.x), bf_hi(y1.x), bf_lo(y1.y), bf_hi(y1.y), bf_lo(y1.z), bf_hi(y1.z), bf_lo(y1.w), bf_hi(y1.w)};
#pragma unroll
            for (int j = 0; j < 8; ++j) v[j] = (v[j] + p[j]) + q[j];
            if (last) { float* o = a.out + (size_t)row * D + c0; *(f32x4*)o = (f32x4){v[0], v[1], v[2], v[3]}; *(f32x4*)(o + 4) = (f32x4){v[4], v[5], v[6], v[7]}; }
            else { u32x4 w; w.x = pk2(v[0], v[1]); w.y = pk2(v[2], v[3]); w.z = pk2(v[4], v[5]); w.w = pk2(v[6], v[7]); *(u32x4*)(X + (size_t)row * D + c0) = w;
                const float r[8] = {bf_lo(w.x), bf_hi(w.x), bf_lo(w.y), bf_hi(w.y), bf_lo(w.z), bf_hi(w.z), bf_lo(w.w), bf_hi(w.w)};
#pragma unroll
                for (int j = 0; j < 8; ++j) ss += r[j] * r[j]; }
        }
        if (!last) { ss = wave_sum(ss); if (lane < 16) xstat[(size_t)row * 16 + lane] = lane == 0 ? ss : 0.f; }
    }
}

#define XB_TMO      128
#define XB_XCNT(j)  (256  + 64 * (j))
#define XB_XSUB(j)  (1280 + 64 * (j))
#define XB_XGEN(j)  (2304 + 64 * (j))
#define XB_TOP      3328
#define XB_TOPGEN   3392
#define XCD_BAR_WORDS 3456
#define XB_SPIN_CAP (1u << 22)

__device__ __forceinline__ unsigned xb_ld(unsigned* p)              { return __hip_atomic_load(p, __ATOMIC_RELAXED, __HIP_MEMORY_SCOPE_AGENT); }
__device__ __forceinline__ unsigned xb_add(unsigned* p, unsigned v) { return __hip_atomic_fetch_add(p, v, __ATOMIC_RELAXED, __HIP_MEMORY_SCOPE_AGENT); }
__device__ __forceinline__ unsigned xb_xcc_id() { return (unsigned)__builtin_amdgcn_s_getreg((3 << 11) | 20) & 0xFu; }
#define XB_SPIN(cond, bar) do { unsigned _sp = 0; while (cond) { __builtin_amdgcn_s_sleep(1); \
    if ((++_sp & 255u) == 0u) { if (xb_ld(&(bar)[XB_TMO])) break; if (_sp > XB_SPIN_CAP) { atomicAdd(&(bar)[XB_TMO], 1u); break; } } } } while (0)

struct XcdBarrier {
    unsigned* bar; unsigned x;
    volatile LAS unsigned* st;
};

__device__ __forceinline__ XcdBarrier xcd_barrier_post(unsigned* bar, volatile LAS unsigned* st) {
    XcdBarrier b; b.bar = bar; b.x = xb_xcc_id(); b.st = st;
    if (threadIdx.x == 0) (void)xb_add(&bar[XB_XCNT(b.x)], 1u);
    return b;
}
__device__ __forceinline__ void xcd_barrier_complete(unsigned* bar, unsigned x, unsigned& nloc, unsigned& nx) {
    const unsigned G = gridDim.x * gridDim.y * gridDim.z;
    unsigned sum, cnt, mine, sp = 0u;
    for (;;) {
        sum = 0u; cnt = 0u; mine = 0u;
#pragma unroll
        for (unsigned j = 0; j < 16; ++j) { const unsigned c = xb_ld(&bar[XB_XCNT(j)]); sum += c; cnt += (c > 0u) ? 1u : 0u; mine = (j == x) ? c : mine; }
        if (sum == G) break;
        __builtin_amdgcn_s_sleep(1);
        if ((++sp & 255u) == 0u) { if (xb_ld(&bar[XB_TMO])) break; if (sp > XB_SPIN_CAP) { atomicAdd(&bar[XB_TMO], 1u); break; } }
    }
    nloc = mine > 0u ? mine : 1u; nx = cnt > 0u ? cnt : 1u;
}

__device__ __forceinline__ void xcd_barrier(const XcdBarrier& b) {
    asm volatile("s_waitcnt vmcnt(0)" ::: "memory");
    __syncthreads();
    if (threadIdx.x == 0) {
        unsigned* bar = b.bar;
        __builtin_amdgcn_s_waitcnt(0);
        unsigned nloc = b.st[0], nx = b.st[1];
        if (nloc == 0u) { xcd_barrier_complete(bar, b.x, nloc, nx); b.st[0] = nloc; b.st[1] = nx; }
        const unsigned old = xb_add(&bar[XB_XSUB(b.x)], 1u);
        const unsigned gen = old / nloc;
        if (old + 1u == (gen + 1u) * nloc) {
            __builtin_amdgcn_fence(__ATOMIC_RELEASE, "agent");
            asm volatile("s_waitcnt vmcnt(0)" ::: "memory");
            const unsigned og = xb_add(&bar[XB_TOP], 1u);
            const unsigned tg = og / nx;
            if (og + 1u == (tg + 1u) * nx) xb_add(&bar[XB_TOPGEN], 1u);
            else XB_SPIN(xb_ld(&bar[XB_TOPGEN]) == tg, bar);
            __builtin_amdgcn_fence(__ATOMIC_ACQUIRE, "agent");
            xb_add(&bar[XB_XGEN(b.x)], 1u);
            asm volatile("s_waitcnt vmcnt(0)" ::: "memory");
        } else {
            XB_SPIN(xb_ld(&bar[XB_XGEN(b.x)]) == gen, bar);
            __builtin_amdgcn_fence(__ATOMIC_ACQUIRE, "agent");
            asm volatile("s_waitcnt vmcnt(0)" ::: "memory");
        }
    }
    __syncthreads();
}

constexpr int NPHASES = 26;
#ifdef ONLY_PHASE
#define PH(k) if (((k) == ONLY_PHASE || (k) == ONLY_PHASE2) && a.ph_lo <= (k) && (k) < a.ph_hi)
#else
#define PH(k) if (a.ph_lo <= (k) && (k) < a.ph_hi)
#endif
#ifdef PROBE_LO
#define STAMP(k) do { if (blockIdx.x == 0 && threadIdx.x == 0) ((unsigned long long*)(a.ws + WS_CTL + 24576))[k] = __builtin_amdgcn_s_memrealtime(); } while (0)
#else
#define STAMP(k) do { } while (0)
#endif
#if USE_CG_SYNC
#define SYNC(k) do { if ((k) + 1 < a.ph_hi) cg::this_grid().sync(); } while (0)
#else
#define SYNC(k) do { if ((k) + 1 < a.ph_hi) xcd_barrier(bar); } while (0)
#endif

template <int L> __device__ __forceinline__ void layer_tail(const Args& a, LAS unsigned char* lds, const int base, const XcdBarrier& bar) {
    unsigned char* ws = a.ws; unsigned char* ar = ws + WS_ARENA;
    bf16_t* X = (bf16_t*)(ws + WS_X); float* xstat = (float*)(ws + WS_XSTAT);
    volatile LAS int* tpre = (volatile LAS int*)(lds + 131072);
    PH(base + 0) { STAMP(base + 0); PCrossQ p; p.nM = T / 256; p.nN = 4; p.X = X; p.W = (const bf16_t*)(ws + WS_W_Q) + (size_t)L * D * D; p.xstat = xstat; p.Q2 = (bf16_t*)(ar + AR_Q2); p.qstat = (float*)(ws + WS_QSTAT); p.lda = D; p.ldb = D; p.K = D; run_gemm(lds, p); SYNC(base + 0); }
    PH(base + 1) { STAMP(base + 1); PCrossS p; p.nM = T / 256; p.nN = 4; p.Q2 = (const bf16_t*)(ar + AR_Q2); p.K2 = (const bf16_t*)(ws + WS_K2) + (size_t)L * 2048 * 1024; p.qstat = (const float*)(ws + WS_QSTAT); p.P = (bf16_t*)(ar + AR_P); p.xs = (LAS float*)(lds + 131072 + 1024); p.lda = D; p.ldb = 256; p.K = 256; run_gemm(lds, p); SYNC(base + 1); }
    PH(base + 3) { STAMP(base + 3); PResid p; p.nM = T / 256; p.nN = 4; p.A = (const bf16_t*)(ar + AR_P); p.W = (const bf16_t*)(ws + WS_VW) + (size_t)L * NB * D * D; p.X = X; p.xstat = xstat; p.lda = D; p.ldb = D; p.K = D; p.bstride = (size_t)D * D; run_gemm(lds, p); SYNC(base + 3); }
    PH(base + 4) { STAMP(base + 4); PRouter p; p.nM = T / 256; p.nN = 1; p.X = X; p.W = (const bf16_t*)(ws + WS_W_R) + (size_t)L * 256 * D; p.xstat = xstat; p.bg = AIN(I_MBG) + L * 4; p.be = AIN(I_MBE) + L * 32; p.rlog = (float*)(ws + WS_RLOG); p.lda = D; p.ldb = D; p.K = D; run_gemm(lds, p); SYNC(base + 4); }
    PH(base + 5) { STAMP(base + 5); phase_route(a, lds, L); SYNC(base + 5); }
    PH(base + 6) { STAMP(base + 6); PMoeUp p; p.cnt = (const int*)(ws + WS_CTL) + 64 * L; p.list = (const int*)(ws + WS_LIST); p.lists = (const float*)(ws + WS_LISTS); p.listw = (const float*)(ws + WS_LISTW); p.tpre = tpre; p.X = X; p.W = (const bf16_t*)(ws + WS_W_GU); p.xstat = xstat; p.H = (bf16_t*)(ar + AR_H); p.lda = D; p.ldb = D; p.K = D;
        moe_sched_build(p.cnt, tpre); run_gemm(lds, p); SYNC(base + 6); }
    PH(base + 7) { STAMP(base + 7); PMoeDown p; p.cnt = (const int*)(ws + WS_CTL) + 64 * L; p.list = (const int*)(ws + WS_LIST); p.lists = (const float*)(ws + WS_LISTS); p.listw = (const float*)(ws + WS_LISTW); p.tpre = tpre; p.H = (const bf16_t*)(ar + AR_H); p.W = (const bf16_t*)(ws + WS_W_DN); p.pairw = (const float*)(ws + WS_PAIRW); p.Y = (bf16_t*)(ar + AR_Y); p.lda = DEXP; p.ldb = DEXP; p.K = DEXP;
        moe_sched_build(p.cnt, tpre); run_gemm(lds, p); SYNC(base + 7); }
    PH(base + 8) { STAMP(base + 8); phase_combine(a, L == 1); SYNC(base + 8); }
}

__global__ void __launch_bounds__(NTHREADS, 2) fwd_kernel(Args a) {
    extern __shared__ __attribute__((aligned(16))) unsigned char lds_raw[];
    LAS unsigned char* lds = (LAS unsigned char*)lds_raw;
    unsigned char* ws = a.ws;
    bf16_t* X = (bf16_t*)(ws + WS_X); float* xstat = (float*)(ws + WS_XSTAT);
    unsigned char* ar = ws + WS_ARENA;
    volatile LAS unsigned* bst = (volatile LAS unsigned*)(lds + 131072 + 256);
    if (threadIdx.x < 2) bst[threadIdx.x] = 0u;
    __syncthreads();
    XcdBarrier bar = xcd_barrier_post((unsigned*)(ws + WS_CTL + 4096), bst);
    PH(0) { STAMP(0); phase_prologue(a, lds);
#if defined(REPEAT_PRO)
        __syncthreads(); phase_prologue(a, lds);
#endif
        SYNC(0); }
    PH(1) { STAMP(1);
        phase_cumsum(a, lds);
        { PInProj0 p; p.nM = T / 256; p.nN = 10; p.X = X; p.W = (const bf16_t*)(ws + WS_W_IN0); p.xstat = xstat; p.qg = AIN(I_AQG); p.kg = AIN(I_AKG);
          p.Q = (bf16_t*)(ar + AR_Q); p.Kq = (bf16_t*)(ar + AR_K); p.V = (bf16_t*)(ar + AR_V); p.XB = (bf16_t*)(ar + AR_XB); p.GATE = (bf16_t*)(ar + AR_GATE); p.lda = D; p.ldb = D; p.K = D;
          run_gemm(lds, p); }
        { PMemKV m; m.nM = 8; m.nN = 16; m.A = (const bf16_t*)(ws + WS_MEMB); m.W = (const bf16_t*)(ws + WS_W_KV); m.memstat = (const float*)(ws + WS_MISC + MISC_MEMSTAT);
          m.k2stat_ = (float*)(ws + WS_MISC + MISC_K2STAT); m.K2_ = (bf16_t*)(ws + WS_K2); m.V2T_ = (bf16_t*)(ws + WS_ARENA + AR_V2TMP); m.lda = D; m.ldb = D; m.K = D;
          run_gemm(lds, m); }
        SYNC(1);
    }
    PH(2) { STAMP(2); phase_k2fin(a);
        { PVW p; p.WO = (const bf16_t*)(ws + WS_W_O); p.V2 = (const bf16_t*)(ws + WS_ARENA + AR_V2TMP); p.VW = (bf16_t*)(ws + WS_VW); p.lda = D; p.ldb = 256; p.K = 256; run_gemm(lds, p); }
        phase_lru(a, lds, 0);
#if defined(REPEAT_LRU)
        phase_lru(a, lds, 0);
#endif
        SYNC(2); }
    PH(3) { STAMP(3); phase_lru(a, lds, 1);
#if FAST_ATTN
        { const attn_body::AttnTensors AT{(const attn_body::bf16*)(ar + AR_Q), (const attn_body::bf16*)(ar + AR_K), (const attn_body::bf16*)(ar + AR_V), (attn_body::bf16*)(ar + AR_AR), (const float*)(ws + WS_CSUM)};
          __syncthreads(); attn_body::attn_phase<ATTN_THRL>((char*)lds_raw, AT); __syncthreads();
#ifdef REPEAT_ATTN
          attn_body::attn_phase<ATTN_THRL>((char*)lds_raw, AT); __syncthreads();
#endif
        }
#else
        phase_attn_naive(a);
#endif
        SYNC(3); }
    PH(4) { STAMP(4); PResid p; p.nM = T / 256; p.nN = 4; p.A = (const bf16_t*)(ar + AR_AR); p.W = (const bf16_t*)(ws + WS_W_OUT0); p.X = X; p.xstat = xstat; p.lda = D; p.ldb = D; p.K = D; p.bstride = 0; run_gemm(lds, p); SYNC(4); }
    layer_tail<0>(a, lds, 5, bar);
    PH(14) { STAMP(14); conv_moe_layer(a, 1);
        PInProj1 p; p.nM = T / 256; p.nN = 16; p.X = X; p.W = (const bf16_t*)(ws + WS_W_IN1); p.xstat = xstat; p.bias = AIN(I_CBIN); p.Ub = (bf16_t*)(ar + AR_U); p.V3 = (bf16_t*)(ar + AR_V3); p.vstat = (float*)(ws + WS_VSTAT); p.lda = D; p.ldb = D; p.K = D;
        __syncthreads(); run_gemm(lds, p); SYNC(14); }
    PH(15) { STAMP(15); phase_mix_fast(a, lds); SYNC(15); }
    PH(16) { STAMP(16); PResid p; p.nM = T / 256; p.nN = 4; p.A = (const bf16_t*)(ar + AR_U); p.W = (const bf16_t*)(ws + WS_W_OUT1); p.X = X; p.xstat = xstat; p.lda = CW; p.ldb = CW; p.K = CW; p.bstride = 0; run_gemm(lds, p); SYNC(16); }
    layer_tail<1>(a, lds, 17, bar);
#ifdef PROBE_LO
    __syncthreads();
    if (blockIdx.x == 0 && threadIdx.x == 0) { STAMP(26); const unsigned long long* ts = (const unsigned long long*)(a.ws + WS_CTL + 24576);
        a.out[0] = 10.f + (float)(ts[PROBE_HI + 1] - ts[PROBE_LO]) / (100.f * PROBE_DIV); }
#endif
}

extern "C" void kernel_launch(void* const* d_in, const int* in_sizes, int n_in, void* d_out, int out_size, void* d_ws, size_t ws_size, hipStream_t stream) {
    static int grid = 0;
    if (grid == 0) {
        if (n_in != 36 || out_size != T * D || ws_size < WS_END) { fprintf(stderr, "kernel_launch: unexpected sizes n_in %d out %d ws %zu\n", n_in, out_size, ws_size); grid = -1; return; }
        int dev = 0, cus = 0, per_cu = 0;
        hipGetDevice(&dev); hipDeviceGetAttribute(&cus, hipDeviceAttributeMultiprocessorCount, dev);
        hipFuncSetAttribute((const void*)fwd_kernel, hipFuncAttributeMaxDynamicSharedMemorySize, LDS_BYTES);
        hipOccupancyMaxActiveBlocksPerMultiprocessor(&per_cu, (const void*)fwd_kernel, NTHREADS, LDS_BYTES);
        if (per_cu < 1) { fprintf(stderr, "kernel_launch: occupancy query says %d blocks per CU\n", per_cu); per_cu = 1; }
        (void)hipGetLastError();
        grid = cus;
    }
    if (grid < 0) return;
    (void)hipMemsetAsync((char*)d_ws + WS_CTL, 0, 32768, stream);
    Args a{};
    for (int i = 0; i < 36; ++i) a.in[i] = (const float*)d_in[i];
    a.out = (float*)d_out; a.ws = (unsigned char*)d_ws;
#if ONE_LAUNCH
    a.ph_lo = 0; a.ph_hi = NPHASES;
#if USE_CG_SYNC
    void* args[] = {&a};
    hipError_t e = hipLaunchCooperativeKernel((const void*)fwd_kernel, dim3(grid), dim3(NTHREADS), args, LDS_BYTES, stream);
    if (e != hipSuccess) fprintf(stderr, "cooperative launch failed: %s (grid %d)\n", hipGetErrorString(e), grid);
#else
    hipLaunchKernelGGL(fwd_kernel, dim3(grid), dim3(NTHREADS), LDS_BYTES, stream, a);
#endif
#else
    for (int ph = 0; ph < NPHASES; ++ph) { a.ph_lo = ph; a.ph_hi = ph + 1; hipLaunchKernelGGL(fwd_kernel, dim3(grid), dim3(NTHREADS), LDS_BYTES, stream, a); }
#endif
}
```
